# Optimizing an MI355X kernel written in HIP

```python
import jax, jax.numpy as jnp
from jax import lax
import numpy as np

D_MODEL = 1024
BATCH = 2
SEQ = 16384
DEPTH = 2

GRID_W = 64
CTX_LEN = 256
POOL_WINDOWS = (2, 4, 8, 16)
N_POOL_GROUPS = 4
POOL_GROUP_W = D_MODEL // 8
POOL_W = N_POOL_GROUPS * POOL_GROUP_W
HEAD_DIM = 64
N_HEADS = D_MODEL // (2 * HEAD_DIM)
N_KV_HEADS = N_HEADS // 4
Q_REP = N_HEADS // N_KV_HEADS
ATTN_W = N_HEADS * HEAD_DIM
KV_W = N_KV_HEADS * HEAD_DIM
WINDOW = 128
BLOCK = 128
ROPE_BASE = 10000.0
N_BRANCHES = 2
COL_POOL = 0
COL_Q = COL_POOL + POOL_W
COL_K = COL_Q + ATTN_W
COL_V = COL_K + KV_W
COL_GATE = COL_V + KV_W
IN_COLS = COL_GATE + N_BRANCHES * D_MODEL
N_EXPERTS = 32
N_EXPERT_GROUPS = 8
EXPERTS_PER_GROUP = N_EXPERTS // N_EXPERT_GROUPS
TOP_K = 2
D_EXPERT = D_MODEL
EXPERT_BLOCK = 256
DEEPNORM_ALPHA = (2 * DEPTH) ** 0.25
DEEPNORM_BETA = (8 * DEPTH) ** -0.25
LN_EPS = 1e-6

kernel_name = 'hybrid_pool_swa_moe_dit_block'


def layer_norm(x, gain=None, bias=None):
    xf = x.astype(jnp.float32)
    xc = xf - xf.mean(-1, keepdims=True)
    y = xc * lax.rsqrt((xc * xc).mean(-1, keepdims=True) + LN_EPS)
    if gain is not None:
        y = y * gain.astype(jnp.float32) + bias.astype(jnp.float32)
    return y.astype(x.dtype)


def modulate(x, shift, scale):
    return layer_norm(x) * (1 + scale) + shift


def ada_terms(cond, w_ada, b_ada):
    return jnp.split(jax.nn.silu(cond) @ w_ada + b_ada, 6, axis=-1)


def axial_rope_tables(rows):
    row = jnp.repeat(jnp.arange(rows), GRID_W).astype(jnp.float32)
    col = jnp.tile(jnp.arange(GRID_W), rows).astype(jnp.float32)
    half = HEAD_DIM // 2
    inv_freq = ROPE_BASE ** (-jnp.arange(0, half, 2, dtype=jnp.float32) / half)
    ang_r = row[:, None] * inv_freq
    ang_c = col[:, None] * inv_freq
    return (jnp.cos(ang_r), jnp.sin(ang_r), jnp.cos(ang_c), jnp.sin(ang_c))


def rotate(x, cos, sin):
    x1, x2 = jnp.split(x, 2, axis=-1)
    c = cos[:, None, :].astype(x.dtype)
    s = sin[:, None, :].astype(x.dtype)
    return jnp.concatenate([x1 * c - x2 * s, x2 * c + x1 * s], axis=-1)


def apply_axial_rope(x, tables):
    cr, sr, cc, sc = tables
    x_row, x_col = jnp.split(x, 2, axis=-1)
    return jnp.concatenate([rotate(x_row, cr, sr), rotate(x_col, cc, sc)], axis=-1)


def sink_softmax(s, sink):
    m = jnp.maximum(jnp.max(s, axis=-1, keepdims=True), sink)
    e = jnp.exp(s - m)
    return e / (jnp.sum(e, axis=-1, keepdims=True) + jnp.exp(sink - m))


def multiscale_pool(u, w_grp, scale):
    B, L, _ = u.shape
    cs = jnp.pad(jnp.cumsum(u.astype(jnp.float32), axis=1), ((0, 0), (1, 0), (0, 0)))
    t = jnp.arange(L)
    means = []
    for g, w in enumerate(POOL_WINDOWS):
        lo = jnp.clip(t - w // 2, 0, L - 1)
        hi = jnp.clip(t - w // 2 + w - 1, 0, L - 1)
        csg = cs[:, :, g * POOL_GROUP_W:(g + 1) * POOL_GROUP_W]
        cnt = (hi - lo + 1).astype(jnp.float32)[None, :, None]
        means.append((jnp.take(csg, hi + 1, axis=1) - jnp.take(csg, lo, axis=1)) / cnt)
    pooled = jnp.concatenate(means, axis=-1).astype(u.dtype) - u
    y = jnp.einsum('blgc,gcd->blgd', pooled.reshape(B, L, N_POOL_GROUPS, POOL_GROUP_W), w_grp)
    return y.reshape(B, L, POOL_W) * scale


def windowed_gqa(q, k, v, kc, vc, sink):
    B, L = q.shape[:2]
    nb = L // BLOCK
    qb = q.reshape(B, nb, BLOCK, N_KV_HEADS, Q_REP, HEAD_DIM)

    def band(t):
        tp = jnp.pad(t, ((0, 0), (BLOCK, BLOCK), (0, 0), (0, 0))).reshape(B, nb + 2, BLOCK, N_KV_HEADS, HEAD_DIM)
        return jnp.concatenate([tp[:, :-2], tp[:, 1:-1], tp[:, 2:]], axis=2)

    kb, vb = band(k), band(v)
    scale = HEAD_DIM ** -0.5
    s_loc = jnp.einsum('bnqgrd,bnkgd->bngrqk', qb, kb).astype(jnp.float32) * scale
    s_ctx = jnp.einsum('bnqgrd,bcgd->bngrqc', qb, kc).astype(jnp.float32) * scale
    blk = jnp.arange(nb)[:, None, None] * BLOCK
    qpos = blk + jnp.arange(BLOCK)[None, :, None]
    kpos = blk - BLOCK + jnp.arange(3 * BLOCK)[None, None, :]
    valid = (jnp.abs(qpos - kpos) <= WINDOW) & (kpos >= 0) & (kpos < L)
    s_loc = jnp.where(valid[None, :, None, None], s_loc, -jnp.inf)
    sk = sink.astype(jnp.float32).reshape(N_KV_HEADS, Q_REP, 1, 1)
    p = sink_softmax(jnp.concatenate([s_loc, s_ctx], axis=-1), sk).astype(v.dtype)
    nk = 3 * BLOCK
    o = (jnp.einsum('bngrqk,bnkgd->bnqgrd', p[..., :nk], vb)
         + jnp.einsum('bngrqc,bcgd->bnqgrd', p[..., nk:], vc))
    return o.reshape(B, L, ATTN_W)


def context_gqa(qc, kc, vc, sink):
    B, C = qc.shape[:2]
    qg = qc.reshape(B, C, N_KV_HEADS, Q_REP, HEAD_DIM)
    s = jnp.einsum('bqgrd,bkgd->bgrqk', qg, kc).astype(jnp.float32) * HEAD_DIM ** -0.5
    sk = sink.astype(jnp.float32).reshape(N_KV_HEADS, Q_REP, 1, 1)
    p = sink_softmax(s, sk).astype(vc.dtype)
    return jnp.einsum('bgrqk,bkgd->bqgrd', p, vc).reshape(B, C, ATTN_W)


def merge_branches(gate_cols, pool_out, attn_out, w_pool_br, w_attn_br, w_o):
    g_pool, g_attn = jnp.split(jax.nn.sigmoid(gate_cols), N_BRANCHES, axis=-1)
    return (g_pool * (pool_out @ w_pool_br) + g_attn * (attn_out @ w_attn_br)) @ w_o


def token_mixer(h, hc, rope, w_in, w_pool_grp, pool_scale, w_pool_br, w_attn_br, sink, w_o, ctx_out):
    B, L, _ = h.shape
    C = hc.shape[1]
    p = h @ w_in
    q = apply_axial_rope(p[..., COL_Q:COL_K].reshape(B, L, N_HEADS, HEAD_DIM), rope)
    k = apply_axial_rope(p[..., COL_K:COL_V].reshape(B, L, N_KV_HEADS, HEAD_DIM), rope)
    v = p[..., COL_V:COL_GATE].reshape(B, L, N_KV_HEADS, HEAD_DIM)
    if ctx_out:
        pc = hc @ w_in
        kvc = pc[..., COL_K:COL_GATE]
    else:
        kvc = hc @ w_in[:, COL_K:COL_GATE]
    kc = kvc[..., :KV_W].reshape(B, C, N_KV_HEADS, HEAD_DIM)
    vc = kvc[..., KV_W:].reshape(B, C, N_KV_HEADS, HEAD_DIM)
    pool_lat = multiscale_pool(p[..., COL_POOL:COL_Q], w_pool_grp, pool_scale)
    attn_lat = windowed_gqa(q, k, v, kc, vc, sink)
    y = merge_branches(p[..., COL_GATE:], pool_lat, attn_lat, w_pool_br, w_attn_br, w_o)
    if not ctx_out:
        return y, None
    pool_c = multiscale_pool(pc[..., COL_POOL:COL_Q], w_pool_grp, pool_scale)
    attn_c = context_gqa(pc[..., COL_Q:COL_K].reshape(B, C, N_HEADS, HEAD_DIM), kc, vc, sink)
    yc = merge_branches(pc[..., COL_GATE:], pool_c, attn_c, w_pool_br, w_attn_br, w_o)
    return y, yc


def route(h, w_router, router_bias):
    N = h.shape[0]
    scores = jax.nn.sigmoid((h @ w_router).astype(jnp.float32))
    biased = (scores + router_bias.astype(jnp.float32)).reshape(N, N_EXPERT_GROUPS, EXPERTS_PER_GROUP)
    group_score = lax.top_k(biased, 2)[0].sum(-1)
    g_sel = jnp.argmax(group_score, axis=-1).astype(jnp.int32)
    in_group = jnp.take_along_axis(biased, g_sel[:, None, None], axis=1)[:, 0]
    _, local = lax.top_k(in_group, TOP_K)
    experts = (g_sel[:, None] * EXPERTS_PER_GROUP + local).astype(jnp.int32)
    w = jnp.take_along_axis(scores, experts, axis=1)
    return experts, (w / w.sum(-1, keepdims=True)).astype(h.dtype)


def expert_ffn(h, experts, weights, w_gate, w_up, w_down):
    N, D = h.shape
    M = N * TOP_K
    flat_e = experts.reshape(M)
    flat_tok = jnp.repeat(jnp.arange(N, dtype=jnp.int32), TOP_K)
    order = jnp.argsort(flat_e)
    e_sorted = flat_e[order]
    counts = jnp.bincount(flat_e, length=N_EXPERTS)
    padded = (counts + EXPERT_BLOCK - 1) // EXPERT_BLOCK * EXPERT_BLOCK
    starts = jnp.cumsum(counts) - counts
    pends = jnp.cumsum(padded)
    pstarts = pends - padded
    dest = (pstarts[e_sorted] + jnp.arange(M) - starts[e_sorted]).astype(jnp.int32)
    n_rows = -(-M // EXPERT_BLOCK) * EXPERT_BLOCK + N_EXPERTS * EXPERT_BLOCK
    n_blocks = n_rows // EXPERT_BLOCK
    row_tok = jnp.full((n_rows,), N, jnp.int32).at[dest].set(flat_tok[order])
    block_expert = jnp.minimum(
        jnp.searchsorted(pends, jnp.arange(n_blocks) * EXPERT_BLOCK, side='right'), N_EXPERTS - 1).astype(jnp.int32)
    h_pad = jnp.concatenate([h, jnp.zeros((1, D), h.dtype)], axis=0)
    xb = h_pad[row_tok].reshape(n_blocks, EXPERT_BLOCK, D)

    def run_block(args):
        xblk, e = args
        return (jax.nn.silu(xblk @ w_gate[e]) * (xblk @ w_up[e])) @ w_down[e]

    yb = lax.map(run_block, (xb, block_expert)).reshape(n_rows, D)
    slot = jnp.zeros((M,), jnp.int32).at[order].set(dest)
    return jnp.einsum('nkd,nk->nd', yb[slot].reshape(N, TOP_K, D), weights)


def setup_inputs(seed: int = 0) -> dict:
    key = jax.random.key(seed)
    ks = jax.random.split(key, 24)

    def nrm(k, shape, s):
        return jax.random.normal(k, shape, jnp.float32) * s

    D = D_MODEL
    w_in = nrm(ks[4], (DEPTH, D, IN_COLS), D ** -0.5)
    w_in = w_in.at[:, :, COL_V:COL_GATE].multiply(DEEPNORM_BETA)
    return {
        'x': nrm(ks[0], (BATCH, SEQ, D), 1.0),
        'c': nrm(ks[1], (BATCH, D), 1.0),
        'ctx': nrm(ks[2], (BATCH, CTX_LEN, D), 1.0),
        'c_ctx': nrm(ks[3], (D,), 1.0),
        'w_ada': nrm(ks[5], (DEPTH, D, 6 * D), 0.5 * D ** -0.5),
        'b_ada': nrm(ks[6], (DEPTH, 6 * D), 0.02),
        'w_in': w_in,
        'w_pool_grp': nrm(ks[7], (DEPTH, N_POOL_GROUPS, POOL_GROUP_W, POOL_GROUP_W), POOL_GROUP_W ** -0.5),
        'pool_scale': 1.0 + nrm(ks[8], (DEPTH, POOL_W), 0.1),
        'w_pool_br': nrm(ks[9], (DEPTH, POOL_W, D), DEEPNORM_BETA * POOL_W ** -0.5),
        'w_attn_br': nrm(ks[10], (DEPTH, ATTN_W, D), DEEPNORM_BETA * ATTN_W ** -0.5),
        'attn_sink': nrm(ks[11], (DEPTH, N_HEADS), 0.5),
        'w_o': nrm(ks[12], (DEPTH, D, D), DEEPNORM_BETA * D ** -0.5),
        'ln1_g': 1.0 + nrm(ks[13], (DEPTH, D), 0.02),
        'ln1_b': nrm(ks[14], (DEPTH, D), 0.02),
        'w_router': nrm(ks[15], (D, N_EXPERTS), D ** -0.5),
        'router_bias': nrm(ks[16], (N_EXPERTS,), 0.01),
        'w_exp_gate': nrm(ks[17], (DEPTH, N_EXPERTS, D, D_EXPERT), D ** -0.5),
        'w_exp_up': nrm(ks[18], (DEPTH, N_EXPERTS, D, D_EXPERT), D ** -0.5),
        'w_exp_down': nrm(ks[19], (DEPTH, N_EXPERTS, D_EXPERT, D), DEEPNORM_BETA * D_EXPERT ** -0.5),
        'ln2_g': 1.0 + nrm(ks[20], (DEPTH, D), 0.02),
        'ln2_b': nrm(ks[21], (DEPTH, D), 0.02),
    }


def reference(x, c, ctx, c_ctx, w_ada, b_ada, w_in, w_pool_grp, pool_scale, w_pool_br, w_attn_br,
              attn_sink, w_o, ln1_g, ln1_b, w_router, router_bias, w_exp_gate, w_exp_up, w_exp_down,
              ln2_g, ln2_b):
    B, L, D = x.shape
    C = ctx.shape[1]
    ROWS = L // GRID_W
    rope = axial_rope_tables(ROWS)
    xc = ctx
    for l in range(DEPTH):
        ctx_out = l < DEPTH - 1
        sh1, sc1, g1, sh2, sc2, g2 = ada_terms(c[:, None, :], w_ada[l], b_ada[l])
        csh1, csc1, cg1, csh2, csc2, cg2 = ada_terms(c_ctx, w_ada[l], b_ada[l])
        h = modulate(x, sh1, sc1)
        hc = modulate(xc, csh1, csc1)
        y, yc = token_mixer(h, hc, rope, w_in[l], w_pool_grp[l], pool_scale[l], w_pool_br[l],
                            w_attn_br[l], attn_sink[l], w_o[l], ctx_out)
        x = layer_norm(DEEPNORM_ALPHA * x + g1 * y, ln1_g[l], ln1_b[l])
        h = modulate(x, sh2, sc2)
        if ctx_out:
            xc = layer_norm(DEEPNORM_ALPHA * xc + cg1 * yc, ln1_g[l], ln1_b[l])
            hc = modulate(xc, csh2, csc2)
            tokens = jnp.concatenate([h.reshape(B * L, D), hc.reshape(B * C, D)], axis=0)
        else:
            tokens = h.reshape(B * L, D)
        experts, weights = route(tokens, w_router, router_bias)
        f = expert_ffn(tokens, experts, weights, w_exp_gate[l], w_exp_up[l], w_exp_down[l])
        x = layer_norm(DEEPNORM_ALPHA * x + g2 * f[:B * L].reshape(B, L, D), ln2_g[l], ln2_b[l])
        if ctx_out:
            xc = layer_norm(DEEPNORM_ALPHA * xc + cg2 * f[B * L:].reshape(B, C, D), ln2_g[l], ln2_b[l])
    return x
```

```cpp
#include <hip/hip_runtime.h>
#include <cstdio>
#include <cstdint>

#ifndef MK_ONE_LAUNCH
#define MK_ONE_LAUNCH 1
#endif

#define GAS __attribute__((address_space(1)))
#define LAS __attribute__((address_space(3)))
typedef unsigned short bf16;
typedef short bf16x8 __attribute__((ext_vector_type(8)));
typedef float f32x4 __attribute__((ext_vector_type(4)));
typedef float f32x2 __attribute__((ext_vector_type(2)));
typedef unsigned u32x4 __attribute__((ext_vector_type(4)));
typedef unsigned u32x2 __attribute__((ext_vector_type(2)));
typedef GAS unsigned gu32;

constexpr int D = 1024, NB_ = 2, SEQ = 16384, CTX = 256;
constexpr int NL = NB_ * SEQ;
constexpr int NC = NB_ * CTX;
constexpr int MT = NL + NC;
constexpr int IN_COLS = 3328;
constexpr int NEXP = 32;
constexpr int LCAP = 2 * MT;
constexpr int MAXBLK = 291;
constexpr float LN_EPS = 1e-6f;
constexpr float ALPHA = 1.4142135623730951f;
constexpr float LOG2E = 1.4426950408889634f;
constexpr float QSCALE = 0.125f * LOG2E;

constexpr size_t WS_CTL = 0, CTL_ZERO_BYTES = 1u << 20;
constexpr int CW_TMO = 0;
constexpr int CW_BAR = 4096;
constexpr int CW_CNT = 8192;
constexpr int CW_QHEAD = 12288;
constexpr int CW_PHDONE = 12352;
constexpr int BG_PER_LAYER = 3 * 32 * 256, BG_TOTAL = 2 * BG_PER_LAYER;
constexpr size_t al256(size_t x) { return (x + 255) & ~(size_t)255; }
constexpr size_t WS_ROPE = CTL_ZERO_BYTES;
constexpr size_t WS_WRT  = WS_ROPE + 65536;
constexpr size_t WS_ADAP = WS_WRT + 131072;
constexpr size_t WS_WIN  = WS_ADAP + (size_t)36864 * 4;
constexpr size_t WS_WPG  = WS_WIN + (size_t)2 * IN_COLS * D * 2;
constexpr size_t WS_WPB  = WS_WPG + (size_t)2 * 4 * 128 * 128 * 2;
constexpr size_t WS_WAB  = WS_WPB + (size_t)2 * 1024 * 512 * 2;
constexpr size_t WS_WO   = WS_WAB + (size_t)2 * 1024 * 512 * 2;
constexpr size_t WS_WEG  = WS_WO + (size_t)2 * 1024 * 1024 * 2;
constexpr size_t WS_WEU  = WS_WEG + (size_t)64 * 1024 * 1024 * 2;
constexpr size_t WS_WED  = WS_WEU + (size_t)64 * 1024 * 1024 * 2;
constexpr size_t WS_LIST = WS_WED + (size_t)64 * 1024 * 1024 * 2;
constexpr size_t WS_TOK  = WS_LIST + (size_t)NEXP * LCAP * 4;
constexpr size_t WS_X1C  = WS_TOK + (size_t)MT * 32;
constexpr size_t WS_A    = al256(WS_X1C + (size_t)NC * D * 4);
constexpr size_t SZ_A    = (size_t)MT * 4608;
static_assert(SZ_A >= (size_t)MAXBLK * 256 * D * 2, "region A holds ACT");
constexpr size_t WS_H    = WS_A;
constexpr size_t WS_U    = WS_H + (size_t)MT * D * 2;
constexpr size_t WS_Q    = WS_U + (size_t)MT * 512 * 2;
constexpr size_t WS_K    = WS_Q + (size_t)MT * 512 * 2;
constexpr size_t WS_V    = WS_K + (size_t)MT * 128 * 2;
static_assert(WS_V + (size_t)MT * 128 * 2 <= WS_A + SZ_A, "region A");
constexpr size_t WS_B    = WS_A + SZ_A;
constexpr size_t WS_GATE = WS_B;
static_assert((size_t)MT * 2048 * 2 <= SZ_A, "region B");
constexpr size_t WS_C    = WS_B + SZ_A;
constexpr size_t WS_E    = WS_C + (size_t)MT * D * 4;
constexpr size_t WS_PO   = WS_E;
constexpr size_t WS_AO   = WS_E + (size_t)MT * 512 * 2;
constexpr size_t WS_F    = WS_E + (size_t)MT * D * 2;
constexpr size_t WS_END  = WS_F + (size_t)MT * D * 2;
static_assert(WS_END <= (size_t)1073741824, "d_ws map must fit 1 GiB");

constexpr int RING_BYTES = 131072;
constexpr int MISC_OFF = RING_BYTES;
constexpr int L_BARW = 0;
constexpr int L_QSLOT = 32;
constexpr int L_BLK = 64;
constexpr int L_CNT = 256;
constexpr int L_LCNT = 384;
constexpr int L_BASE = 512;
constexpr int L_ROW = 1024;
constexpr int LDS_BYTES = 147456;

#define RLX_AGENT __ATOMIC_RELAXED, __HIP_MEMORY_SCOPE_AGENT
#define LDS_WAIT() asm volatile("s_waitcnt lgkmcnt(0)" ::: "memory")
#define VM_WAIT() asm volatile("s_waitcnt vmcnt(0)" ::: "memory")

__device__ __forceinline__ unsigned cvt_pk_bf16(float lo, float hi) { unsigned r; asm volatile("v_cvt_pk_bf16_f32 %0, %1, %2" : "=v"(r) : "v"(lo), "v"(hi)); return r; }
__device__ __forceinline__ float bf_lo(unsigned w) { return __uint_as_float(w << 16); }
__device__ __forceinline__ float bf_hi(unsigned w) { return __uint_as_float(w & 0xffff0000u); }
__device__ __forceinline__ float bf2f(bf16 b) { return __uint_as_float(((unsigned)b) << 16); }
__device__ __forceinline__ float sigmoid_fast(float x) { return __builtin_amdgcn_rcpf(1.0f + __builtin_amdgcn_exp2f(-x * LOG2E)); }

namespace pg8 {
constexpr int BM = 256, BK = 64, HALF = 128, HTB = HALF * BK * 2, STAGE_BYTES = 8 * HTB, NXCD = 8, WGM = 8;
__host__ __device__ __forceinline__ int lds_byte(int r, int c) { const int st = (r >> 4) * 2 + (c >> 5), rr = r & 15, cc = c & 31, ob = rr * 64 + cc * 2; return st * 1024 + (ob ^ (((ob >> 9) & 1) << 5)); }
__host__ __device__ __forceinline__ void stage_rc(int b, int& R, int& C) { const int st = b / 1024, sb = b % 1024, swz = sb ^ (((sb >> 9) & 1) << 5); R = (st >> 1) * 16 + swz / 64; C = (st & 1) * 32 + (swz % 64) / 2; }
__host__ __device__ __forceinline__ int perm32(int rho) { const int n = rho >> 4, i = rho & 15; return 8 * (i >> 2) + 4 * n + (i & 3); }

struct Unit { int pm, pn, e, x0, x1; };

template <class Epi, class Sched, bool ALIGN_EPI>
__device__ __forceinline__ void gemm_phase(LAS unsigned char* lds, const int K, const Sched& S, const Epi& E) {
    int tid_l = threadIdx.x; asm volatile("" : "+v"(tid_l));
    const int tid = tid_l, wid = __builtin_amdgcn_readfirstlane(tid >> 6), lane = tid & 63, wr = wid >> 2, wc = wid & 3, fr = lane & 15, fq = lane >> 4;
    const int nt = K / BK;
    int Rr[2]; unsigned Cc[2], voffB[2];
#pragma unroll
    for (int i = 0; i < 2; ++i) { int R, C; stage_rc(tid * 16 + i * 8192, R, C); const int Rb = Epi::PERM ? ((R & ~31) + perm32(R & 31)) : R;
        Rr[i] = R; Cc[i] = (unsigned)C * 2u; voffB[i] = (unsigned)(Rb * K + C) * 2u; }
    const size_t kstep = (size_t)(BK * 2);
    const unsigned ldsw = (unsigned)wid * 1024u;
    const int aoff = lds_byte(wr * 64 + fr, fq * 8), boff = lds_byte(wc * 32 + fr, fq * 8);
#define PG8_SA(b, h) (((b) * 2 + (h)) * HTB)
#define PG8_SB(b, h) ((4 + (b) * 2 + (h)) * HTB)
#define PG8_STAGE(bufoff, gbase, voff) do { _Pragma("unroll") for (int _i = 0; _i < 2; ++_i) \
        __builtin_amdgcn_global_load_lds((const unsigned*)((const char*)(gbase) + (voff)[_i]), (LAS unsigned*)(lds + (bufoff) + ldsw + _i * 8192), 16, 0, 0); } while (0)
#define PG8_LDA(dst, b, h) do { _Pragma("unroll") for (int m = 0; m < 4; ++m) _Pragma("unroll") for (int k = 0; k < 2; ++k) dst[m][k] = *(const LAS bf16x8*)(lds + PG8_SA(b, h) + aoff + m * 2048 + k * 1024); } while (0)
#define PG8_LDB(dst, b, h) do { _Pragma("unroll") for (int n = 0; n < 2; ++n) _Pragma("unroll") for (int k = 0; k < 2; ++k) dst[n][k] = *(const LAS bf16x8*)(lds + PG8_SB(b, h) + boff + n * 2048 + k * 1024); } while (0)
#define PG8_MMA(ai, bj, At, Bt) do { __builtin_amdgcn_s_setprio(1); _Pragma("unroll") for (int m = 0; m < 4; ++m) _Pragma("unroll") for (int n = 0; n < 2; ++n) _Pragma("unroll") for (int k = 0; k < 2; ++k) \
        acc[ai][bj][m][n] = __builtin_amdgcn_mfma_f32_16x16x32_bf16(Bt[n][k], At[m][k], acc[ai][bj][m][n], 0, 0, 0); __builtin_amdgcn_s_setprio(0); } while (0)
#define PG8_WAIT_V(n) asm volatile("s_waitcnt vmcnt(" #n ")" ::: "memory")
#define PG8_WAIT_L(n) asm volatile("s_waitcnt lgkmcnt(" #n ")" ::: "memory")
#define PG8_BAR __builtin_amdgcn_s_barrier()
#define PG8_SCHED __builtin_amdgcn_sched_barrier(0)
    Unit cur, nxt; int ui = 0; cur.e = 0;
    if (!S.next(0, cur)) return;
    f32x4 acc[2][2][4][2];
#pragma unroll
    for (int a = 0; a < 2; ++a)
#pragma unroll
        for (int b = 0; b < 2; ++b)
#pragma unroll
            for (int m = 0; m < 4; ++m)
#pragma unroll
                for (int n = 0; n < 2; ++n) acc[a][b][m][n] = (f32x4){0.f, 0.f, 0.f, 0.f};
    bf16x8 At[4][2], B0[2][2], B1[2][2];
    unsigned voffA[2][2];
#pragma unroll
    for (int h = 0; h < 2; ++h)
#pragma unroll
        for (int i = 0; i < 2; ++i) voffA[h][i] = S.a_off(cur, Rr[i] + 128 * h) + Cc[i];
    const char* const Ab = S.A;
    const char *cB0, *cB1; S.b_ptr(cur, cB0, cB1);
    PG8_STAGE(PG8_SB(0, 0), cB0, voffB); PG8_STAGE(PG8_SB(0, 1), cB1, voffB); PG8_STAGE(PG8_SA(0, 0), Ab, voffA[0]); PG8_STAGE(PG8_SA(0, 1), Ab, voffA[1]);
    if (wr == 1) PG8_BAR;
    PG8_WAIT_V(2); PG8_BAR;
    PG8_STAGE(PG8_SB(1, 0), cB0 + kstep, voffB); PG8_STAGE(PG8_SA(1, 0), Ab + kstep, voffA[0]); PG8_STAGE(PG8_SB(1, 1), cB1 + kstep, voffB);
    PG8_WAIT_V(6); PG8_BAR;
    for (;;) {
        nxt = cur; const bool has_next = S.next(ui + 1, nxt);
        const char *nB0 = cB0, *nB1 = cB1; if (has_next) S.b_ptr(nxt, nB0, nB1);
        for (int t = 0; t < nt; t += 2) {
            const bool last = (t == nt - 2);
            const char* a1 = Ab + (size_t)(t + 1) * kstep;
            const char* a2 = last ? Ab : Ab + (size_t)(t + 2) * kstep;
            const char* b20 = last ? nB0 : cB0 + (size_t)(t + 2) * kstep; const char* b21 = last ? nB1 : cB1 + (size_t)(t + 2) * kstep;
            const char* a3 = a2 + kstep; const char* b30 = b20 + kstep; const char* b31 = b21 + kstep;
            if constexpr (Epi::MID) { if (t == nt / 2) E.mid(acc, cur, wr, wc, fr, fq); }
            PG8_LDB(B0, 0, 0); PG8_LDB(B1, 0, 1); PG8_SCHED; PG8_LDA(At, 0, 0); PG8_STAGE(PG8_SA(1, 1), a1, voffA[1]);
            if (last && has_next) {
                int tt = tid; asm volatile("" : "+v"(tt));
#pragma unroll
                for (int i = 0; i < 2; ++i) { int R, C; stage_rc(tt * 16 + i * 8192, R, C);
#pragma unroll
                    for (int h = 0; h < 2; ++h) voffA[h][i] = S.a_off(nxt, R + 128 * h) + (unsigned)C * 2u; }
            }
            PG8_WAIT_V(8); PG8_WAIT_L(0); PG8_BAR; PG8_MMA(0, 0, At, B0); PG8_MMA(0, 1, At, B1); PG8_BAR; PG8_SCHED;
            PG8_LDA(At, 0, 1); PG8_STAGE(PG8_SB(0, 0), b20, voffB); PG8_STAGE(PG8_SB(0, 1), b21, voffB); PG8_STAGE(PG8_SA(0, 0), a2, voffA[0]);
            PG8_WAIT_V(8); PG8_WAIT_L(0); PG8_BAR; PG8_MMA(1, 0, At, B0); PG8_MMA(1, 1, At, B1); PG8_BAR; PG8_SCHED;
            PG8_LDB(B0, 1, 0); PG8_LDB(B1, 1, 1); PG8_SCHED; PG8_LDA(At, 1, 0); PG8_STAGE(PG8_SA(0, 1), a2, voffA[1]);
            PG8_WAIT_V(8); PG8_WAIT_L(0); PG8_BAR; PG8_MMA(0, 0, At, B0); PG8_MMA(0, 1, At, B1); PG8_BAR; PG8_SCHED;
            PG8_LDA(At, 1, 1); PG8_STAGE(PG8_SB(1, 0), b30, voffB); PG8_STAGE(PG8_SB(1, 1), b31, voffB); PG8_STAGE(PG8_SA(1, 0), a3, voffA[0]);
            PG8_WAIT_V(8); PG8_WAIT_L(0); PG8_BAR; PG8_MMA(1, 0, At, B0); PG8_MMA(1, 1, At, B1); PG8_BAR; PG8_SCHED;
        }
        if constexpr (ALIGN_EPI) { if (wr == 0) PG8_BAR; }
        E(acc, cur, wr, wc, fr, fq);
        if (!has_next) break;
#pragma unroll
        for (int a = 0; a < 2; ++a)
#pragma unroll
            for (int b = 0; b < 2; ++b)
#pragma unroll
                for (int m = 0; m < 4; ++m)
#pragma unroll
                    for (int n = 0; n < 2; ++n) acc[a][b][m][n] = (f32x4){0.f, 0.f, 0.f, 0.f};
        cur = nxt; cB0 = nB0; cB1 = nB1; ++ui;
        if constexpr (ALIGN_EPI) { if (wr == 1) PG8_BAR; }
    }
    PG8_WAIT_V(0);
    if constexpr (!ALIGN_EPI) { if (wr == 0) PG8_BAR; }
    PG8_BAR;
#undef PG8_SA
#undef PG8_SB
#undef PG8_STAGE
#undef PG8_LDA
#undef PG8_LDB
#undef PG8_MMA
#undef PG8_WAIT_V
#undef PG8_WAIT_L
#undef PG8_BAR
#undef PG8_SCHED
}
}
using pg8::Unit;

#define XB_TMO      128
#define XB_XCNT(j)  (256  + 64 * (j))
#define XB_XSUB(j)  (1280 + 64 * (j))
#define XB_XGEN(j)  (2304 + 64 * (j))
#define XB_TOP      3328
#define XB_TOPGEN   3392
#define XCD_BAR_WORDS 3456
#define XB_SPIN_CAP (1u << 18)
__device__ __forceinline__ unsigned xb_ld(unsigned* p)              { return __hip_atomic_load(p, __ATOMIC_RELAXED, __HIP_MEMORY_SCOPE_AGENT); }
__device__ __forceinline__ unsigned xb_add(unsigned* p, unsigned v) { return __hip_atomic_fetch_add(p, v, __ATOMIC_RELAXED, __HIP_MEMORY_SCOPE_AGENT); }
__device__ __forceinline__ unsigned xb_xcc_id() { return (unsigned)__builtin_amdgcn_s_getreg((3 << 11) | 20) & 0xFu; }
#define XB_SPIN(cond, bar) do { unsigned _sp = 0; while (cond) { __builtin_amdgcn_s_sleep(1); \
    if ((++_sp & 255u) == 0u) { if (xb_ld(&(bar)[XB_TMO])) break; if (_sp > XB_SPIN_CAP) { atomicAdd(&(bar)[XB_TMO], 1u); break; } } } } while (0)
struct XcdBarrier { unsigned* bar; unsigned x; volatile LAS unsigned* st; };
__device__ __forceinline__ XcdBarrier xcd_barrier_post(unsigned* bar, volatile LAS unsigned* st) {
    XcdBarrier b; b.bar = bar; b.x = xb_xcc_id(); b.st = st;
    if (threadIdx.x == 0) (void)xb_add(&bar[XB_XCNT(b.x)], 1u);
    return b;
}
__device__ __forceinline__ void xcd_barrier_complete(unsigned* bar, unsigned x, unsigned& nloc, unsigned& nx) {
    const unsigned G = gridDim.x * gridDim.y * gridDim.z;
    unsigned sum, cnt, mine, sp = 0u;
    for (;;) {
        sum = 0u; cnt = 0u; mine = 0u;
#pragma unroll
        for (unsigned j = 0; j < 16; ++j) { const unsigned c = xb_ld(&bar[XB_XCNT(j)]); sum += c; cnt += (c > 0u) ? 1u : 0u; mine = (j == x) ? c : mine; }
        if (sum == G) break;
        __builtin_amdgcn_s_sleep(1);
        if ((++sp & 255u) == 0u) { if (xb_ld(&bar[XB_TMO])) break; if (sp > XB_SPIN_CAP) { atomicAdd(&bar[XB_TMO], 1u); break; } }
    }
    nloc = mine > 0u ? mine : 1u; nx = cnt > 0u ? cnt : 1u;
}
__device__ __forceinline__ void xcd_barrier(const XcdBarrier& b) {
    asm volatile("s_waitcnt vmcnt(0)" ::: "memory");
    __syncthreads();
    if (threadIdx.x == 0) {
        unsigned* bar = b.bar;
        __builtin_amdgcn_s_waitcnt(0);
        unsigned nloc = b.st[0], nx = b.st[1];
        if (nloc == 0u) { xcd_barrier_complete(bar, b.x, nloc, nx); b.st[0] = nloc; b.st[1] = nx; }
        const unsigned old = xb_add(&bar[XB_XSUB(b.x)], 1u);
        const unsigned gen = old / nloc;
        if (old + 1u == (gen + 1u) * nloc) {
            __builtin_amdgcn_fence(__ATOMIC_RELEASE, "agent");
            asm volatile("s_waitcnt vmcnt(0)" ::: "memory");
            const unsigned og = xb_add(&bar[XB_TOP], 1u);
            const unsigned tg = og / nx;
            if (og + 1u == (tg + 1u) * nx) xb_add(&bar[XB_TOPGEN], 1u);
            else XB_SPIN(xb_ld(&bar[XB_TOPGEN]) == tg, bar);
            __builtin_amdgcn_fence(__ATOMIC_ACQUIRE, "agent");
            xb_add(&bar[XB_XGEN(b.x)], 1u);
            asm volatile("s_waitcnt vmcnt(0)" ::: "memory");
        } else {
            XB_SPIN(xb_ld(&bar[XB_XGEN(b.x)]) == gen, bar);
            __builtin_amdgcn_fence(__ATOMIC_ACQUIRE, "agent");
            asm volatile("s_waitcnt vmcnt(0)" ::: "memory");
        }
    }
    __syncthreads();
}

struct Args { const float* in[22]; float* out; unsigned char* ws; int ph_lo, ph_hi; };
struct Frame {
    LAS unsigned char* lds; unsigned char* ws; unsigned* ctl;
    int tid, lane, wave, vcu, G;
};
enum { I_X = 0, I_C, I_CTX, I_CCTX, I_WADA, I_BADA, I_WIN, I_WPG, I_PSCALE, I_WPB, I_WAB, I_SINK, I_WO, I_LN1G, I_LN1B, I_WR, I_RB, I_WEG, I_WEU, I_WED, I_LN2G, I_LN2B };

template <int CTRL> __device__ __forceinline__ float dppf(float v) { return __builtin_bit_cast(float, __builtin_amdgcn_update_dpp(0, __builtin_bit_cast(int, v), CTRL, 0xf, 0xf, true)); }
template <int CTRL> __device__ __forceinline__ int dppi(int v) { return __builtin_amdgcn_update_dpp(0, v, CTRL, 0xf, 0xf, true); }
__device__ __forceinline__ float xor4f(float v) { return dppf<0x1B>(dppf<0x141>(v)); }
__device__ __forceinline__ int xor4i(int v) { return dppi<0x1B>(dppi<0x141>(v)); }
__device__ __forceinline__ float wave_sum(float v) {
#pragma unroll
    for (int o = 1; o < 64; o <<= 1) v += __shfl_xor(v, o);
    return v;
}
__device__ __forceinline__ void ln_stats(const f32x4 (&v)[4], float& mean, float& rstd) {
    float s = 0.f, q = 0.f;
#pragma unroll
    for (int j = 0; j < 4; ++j) { s += (v[j].x + v[j].y) + (v[j].z + v[j].w); q += (v[j].x * v[j].x + v[j].y * v[j].y) + (v[j].z * v[j].z + v[j].w * v[j].w); }
    s += dppf<0xB1>(s); q += dppf<0xB1>(q); s += dppf<0x4E>(s); q += dppf<0x4E>(q); s += dppf<0x141>(s); q += dppf<0x141>(q); s += dppf<0x140>(s); q += dppf<0x140>(q);
    s += __shfl_xor(s, 16); q += __shfl_xor(q, 16); s += __shfl_xor(s, 32); q += __shfl_xor(q, 32);
    mean = s * (1.f / D);
    const float var = fmaxf(q * (1.f / D) - mean * mean, 0.f);
    rstd = 1.0f / sqrtf(var + LN_EPS);
}
__device__ __forceinline__ void load_row(const float* p, int lane, f32x4 (&v)[4]) {
#pragma unroll
    for (int j = 0; j < 4; ++j) v[j] = *(const f32x4*)(p + 256 * j + 4 * lane);
}
__device__ __forceinline__ void store_row(float* p, int lane, const f32x4 (&v)[4]) {
#pragma unroll
    for (int j = 0; j < 4; ++j) *(f32x4*)(p + 256 * j + 4 * lane) = v[j];
}
__device__ __forceinline__ void store_row_bf16(bf16* p, int lane, const f32x4 (&v)[4]) {
#pragma unroll
    for (int j = 0; j < 4; ++j) { u32x2 w; w.x = cvt_pk_bf16(v[j].x, v[j].y); w.y = cvt_pk_bf16(v[j].z, v[j].w); *(u32x2*)(p + 256 * j + 4 * lane) = w; }
}
__device__ __forceinline__ void load_vec(const float* p, int lane, f32x4 (&v)[4]) {
#pragma unroll
    for (int j = 0; j < 4; ++j) v[j] = *(const f32x4*)(p + 256 * j + 4 * lane);
}
__device__ __forceinline__ void pin_vec(f32x4 (&v)[4]) {
#pragma unroll
    for (int j = 0; j < 4; ++j) asm volatile("" : "+v"(v[j]));
}
__device__ __forceinline__ int row_vec(int row) { return row < NL ? (row >> 14) : 2; }
__device__ __forceinline__ const float* ada_vec(const Frame& F, int layer, int vec, int chunk) { return (const float*)(F.ws + WS_ADAP) + ((size_t)(layer * 3 + vec) * 6 + chunk) * D; }
__device__ __forceinline__ void load_ada(const float* p, int lane, f32x4 (&v)[4]) { load_vec(p, lane, v); }
__device__ __forceinline__ void modulate_store(const f32x4 (&v)[4], const float* sh, const float* sc, bf16* out, int lane) {
    float mean, rstd; ln_stats(v, mean, rstd);
    f32x4 h[4];
#pragma unroll
    for (int j = 0; j < 4; ++j) { const f32x4 s1 = *(const f32x4*)(sc + 256 * j + 4 * lane), s0 = *(const f32x4*)(sh + 256 * j + 4 * lane); h[j] = (v[j] - mean) * rstd * (s1 + 1.0f) + s0; }
    store_row_bf16(out, lane, h);
}

__device__ __forceinline__ void transpose_item(const float* W, int K, int N, bf16* WT, int k0, int n0, bool perm, LAS float* scr, int lane, int ldk = 0, int kd0 = -1) {
    if (ldk == 0) ldk = K; if (kd0 < 0) kd0 = k0;
    f32x4 r[16];
#pragma unroll
    for (int q = 0; q < 16; ++q) r[q] = *(const f32x4*)(W + (size_t)(k0 + 4 * q + (lane >> 4)) * N + n0 + 4 * (lane & 15));
#pragma unroll
    for (int hf = 0; hf < 2; ++hf) {
#pragma unroll
        for (int q = 0; q < 8; ++q) { const int kk = 4 * q + (lane >> 4); LAS float* d = scr + kk * 65 + 4 * (lane & 15); const f32x4 x = r[hf * 8 + q]; d[0] = x.x; d[1] = x.y; d[2] = x.z; d[3] = x.w; }
        LDS_WAIT(); asm volatile("" ::: "memory");
        const int c = lane & 3;
#pragma unroll
        for (int i = 0; i < 4; ++i) {
            const int n = (lane >> 2) + 16 * i;
            int ns = n;
            if (perm) { const int hh = n >> 5, rem = n & 31; ns = 32 * hh + 16 * (rem & 1) + (rem >> 1); }
            const LAS float* s = scr + (8 * c) * 65 + ns;
            u32x4 o; o.x = cvt_pk_bf16(s[0 * 65], s[1 * 65]); o.y = cvt_pk_bf16(s[2 * 65], s[3 * 65]); o.z = cvt_pk_bf16(s[4 * 65], s[5 * 65]); o.w = cvt_pk_bf16(s[6 * 65], s[7 * 65]);
            *(u32x4*)(WT + (size_t)(n0 + n) * ldk + kd0 + 32 * hf + 8 * c) = o;
        }
        LDS_WAIT(); asm volatile("" ::: "memory");
    }
}
__device__ __forceinline__ float silu_f(float x) { return x / (1.0f + expf(-x)); }
struct TDesc { const float* src; bf16* dst; int N, ldk, k0, kd0, n0, perm; };
__device__ __forceinline__ void t_load(const TDesc& d, int lane, f32x4 (&r)[16]) {
#pragma unroll
    for (int q = 0; q < 16; ++q) r[q] = *(const f32x4*)(d.src + (size_t)(d.k0 + 4 * q + (lane >> 4)) * d.N + d.n0 + 4 * (lane & 15));
}
__device__ __forceinline__ void t_process(const TDesc& d, int lane, const f32x4 (&r)[16], LAS float* scr) {
#pragma unroll
    for (int hf = 0; hf < 2; ++hf) {
#pragma unroll
        for (int q = 0; q < 8; ++q) { const int kk = 4 * q + (lane >> 4); LAS float* p = scr + kk * 65 + 4 * (lane & 15); const f32x4 x = r[hf * 8 + q]; p[0] = x.x; p[1] = x.y; p[2] = x.z; p[3] = x.w; }
        LDS_WAIT(); asm volatile("" ::: "memory");
        const int c = lane & 3;
#pragma unroll
        for (int i = 0; i < 4; ++i) {
            const int n = (lane >> 2) + 16 * i;
            int ns = n;
            if (d.perm) { const int hh = n >> 5, rem = n & 31; ns = 32 * hh + 16 * (rem & 1) + (rem >> 1); }
            const LAS float* sp = scr + (8 * c) * 65 + ns;
            u32x4 o; o.x = cvt_pk_bf16(sp[0 * 65], sp[1 * 65]); o.y = cvt_pk_bf16(sp[2 * 65], sp[3 * 65]); o.z = cvt_pk_bf16(sp[4 * 65], sp[5 * 65]); o.w = cvt_pk_bf16(sp[6 * 65], sp[7 * 65]);
            *(u32x4*)(d.dst + (size_t)(d.n0 + n) * d.ldk + d.kd0 + 32 * hf + 8 * c) = o;
        }
        LDS_WAIT(); asm volatile("" ::: "memory");
    }
}
template <class AT> __device__ __forceinline__ TDesc t_decode(Frame& F, AT& a, int r) {
    constexpr int I_WINn = 2 * 16 * 52, I_WPGn = 2 * 4 * 2 * 2, I_WPBn = 2 * 8 * 16, I_WOn = 2 * 16 * 16, I_EXn = 64 * 256;
    TDesc d; d.perm = 0; d.src = nullptr; d.dst = nullptr; d.N = 0; d.ldk = 0; d.k0 = 0; d.kd0 = 0; d.n0 = 0;
    if (r < I_WINn) { const int l = r / 832, q = r % 832, kb = q / 52, nb = q % 52; d.src = a.in[I_WIN] + (size_t)l * D * IN_COLS; d.dst = (bf16*)(F.ws + WS_WIN) + (size_t)l * IN_COLS * D; d.N = IN_COLS; d.ldk = D; d.k0 = 64 * kb; d.kd0 = d.k0; d.n0 = 64 * nb; d.perm = (d.n0 >= 512 && d.n0 < 1152) ? 1 : 0; return d; }
    r -= I_WINn;
    if (r < I_WPGn) { const int m = r / 4, q = r % 4; d.src = a.in[I_WPG] + (size_t)m * 128 * 128; d.dst = (bf16*)(F.ws + WS_WPG) + (size_t)m * 128 * 128; d.N = 128; d.ldk = 128; d.k0 = 64 * (q >> 1); d.kd0 = d.k0; d.n0 = 64 * (q & 1); return d; }
    r -= I_WPGn;
    if (r < 2 * I_WPBn) { const int second = r >= I_WPBn; if (second) r -= I_WPBn; const int l = r / 128, q = r % 128; d.src = a.in[second ? I_WAB : I_WPB] + (size_t)l * 512 * D; d.dst = (bf16*)(F.ws + WS_WPB) + (size_t)l * D * D; d.N = D; d.ldk = D; d.k0 = 64 * (q / 16); d.kd0 = (second ? 512 : 0) + d.k0; d.n0 = 64 * (q % 16); return d; }
    r -= 2 * I_WPBn;
    if (r < I_WOn) { const int l = r / 256, q = r % 256; d.src = a.in[I_WO] + (size_t)l * D * D; d.dst = (bf16*)(F.ws + WS_WO) + (size_t)l * D * D; d.N = D; d.ldk = D; d.k0 = 64 * (q / 16); d.kd0 = d.k0; d.n0 = 64 * (q % 16); return d; }
    r -= I_WOn;
    { const int which = r / I_EXn, q = r % I_EXn, m = q / 256, t = q % 256;
      d.src = a.in[which == 0 ? I_WEG : (which == 1 ? I_WEU : I_WED)] + (size_t)m * D * D;
      d.dst = (bf16*)(F.ws + (which == 0 ? WS_WEG : (which == 1 ? WS_WEU : WS_WED))) + (size_t)m * D * D;
      d.N = D; d.ldk = D; d.k0 = 64 * (t / 16); d.kd0 = d.k0; d.n0 = 64 * (t % 16); }
    return d;
}
template <class AT> __device__ __forceinline__ void phase_pre(Frame& F, AT& a, bool with_experts) {
    LAS float* scr = (LAS float*)(F.lds + F.wave * 8448);
    const int gw = F.vcu * 8 + F.wave, NGW = F.G * 8;
    { float* tab = (float*)(F.ws + WS_ROPE);
      for (int idx = blockIdx.x * 512 + F.tid; idx < 320 * 16; idx += F.G * 512) {
          const int p = idx >> 4, i = idx & 15; const int pos = p < 256 ? p : p - 256;
          const float inv = powf(10000.0f, -(float)i / 16.0f); const float ang = (float)pos * inv;
          tab[2 * idx] = cosf(ang); tab[2 * idx + 1] = sinf(ang); } }
    { const float* wr = a.in[I_WR]; float* wt = (float*)(F.ws + WS_WRT);
      for (int idx = blockIdx.x * 512 + F.tid; idx < D * NEXP; idx += F.G * 512) { const int c = idx >> 5, e = idx & 31; wt[e * D + c] = wr[idx]; } }
    if (F.vcu < 48) {
        const int l = F.vcu / 24, cg = F.vcu % 24, kc = F.wave; const int col = cg * 256 + 4 * F.lane;
        const float* W = a.in[I_WADA] + (size_t)l * D * 6144 + col;
        f32x4 a0 = {0.f, 0.f, 0.f, 0.f}, a1 = a0, a2 = a0;
        for (int kb = kc * 128; kb < kc * 128 + 128; kb += 16) {
            f32x4 w[16];
#pragma unroll
            for (int i = 0; i < 16; ++i) w[i] = *(const f32x4*)(W + (size_t)(kb + i) * 6144);
            const int kl = kb + (F.lane & 15);
            const float m0 = silu_f(a.in[I_C][kl]), m1 = silu_f(a.in[I_C][D + kl]), m2 = silu_f(a.in[I_CCTX][kl]);
#pragma unroll
            for (int i = 0; i < 16; ++i) {
                const float s0 = __builtin_bit_cast(float, __builtin_amdgcn_readlane(__builtin_bit_cast(int, m0), i)), s1 = __builtin_bit_cast(float, __builtin_amdgcn_readlane(__builtin_bit_cast(int, m1), i)), s2 = __builtin_bit_cast(float, __builtin_amdgcn_readlane(__builtin_bit_cast(int, m2), i));
                a0 += w[i] * s0; a1 += w[i] * s1; a2 += w[i] * s2; }
        }
        LAS f32x4* part = (LAS f32x4*)(F.lds + 69632);
        part[(kc * 3 + 0) * 64 + F.lane] = a0; part[(kc * 3 + 1) * 64 + F.lane] = a1; part[(kc * 3 + 2) * 64 + F.lane] = a2;
        __syncthreads();
        if (F.tid < 192) { const int v = F.tid >> 6, ln = F.tid & 63;
            f32x4 sum = part[(0 * 3 + v) * 64 + ln];
#pragma unroll
            for (int w8 = 1; w8 < 8; ++w8) sum += part[(w8 * 3 + v) * 64 + ln];
            sum += *(const f32x4*)(a.in[I_BADA] + (size_t)l * 6144 + cg * 256 + 4 * ln);
            *(f32x4*)((float*)(F.ws + WS_ADAP) + (size_t)(l * 3 + v) * 6144 + cg * 256 + 4 * ln) = sum; }
        __syncthreads();
    }
    constexpr int I_SMALL = 2 * 16 * 52 + 2 * 4 * 2 * 2 + 2 * 2 * 8 * 16 + 2 * 16 * 16, I_EXn = 64 * 256;
    const int NT = I_SMALL + (with_experts ? 3 * I_EXn : 0);
    int it = gw;
    if (it < NT) {
        f32x4 rc[16]; { const TDesc d0 = t_decode(F, a, it); t_load(d0, F.lane, rc); }
        for (;;) {
            const int nx = it + NGW; const bool more = nx < NT;
            f32x4 rn[16];
            if (more) { const TDesc nd = t_decode(F, a, nx); t_load(nd, F.lane, rn); }
            { const TDesc cd = t_decode(F, a, it); t_process(cd, F.lane, rc, scr); }
            if (!more) break;
            it = nx;
#pragma unroll
            for (int q = 0; q < 16; ++q) rc[q] = rn[q];
        }
    }
}
template <class AT> __device__ __forceinline__ void bg_item(Frame& F, AT& a, int it, LAS float* scr) {
    const int layer = it / BG_PER_LAYER, r = it % BG_PER_LAYER, which = r >> 13, q = r & 8191, m = layer * 32 + (q >> 8), t = q & 255;
    const float* src = a.in[which == 0 ? I_WEG : (which == 1 ? I_WEU : I_WED)] + (size_t)m * D * D;
    bf16* dst = (bf16*)(F.ws + (which == 0 ? WS_WEG : (which == 1 ? WS_WEU : WS_WED))) + (size_t)m * D * D;
    transpose_item(src, D, D, dst, 64 * (t / 16), 64 * (t % 16), false, scr, F.lane);
}
template <class AT> __device__ __forceinline__ TDesc bg_desc(Frame& F, AT& a, int it) {
    const int layer = it / BG_PER_LAYER, r = it % BG_PER_LAYER, which = r >> 13, q = r & 8191, m = layer * 32 + (q >> 8), t = q & 255;
    TDesc d; d.perm = 0;
    d.src = a.in[which == 0 ? I_WEG : (which == 1 ? I_WEU : I_WED)] + (size_t)m * D * D;
    d.dst = (bf16*)(F.ws + (which == 0 ? WS_WEG : (which == 1 ? WS_WEU : WS_WED))) + (size_t)m * D * D;
    d.N = D; d.ldk = D; d.k0 = 64 * (t / 16); d.kd0 = d.k0; d.n0 = 64 * (t % 16);
    return d;
}
template <class AT> __device__ __forceinline__ void seam_fill(Frame& F, AT& a, int k, int drain_limit) {
    LAS int* slot = (LAS int*)(F.lds + MISC_OFF + L_QSLOT);
    LAS float* scr = (LAS float*)(F.lds + F.wave * 8448);
    __syncthreads();
    if (F.tid == 0) (void)__hip_atomic_fetch_add(F.ctl + CW_PHDONE + 64 * k, 1u, RLX_AGENT);
    for (;;) {
        if (F.tid == 0) {
            int base = 0x7fffffff, cnt = 0;
            const int head = (int)__hip_atomic_load(F.ctl + CW_QHEAD, RLX_AGENT);
            if (head < drain_limit) { cnt = 64; base = (int)__hip_atomic_fetch_add(F.ctl + CW_QHEAD, 64u, RLX_AGENT); }
            else if (head < BG_TOTAL && (int)__hip_atomic_load(F.ctl + CW_PHDONE + 64 * k, RLX_AGENT) < F.G) { cnt = 8; base = (int)__hip_atomic_fetch_add(F.ctl + CW_QHEAD, 8u, RLX_AGENT); }
            slot[0] = base; slot[1] = cnt;
        }
        __syncthreads();
        const int base = slot[0], cnt = slot[1];
        if (base >= BG_TOTAL) break;
        int it = base + F.wave; const int end = (base + cnt < BG_TOTAL) ? base + cnt : BG_TOTAL;
        if (it < end) {
            f32x4 rc[16]; { const TDesc d0 = bg_desc(F, a, it); t_load(d0, F.lane, rc); }
            for (;;) {
                const int nx = it + 8; const bool more = nx < end;
                f32x4 rn[16];
                if (more) { const TDesc nd = bg_desc(F, a, nx); t_load(nd, F.lane, rn); }
                { const TDesc cd = bg_desc(F, a, it); t_process(cd, F.lane, rc, scr); }
                if (!more) break;
                it = nx;
#pragma unroll
                for (int q = 0; q < 16; ++q) rc[q] = rn[q];
            }
        }
        __syncthreads();
    }
}

template <class AT> __device__ __forceinline__ void phase_h0(Frame& F, AT& a) {
    const int gw = F.vcu * 8 + F.wave, NGW = F.G * 8;
    f32x4 psh[4], psc[4]; int cvec = -1;
    f32x4 nv[4]; int row = gw;
    if (row < MT) load_row(row < NL ? a.in[I_X] + (size_t)row * D : a.in[I_CTX] + (size_t)(row - NL) * D, F.lane, nv);
    while (row < MT) {
      { const int vec = row_vec(row); cvec = vec; load_ada(ada_vec(F, 0, vec, 0), F.lane, psh); load_ada(ada_vec(F, 0, vec, 1), F.lane, psc); pin_vec(psh); pin_vec(psc); }
      const int seg_hi = cvec == 0 ? SEQ : (cvec == 1 ? NL : MT);
      while (row < seg_hi) {
        f32x4 v[4];
#pragma unroll
        for (int j = 0; j < 4; ++j) v[j] = nv[j];
        const int nrow = row + NGW;
        if (nrow < MT) load_row(nrow < NL ? a.in[I_X] + (size_t)nrow * D : a.in[I_CTX] + (size_t)(nrow - NL) * D, F.lane, nv);
        __builtin_amdgcn_sched_barrier(0);
        { float mean, rstd; ln_stats(v, mean, rstd); f32x4 hh[4];
#pragma unroll
          for (int j = 0; j < 4; ++j) hh[j] = (v[j] - mean) * rstd * (psc[j] + 1.0f) + psh[j];
          store_row_bf16((bf16*)(F.ws + WS_H) + (size_t)row * D, F.lane, hh); }
        row = nrow;
      }
    }
}

struct PlainOrder {
    const char* A; const char* Bt; int K, nM, nN, nwg, G, c, exN, exPm0, exPn;
    __device__ __forceinline__ void init(const void* A_, const void* Bt_, int K_, int nM_, int nN_, int G_, int c_) { A = (const char*)A_; Bt = (const char*)Bt_; K = K_; nM = nM_; nN = nN_; nwg = nM * nN; G = G_; c = c_; exN = 0; exPm0 = 0; exPn = 0; }
    __device__ __forceinline__ bool next(int i, Unit& u) const {
        int L = i * G + c; u.e = 0; u.x0 = 0; u.x1 = 0;
        if (L >= nwg) { L -= nwg; if (L < exN) { u.pm = exPm0 + L; u.pn = exPn; return true; } return false; }
        int wgid = L; { const int q = nwg / 8, r = nwg % 8, xcd = wgid % 8, off = wgid / 8; wgid = (xcd < r ? xcd * (q + 1) : r * (q + 1) + (xcd - r) * q) + off; }
        const int nig = 8 * nN, gid = wgid / nig, fm = gid * 8, gsz = (nM - fm) < 8 ? (nM - fm) : 8;
        u.pm = fm + ((wgid % nig) % gsz); u.pn = (wgid % nig) / gsz; return true;
    }
    __device__ __forceinline__ unsigned a_off(const Unit& u, int R) const { return (unsigned)(u.pm * 256 + R) * (unsigned)(K * 2); }
    __device__ __forceinline__ void b_ptr(const Unit& u, const char*& b0, const char*& b1) const { b0 = Bt + (size_t)u.pn * 256 * K * 2; b1 = b0 + (size_t)128 * K * 2; }
};
struct InProjOrder : PlainOrder {
    __device__ __forceinline__ void b_ptr(const Unit& u, const char*& b0, const char*& b1) const {
        if (u.pn < 5) { b0 = Bt + (size_t)u.pn * 256 * K * 2; b1 = b0 + (size_t)128 * K * 2; }
        else { b0 = Bt + (size_t)(1280 + 128 * (u.pn - 5)) * K * 2; b1 = Bt + (size_t)(2304 + 128 * (u.pn - 5)) * K * 2; }
    }
};
template <bool GATHER> struct MoeOrder {
    const char* A; const char* B0; const char* B1; int NPN, G, vcu; const LAS int* blk; const LAS int* cnt; const int* list;
    __device__ __forceinline__ bool next(int i, Unit& u) const {
        const int L = i * G + vcu; const int NB = blk[32];
        if (L >= NB * NPN) return false;
        const int rbg = L / NPN; u.pn = L % NPN; int e = (i > 0) ? u.e : 0;
        if (e < 0 || e > 31 || rbg < blk[e]) e = 0;
        while (e < 31 && rbg >= blk[e + 1]) ++e;
        const int rb = rbg - blk[e]; u.pm = rbg; u.e = e; u.x0 = e * LCAP + rb * 256; u.x1 = cnt[e] - rb * 256; return true;
    }
    __device__ __forceinline__ unsigned a_off(const Unit& u, int R) const {
        if (GATHER) { int tok = list[u.x0 + R]; tok = (R < u.x1) ? tok : 0; return (unsigned)tok * 2048u; }
        return (unsigned)(u.pm * 256 + R) * 2048u;
    }
    __device__ __forceinline__ void b_ptr(const Unit& u, const char*& b0, const char*& b1) const {
        if (GATHER) { const size_t o = ((size_t)u.e * 1024 + (size_t)u.pn * 128) * 2048; b0 = B0 + o; b1 = B1 + o; }
        else { b0 = B0 + ((size_t)u.e * 1024 + (size_t)u.pn * 256) * 2048; b1 = b0 + (size_t)128 * 2048; }
    }
};

typedef const f32x4 (&AccRef)[2][2][4][2];
__device__ __forceinline__ void store8(bf16* p, const f32x4& a, const f32x4& b) { u32x4 w; w.x = cvt_pk_bf16(a.x, a.y); w.y = cvt_pk_bf16(a.z, a.w); w.z = cvt_pk_bf16(b.x, b.y); w.w = cvt_pk_bf16(b.z, b.w); *(u32x4*)p = w; }
struct EpiInProj {
    static constexpr bool PERM = true; static constexpr bool MID = false;
    bf16 *U, *Q, *Kb, *Vb, *GT; const float* rope;
    __device__ __forceinline__ void rot(f32x4& a, f32x4& b, const f32x4& c0, const f32x4& c1) const {
        const f32x4 ia = a, ib = b;
        a.x = ia.x * c0.x - ia.y * c0.y; a.y = ia.y * c0.x + ia.x * c0.y; a.z = ia.z * c0.z - ia.w * c0.w; a.w = ia.w * c0.z + ia.z * c0.w;
        b.x = ib.x * c1.x - ib.y * c1.y; b.y = ib.y * c1.x + ib.x * c1.y; b.z = ib.z * c1.z - ib.w * c1.w; b.w = ib.w * c1.z + ib.z * c1.w;
    }
    __device__ __forceinline__ void operator()(AccRef acc, const Unit& u, int wr, int wc, int fr, int fq) const {
        const int pn = u.pn; int rowb = u.pm * 256 + wr * 64 + fr; const int cl = wc * 32 + 8 * fq; asm volatile("" : "+v"(rowb));
        const bool lat = u.pm < 128;
        if (pn >= 2 && pn <= 4) {
#pragma unroll
            for (int ai = 0; ai < 2; ++ai) {
                f32x4 cs[4][2];
                if (lat) {
#pragma unroll
                    for (int m = 0; m < 4; ++m) { const int t = (rowb + ai * 128 + m * 16) & (SEQ - 1); const int p = (wc & 1) ? 256 + (t & 63) : (t >> 6);
                        cs[m][0] = *(const f32x4*)(rope + (size_t)(p * 16 + 4 * fq) * 2); cs[m][1] = *(const f32x4*)(rope + (size_t)(p * 16 + 4 * fq) * 2 + 4); }
#pragma unroll
                    for (int m = 0; m < 4; ++m) asm volatile("" : "+v"(cs[m][0]), "+v"(cs[m][1]));
                }
#pragma unroll
                for (int m = 0; m < 4; ++m) { const int row = rowb + ai * 128 + m * 16;
#pragma unroll
                    for (int bj = 0; bj < 2; ++bj) { f32x4 v0 = acc[ai][bj][m][0], v1 = acc[ai][bj][m][1];
                        if (pn < 4) { if (lat) rot(v0, v1, cs[m][0], cs[m][1]); v0 *= QSCALE; v1 *= QSCALE; store8(Q + (size_t)row * 512 + (pn - 2) * 256 + bj * 128 + cl, v0, v1); }
                        else if (bj == 0) { if (lat) rot(v0, v1, cs[m][0], cs[m][1]); store8(Kb + (size_t)row * 128 + cl, v0, v1); }
                        else store8(Vb + (size_t)row * 128 + cl, v0, v1); } }
            }
            return;
        }
#pragma unroll
        for (int ai = 0; ai < 2; ++ai)
#pragma unroll
            for (int m = 0; m < 4; ++m) {
                const int row = rowb + ai * 128 + m * 16;
#pragma unroll
                for (int bj = 0; bj < 2; ++bj) {
                    const f32x4 v0 = acc[ai][bj][m][0], v1 = acc[ai][bj][m][1];
                    if (pn < 2) { store8(U + (size_t)row * 512 + pn * 256 + bj * 128 + cl, v0, v1); }
                    else if (bj == 0) {
                        f32x4 a0 = acc[ai][1][m][0], a1 = acc[ai][1][m][1]; f32x4 r0, r1, g0, g1;
#pragma unroll
                        for (int j = 0; j < 4; ++j) { a0[j] = fmaxf(a0[j], -30.0f); a1[j] = fmaxf(a1[j], -30.0f); }
#pragma unroll
                        for (int j = 0; j < 4; ++j) { const float ea0 = __builtin_amdgcn_exp2f(-a0[j] * LOG2E), ea1 = __builtin_amdgcn_exp2f(-a1[j] * LOG2E);
                            g0[j] = __builtin_amdgcn_rcpf(1.0f + ea0); g1[j] = __builtin_amdgcn_rcpf(1.0f + ea1);
                            r0[j] = sigmoid_fast(v0[j]) * (1.0f + ea0); r1[j] = sigmoid_fast(v1[j]) * (1.0f + ea1); }
                        store8(GT + (size_t)row * 2048 + (pn - 5) * 128 + cl, r0, r1); store8(GT + (size_t)row * 2048 + 1024 + (pn - 5) * 128 + cl, g0, g1); }
                }
            }
    }
};
__device__ __forceinline__ void load8(const bf16* p, f32x4& a, f32x4& b) { const u32x4 w = *(const u32x4*)p; a = (f32x4){bf_lo(w.x), bf_hi(w.x), bf_lo(w.y), bf_hi(w.y)}; b = (f32x4){bf_lo(w.z), bf_hi(w.z), bf_lo(w.w), bf_hi(w.w)}; }
struct EpiMergeOne {
    static constexpr bool PERM = true; static constexpr bool MID = true;
    const bf16* GT; bf16* G;
    __device__ __forceinline__ void mid(f32x4 (&acc)[2][2][4][2], const Unit& u, int wr, int wc, int fr, int fq) const {
        int rowb = u.pm * 256 + wr * 64 + fr; const int colb = u.pn * 256 + wc * 32 + 8 * fq; asm volatile("" : "+v"(rowb));
        const bf16* gp = GT + (size_t)rowb * 2048 + colb;
        u32x4 g[2][4][2];
#pragma unroll
        for (int ai = 0; ai < 2; ++ai)
#pragma unroll
            for (int m = 0; m < 4; ++m)
#pragma unroll
                for (int bj = 0; bj < 2; ++bj) g[ai][m][bj] = *(const u32x4*)(gp + (size_t)(ai * 128 + m * 16) * 2048 + bj * 128);
#pragma unroll
        for (int ai = 0; ai < 2; ++ai)
#pragma unroll
            for (int m = 0; m < 4; ++m)
#pragma unroll
                for (int bj = 0; bj < 2; ++bj) asm volatile("" : "+v"(g[ai][m][bj]));
#pragma unroll
        for (int ai = 0; ai < 2; ++ai)
#pragma unroll
            for (int m = 0; m < 4; ++m)
#pragma unroll
                for (int bj = 0; bj < 2; ++bj) { const u32x4 w = g[ai][m][bj];
                    acc[ai][bj][m][0] *= (f32x4){bf_lo(w.x), bf_hi(w.x), bf_lo(w.y), bf_hi(w.y)}; acc[ai][bj][m][1] *= (f32x4){bf_lo(w.z), bf_hi(w.z), bf_lo(w.w), bf_hi(w.w)}; }
    }
    __device__ __forceinline__ void operator()(AccRef acc, const Unit& u, int wr, int wc, int fr, int fq) const {
        int rowb = u.pm * 256 + wr * 64 + fr; const int colb = u.pn * 256 + wc * 32 + 8 * fq; asm volatile("" : "+v"(rowb));
        const bf16* gp = GT + (size_t)rowb * 2048 + 1024 + colb;
        u32x4 g[2][4][2];
#pragma unroll
        for (int ai = 0; ai < 2; ++ai)
#pragma unroll
            for (int m = 0; m < 4; ++m)
#pragma unroll
                for (int bj = 0; bj < 2; ++bj) g[ai][m][bj] = *(const u32x4*)(gp + (size_t)(ai * 128 + m * 16) * 2048 + bj * 128);
#pragma unroll
        for (int ai = 0; ai < 2; ++ai)
#pragma unroll
            for (int m = 0; m < 4; ++m)
#pragma unroll
                for (int bj = 0; bj < 2; ++bj) asm volatile("" : "+v"(g[ai][m][bj]));
#pragma unroll
        for (int ai = 0; ai < 2; ++ai)
#pragma unroll
            for (int m = 0; m < 4; ++m) { const int row = rowb + ai * 128 + m * 16;
#pragma unroll
                for (int bj = 0; bj < 2; ++bj) { const int col = colb + bj * 128; const u32x4 w = g[ai][m][bj];
                    const f32x4 g0 = {bf_lo(w.x), bf_hi(w.x), bf_lo(w.y), bf_hi(w.y)}, g1 = {bf_lo(w.z), bf_hi(w.z), bf_lo(w.w), bf_hi(w.w)};
                    store8(G + (size_t)row * D + col, acc[ai][bj][m][0] * g0, acc[ai][bj][m][1] * g1); } }
    }
};
struct EpiGateUp {
    static constexpr bool PERM = true; static constexpr bool MID = false;
    bf16* ACT;
    __device__ __forceinline__ void operator()(AccRef acc, const Unit& u, int wr, int wc, int fr, int fq) const {
        const int rowb = u.pm * 256 + wr * 64 + fr, col = u.pn * 128 + wc * 32 + 8 * fq;
#pragma unroll
        for (int ai = 0; ai < 2; ++ai)
#pragma unroll
            for (int m = 0; m < 4; ++m) {
                const int row = rowb + ai * 128 + m * 16; f32x4 o[2];
#pragma unroll
                for (int n = 0; n < 2; ++n)
#pragma unroll
                    for (int j = 0; j < 4; ++j) { const float g = acc[ai][0][m][n][j]; o[n][j] = g * sigmoid_fast(g) * acc[ai][1][m][n][j]; }
                store8(ACT + (size_t)row * D + col, o[0], o[1]);
            }
    }
};
struct EpiPlainBf16 {
    static constexpr bool PERM = true; static constexpr bool MID = false;
    bf16* O;
    __device__ __forceinline__ void operator()(AccRef acc, const Unit& u, int wr, int wc, int fr, int fq) const {
        const int rowb = u.pm * 256 + wr * 64 + fr, colb = u.pn * 256 + wc * 32 + 8 * fq;
#pragma unroll
        for (int ai = 0; ai < 2; ++ai)
#pragma unroll
            for (int m = 0; m < 4; ++m) {
                const int row = rowb + ai * 128 + m * 16;
#pragma unroll
                for (int bj = 0; bj < 2; ++bj) store8(O + (size_t)row * D + colb + bj * 128, acc[ai][bj][m][0], acc[ai][bj][m][1]);
            }
    }
};

template <int MODE> __device__ __forceinline__ void ctx_gemm(Frame& F, const bf16* A, const bf16* Bt, const bf16* GT, bf16* O) {
    const int lane = F.lane, i16 = lane & 15, kq = lane >> 4;
    const int rg = F.vcu >> 5, cg = F.vcu & 31;
    if (F.vcu >= 256) return;
    const int row = NL + 64 * rg + 16 * (F.wave & 3) + i16, n0 = 32 * cg + 16 * (F.wave >> 2);
    const bf16* ap = A + (size_t)row * D + 8 * kq; const bf16* bp = Bt + (size_t)(n0 + i16) * D + 8 * kq;
    f32x4 acc = {0.f, 0.f, 0.f, 0.f};
#pragma unroll 1
    for (int kb = 0; kb < 4; ++kb) {
        bf16x8 af[8], bfg[8];
#pragma unroll
        for (int s = 0; s < 8; ++s) { af[s] = *(const bf16x8*)(ap + 256 * kb + 32 * s); bfg[s] = *(const bf16x8*)(bp + 256 * kb + 32 * s); }
        if (MODE == 0 && kb == 2) { const int col = n0 + 4 * kq; const u32x2 w = *(const u32x2*)(GT + (size_t)row * 2048 + col);
            acc *= (f32x4){bf_lo(w.x), bf_hi(w.x), bf_lo(w.y), bf_hi(w.y)}; }
#pragma unroll
        for (int s = 0; s < 8; ++s) acc = __builtin_amdgcn_mfma_f32_16x16x32_bf16(bfg[s], af[s], acc, 0, 0, 0);
    }
    const int col = n0 + 4 * kq;
    if (MODE == 0) { const u32x2 w = *(const u32x2*)(GT + (size_t)row * 2048 + 1024 + col); acc *= (f32x4){bf_lo(w.x), bf_hi(w.x), bf_lo(w.y), bf_hi(w.y)}; }
    u32x2 o; o.x = cvt_pk_bf16(acc.x, acc.y); o.y = cvt_pk_bf16(acc.z, acc.w);
    *(u32x2*)(O + (size_t)row * D + col) = o;
}

template <class AT> __device__ __forceinline__ void pool_unit(Frame& F, AT& a, int layer, int rt, int g) {
    LAS float* P = (LAS float*)F.lds;
    const bf16* U = (const bf16*)(F.ws + WS_U);
    const int w = 2 << g;
    __syncthreads();
    { const int r = F.tid >> 3, c16 = (F.tid & 7) * 16; const int row = rt * 64 + r;
      int s0, len, t;
      if (row < NL) { s0 = row & ~(SEQ - 1); len = SEQ; t = row - s0; } else { s0 = NL + ((row - NL) & ~(CTX - 1)); len = CTX; t = row - s0; }
      int lo = t - w / 2, hi = t - w / 2 + w - 1; lo = lo < 0 ? 0 : lo; hi = hi > len - 1 ? len - 1 : hi;
      float sum[16];
#pragma unroll
      for (int j = 0; j < 16; ++j) sum[j] = 0.f;
      for (int tt = lo; tt <= hi; ++tt) { f32x4 x0, x1, x2, x3; const bf16* p = U + (size_t)(s0 + tt) * 512 + g * 128 + c16; load8(p, x0, x1); load8(p + 8, x2, x3);
#pragma unroll
          for (int j = 0; j < 4; ++j) { sum[j] += x0[j]; sum[4 + j] += x1[j]; sum[8 + j] += x2[j]; sum[12 + j] += x3[j]; } }
      const float inv = 1.0f / (float)(hi - lo + 1);
      f32x4 x0, x1, x2, x3; const bf16* p = U + (size_t)row * 512 + g * 128 + c16; load8(p, x0, x1); load8(p + 8, x2, x3);
#pragma unroll
      for (int j = 0; j < 4; ++j) { P[r * 128 + c16 + j] = sum[j] * inv - x0[j]; P[r * 128 + c16 + 4 + j] = sum[4 + j] * inv - x1[j]; P[r * 128 + c16 + 8 + j] = sum[8 + j] * inv - x2[j]; P[r * 128 + c16 + 12 + j] = sum[12 + j] * inv - x3[j]; } }
    __syncthreads();
    { const int d = F.tid & 127, rg = F.tid >> 7;
      const float* Wg = a.in[I_WPG] + ((size_t)(layer * 4 + g) * 128) * 128 + d;
      float acc[16];
#pragma unroll
      for (int j = 0; j < 16; ++j) acc[j] = 0.f;
      for (int c = 0; c < 128; ++c) { const float wv = Wg[(size_t)c * 128];
#pragma unroll
          for (int j = 0; j < 16; ++j) acc[j] += P[(rg * 16 + j) * 128 + c] * wv; }
      const float sc = a.in[I_PSCALE][layer * 512 + g * 128 + d];
      bf16* O = (bf16*)(F.ws + WS_PO);
#pragma unroll
      for (int j = 0; j < 16; ++j) O[(size_t)(rt * 64 + rg * 16 + j) * 1024 + g * 128 + d] = (bf16)(cvt_pk_bf16(acc[j] * sc, 0.f) & 0xffffu); }
}
template <class AT> __device__ __forceinline__ void attn_unit_simple(Frame& F, AT& a, int layer, int qrow0, int qpos0, int g, int lrow0, int jlo, int jhi, int crow0) {
    LAS float* Ks = (LAS float*)F.lds; LAS float* Vs = Ks + 64 * 64;
    const bf16* Q = (const bf16*)(F.ws + WS_Q); const bf16* Kb = (const bf16*)(F.ws + WS_K); const bf16* Vb = (const bf16*)(F.ws + WS_V);
    const int qi = F.tid & 127, r = F.tid >> 7, h = 4 * g + r; const int qrow = qrow0 + qi, qpos = qpos0 + qi;
    float q[64], o[64];
#pragma unroll
    for (int c = 0; c < 8; ++c) { f32x4 x0, x1; load8(Q + (size_t)qrow * 512 + h * 64 + 8 * c, x0, x1);
#pragma unroll
        for (int j = 0; j < 4; ++j) { q[8 * c + j] = x0[j]; q[8 * c + 4 + j] = x1[j]; } }
#pragma unroll
    for (int d = 0; d < 64; ++d) o[d] = 0.f;
    float m = a.in[I_SINK][layer * 8 + h] * LOG2E, l = 1.0f;
    const int nloc = jhi >= jlo ? jhi - jlo + 1 : 0;
    for (int ch = 0; ch < nloc + 4; ++ch) {
        const bool local = ch < nloc; const int j = jlo + ch;
        const int krow0 = local ? lrow0 + 64 * j : crow0 + 64 * (ch - nloc);
        __syncthreads();
        { const int key = F.tid >> 3, d8 = (F.tid & 7) * 8; f32x4 x0, x1;
          load8(Kb + (size_t)(krow0 + key) * 128 + g * 64 + d8, x0, x1); *(LAS f32x4*)(Ks + key * 64 + d8) = x0; *(LAS f32x4*)(Ks + key * 64 + d8 + 4) = x1;
          load8(Vb + (size_t)(krow0 + key) * 128 + g * 64 + d8, x0, x1); *(LAS f32x4*)(Vs + key * 64 + d8) = x0; *(LAS f32x4*)(Vs + key * 64 + d8 + 4) = x1; }
        __syncthreads();
#pragma unroll 1
        for (int kk = 0; kk < 64; ++kk) {
            const LAS float* kr = Ks + kk * 64; float dsum = 0.f;
#pragma unroll
            for (int d = 0; d < 64; d += 4) { const f32x4 kv = *(const LAS f32x4*)(kr + d); dsum += q[d] * kv.x + q[d + 1] * kv.y + q[d + 2] * kv.z + q[d + 3] * kv.w; }
            bool valid = true;
            if (local) { const int kpos = 64 * j + kk; const int df = qpos - kpos; valid = (df <= 128) && (df >= -128); }
            const float sc = valid ? dsum : -INFINITY;
            const float mn = fmaxf(m, sc), al = __builtin_amdgcn_exp2f(m - mn), p = __builtin_amdgcn_exp2f(sc - mn);
            l = l * al + p; m = mn;
            const LAS float* vr = Vs + kk * 64;
#pragma unroll
            for (int d = 0; d < 64; d += 4) { const f32x4 vv = *(const LAS f32x4*)(vr + d); o[d] = o[d] * al + p * vv.x; o[d + 1] = o[d + 1] * al + p * vv.y; o[d + 2] = o[d + 2] * al + p * vv.z; o[d + 3] = o[d + 3] * al + p * vv.w; }
        }
    }
    const float il = 1.0f / l; bf16* O = (bf16*)(F.ws + WS_PO) + (size_t)qrow * 1024 + 512 + h * 64;
#pragma unroll
    for (int c = 0; c < 8; ++c) { f32x4 x0, x1;
#pragma unroll
        for (int j = 0; j < 4; ++j) { x0[j] = o[8 * c + j] * il; x1[j] = o[8 * c + 4 + j] * il; }
        store8(O + 8 * c, x0, x1); }
}
typedef float f32x16 __attribute__((ext_vector_type(16)));
typedef short s16x4 __attribute__((ext_vector_type(4)));
typedef short v4i16_t __attribute__((ext_vector_type(4)));
constexpr int AK_STRIDE = 144, AV_STRIDE = 192, AK_BYTES = 64 * AK_STRIDE, AV_BYTES = 64 * AV_STRIDE, ABUF_BYTES = AK_BYTES + AV_BYTES;
#ifndef ATT_THR
#define ATT_THR 8.0f
#endif
template <class AT> __device__ __forceinline__ void attn_unit_mfma(Frame& F, AT& a, int layer, int qrow0, int qpos0, int g, int lrow0, int jlo, int jhi, int crow0) {
    const bf16* Q = (const bf16*)(F.ws + WS_Q); const bf16* Kb = (const bf16*)(F.ws + WS_K); const bf16* Vb = (const bf16*)(F.ws + WS_V);
    const int lane = F.lane, r32 = lane & 31, hi = lane >> 5, w = F.wave, r = w >> 1, hq = w & 1, h = 4 * g + r;
    bf16x8 qf[2][4];
#pragma unroll
    for (int qt = 0; qt < 2; ++qt)
#pragma unroll
        for (int s = 0; s < 4; ++s) qf[qt][s] = *(const bf16x8*)(Q + (size_t)(qrow0 + 64 * hq + 32 * qt + r32) * 512 + h * 64 + 16 * s + 8 * hi);
    f32x16 O[2][2];
#pragma unroll
    for (int dt = 0; dt < 2; ++dt)
#pragma unroll
        for (int qt = 0; qt < 2; ++qt)
#pragma unroll
            for (int i = 0; i < 16; ++i) O[dt][qt][i] = 0.f;
    const float sink2 = a.in[I_SINK][layer * 8 + h] * LOG2E;
    float m[2] = {sink2, sink2}, l[2]; l[0] = hi == 0 ? 1.0f : 0.0f; l[1] = l[0];
    const int nloc = jhi >= jlo ? jhi - jlo + 1 : 0, NT = nloc + 4;
    const int skey = F.tid >> 3, sc8 = F.tid & 7;
    const int qa = qpos0 + 64 * hq;
    u32x4 kreg, vreg;
    const unsigned lane_off = (unsigned)(skey * 128 + 8 * sc8) * 2u;
    { const int krow = nloc > 0 ? lrow0 + 64 * jlo : crow0;
      kreg = *(const u32x4*)((const char*)(Kb + (size_t)krow * 128 + g * 64) + lane_off); vreg = *(const u32x4*)((const char*)(Vb + (size_t)krow * 128 + g * 64) + lane_off); }
    __syncthreads();
    *(LAS u32x4*)(F.lds + skey * AK_STRIDE + sc8 * 16) = kreg; *(LAS u32x4*)(F.lds + AK_BYTES + skey * AV_STRIDE + sc8 * 16) = vreg;
    __syncthreads();
#pragma unroll 1
    for (int it = 0; it < NT; ++it) {
        const int bo = (it & 1) * ABUF_BYTES;
        if (it + 1 < NT) { const int krow = (it + 1 < nloc) ? lrow0 + 64 * (jlo + it + 1) : crow0 + 64 * (it + 1 - nloc);
            kreg = *(const u32x4*)((const char*)(Kb + (size_t)krow * 128 + g * 64) + lane_off); vreg = *(const u32x4*)((const char*)(Vb + (size_t)krow * 128 + g * 64) + lane_off); }
        int mode = 1; const int ka = 64 * (jlo + it);
        if (it < nloc) { if (ka - (qa + 63) > 128 || qa - (ka + 63) > 128) mode = 0; else if (ka + 63 - qa > 128 || qa + 63 - ka > 128) mode = 2; }
        if (mode != 0) {
            unsigned kbase = (unsigned)bo + (unsigned)(r32 * AK_STRIDE + 16 * hi), vbase = (unsigned)bo + (unsigned)(AK_BYTES + (4 * hi + ((lane & 15) >> 2)) * AV_STRIDE + (16 * ((lane >> 4) & 1) + 4 * (lane & 3)) * 2);
            asm volatile("" : "+v"(kbase), "+v"(vbase));
            const LAS unsigned char* Kl = F.lds + kbase; const LAS unsigned char* Vl = F.lds + vbase;
#define ATT_VLOAD(dst, kt_) do { _Pragma("unroll") for (int s2 = 0; s2 < 2; ++s2) _Pragma("unroll") for (int dt = 0; dt < 2; ++dt) { \
                const LAS unsigned char* vp = Vl + (32 * (kt_) + 16 * s2) * AV_STRIDE + (32 * dt) * 2; \
                const s16x4 lo = __builtin_bit_cast(s16x4, __builtin_amdgcn_ds_read_tr16_b64_v4i16((LAS v4i16_t*)vp)); \
                const s16x4 hh = __builtin_bit_cast(s16x4, __builtin_amdgcn_ds_read_tr16_b64_v4i16((LAS v4i16_t*)(vp + 8 * AV_STRIDE))); \
                dst[s2][dt] = (bf16x8){lo[0], lo[1], lo[2], lo[3], hh[0], hh[1], hh[2], hh[3]}; } } while (0)
#pragma unroll
            for (int qt = 0; qt < 2; ++qt) {
                f32x16 S0, S1;
#pragma unroll
                for (int i = 0; i < 16; ++i) { S0[i] = 0.f; S1[i] = 0.f; }
                { bf16x8 ka[4], kb[4];
#pragma unroll
                  for (int s = 0; s < 4; ++s) ka[s] = *(const LAS bf16x8*)(Kl + 32 * s);
#pragma unroll
                  for (int s = 0; s < 4; ++s) asm volatile("" : "+v"(ka[s]));
#pragma unroll
                  for (int s = 0; s < 4; ++s) kb[s] = *(const LAS bf16x8*)(Kl + 32 * AK_STRIDE + 32 * s);
#pragma unroll
                  for (int s = 0; s < 4; ++s) S0 = __builtin_amdgcn_mfma_f32_32x32x16_bf16(ka[s], qf[qt][s], S0, 0, 0, 0);
#pragma unroll
                  for (int s = 0; s < 4; ++s) asm volatile("" : "+v"(kb[s]));
#pragma unroll
                  for (int s = 0; s < 4; ++s) S1 = __builtin_amdgcn_mfma_f32_32x32x16_bf16(kb[s], qf[qt][s], S1, 0, 0, 0); }
                if (mode == 2) { const int qp = qa + 32 * qt + r32;
#pragma unroll
                    for (int i = 0; i < 16; ++i) { const int kp = ka + (i & 3) + 8 * (i >> 2) + 4 * hi; const int d0 = qp - kp, d1 = d0 - 32;
                        if (d0 > 128 || d0 < -128) S0[i] = -INFINITY; if (d1 > 128 || d1 < -128) S1[i] = -INFINITY; } }
                float ta = fmaxf(fmaxf(S0[0], S0[1]), S0[2]), tb = fmaxf(fmaxf(S1[0], S1[1]), S1[2]);
#pragma unroll
                for (int i = 3; i < 15; i += 2) { ta = fmaxf(fmaxf(ta, S0[i]), S0[i + 1]); tb = fmaxf(fmaxf(tb, S1[i]), S1[i + 1]); }
                float tmax = fmaxf(fmaxf(ta, tb), fmaxf(S0[15], S1[15]));
                tmax = fmaxf(tmax, __shfl_xor(tmax, 32));
                if (__any(tmax > m[qt] + ATT_THR)) {
                    const float mn = fmaxf(m[qt], tmax), al = __builtin_amdgcn_exp2f(m[qt] - mn);
                    l[qt] *= al; m[qt] = mn;
#pragma unroll
                    for (int i = 0; i < 16; ++i) { O[0][qt][i] *= al; O[1][qt][i] *= al; }
                }
                const float mm = m[qt]; const f32x2 nm2 = {-mm, -mm}; f32x2 ls2 = {0.f, 0.f};
#pragma unroll
                for (int i = 0; i < 16; i += 2) {
                    f32x2 a0 = (f32x2){S0[i], S0[i + 1]} + nm2, a1 = (f32x2){S1[i], S1[i + 1]} + nm2;
                    a0.x = __builtin_amdgcn_exp2f(a0.x); a0.y = __builtin_amdgcn_exp2f(a0.y); a1.x = __builtin_amdgcn_exp2f(a1.x); a1.y = __builtin_amdgcn_exp2f(a1.y);
                    S0[i] = a0.x; S0[i + 1] = a0.y; S1[i] = a1.x; S1[i + 1] = a1.y; ls2 += a0; ls2 += a1; }
                l[qt] += ls2.x + ls2.y;
                bf16x8 pf[2][2];
#pragma unroll
                for (int s2 = 0; s2 < 2; ++s2) {
                    u32x4 p0, p1;
                    p0.x = cvt_pk_bf16(S0[8 * s2 + 0], S0[8 * s2 + 1]); p0.y = cvt_pk_bf16(S0[8 * s2 + 2], S0[8 * s2 + 3]); p0.z = cvt_pk_bf16(S0[8 * s2 + 4], S0[8 * s2 + 5]); p0.w = cvt_pk_bf16(S0[8 * s2 + 6], S0[8 * s2 + 7]);
                    p1.x = cvt_pk_bf16(S1[8 * s2 + 0], S1[8 * s2 + 1]); p1.y = cvt_pk_bf16(S1[8 * s2 + 2], S1[8 * s2 + 3]); p1.z = cvt_pk_bf16(S1[8 * s2 + 4], S1[8 * s2 + 5]); p1.w = cvt_pk_bf16(S1[8 * s2 + 6], S1[8 * s2 + 7]);
                    pf[0][s2] = __builtin_bit_cast(bf16x8, p0); pf[1][s2] = __builtin_bit_cast(bf16x8, p1);
                }
                { bf16x8 g0[2], g1[2], g2[2], g3[2];
#define ATT_VG(dst, kt_, s2_) do { _Pragma("unroll") for (int dt = 0; dt < 2; ++dt) { \
                const LAS unsigned char* vp = Vl + (32 * (kt_) + 16 * (s2_)) * AV_STRIDE + (32 * dt) * 2; \
                const s16x4 lo = __builtin_bit_cast(s16x4, __builtin_amdgcn_ds_read_tr16_b64_v4i16((LAS v4i16_t*)vp)); \
                const s16x4 hh = __builtin_bit_cast(s16x4, __builtin_amdgcn_ds_read_tr16_b64_v4i16((LAS v4i16_t*)(vp + 8 * AV_STRIDE))); \
                dst[dt] = (bf16x8){lo[0], lo[1], lo[2], lo[3], hh[0], hh[1], hh[2], hh[3]}; } } while (0)
#define ATT_PIN2(x) asm volatile("" : "+v"(x[0]), "+v"(x[1]))
#define ATT_PV(x, kt_, s2_) do { O[0][qt] = __builtin_amdgcn_mfma_f32_32x32x16_bf16(x[0], pf[kt_][s2_], O[0][qt], 0, 0, 0); O[1][qt] = __builtin_amdgcn_mfma_f32_32x32x16_bf16(x[1], pf[kt_][s2_], O[1][qt], 0, 0, 0); } while (0)
                  ATT_VG(g0, 0, 0); ATT_VG(g1, 0, 1); ATT_PIN2(g0); ATT_PV(g0, 0, 0);
                  ATT_VG(g2, 1, 0); ATT_PIN2(g1); ATT_PV(g1, 0, 1);
                  ATT_VG(g3, 1, 1); ATT_PIN2(g2); ATT_PV(g2, 1, 0);
                  ATT_PIN2(g3); ATT_PV(g3, 1, 1); }
            }
        }
        if (it + 1 < NT) { const int bn = ((it + 1) & 1) * ABUF_BYTES;
            *(LAS u32x4*)(F.lds + bn + skey * AK_STRIDE + sc8 * 16) = kreg; *(LAS u32x4*)(F.lds + bn + AK_BYTES + skey * AV_STRIDE + sc8 * 16) = vreg; }
        __syncthreads();
    }
#pragma unroll
    for (int qt = 0; qt < 2; ++qt) {
        const float lt = l[qt] + __shfl_xor(l[qt], 32), il = 1.0f / lt;
        bf16* Op = (bf16*)(F.ws + WS_PO) + (size_t)(qrow0 + 64 * hq + 32 * qt + r32) * 1024 + 512 + h * 64;
#pragma unroll
        for (int dt = 0; dt < 2; ++dt)
#pragma unroll
            for (int g4 = 0; g4 < 4; ++g4) { u32x2 wv; wv.x = cvt_pk_bf16(O[dt][qt][4 * g4] * il, O[dt][qt][4 * g4 + 1] * il); wv.y = cvt_pk_bf16(O[dt][qt][4 * g4 + 2] * il, O[dt][qt][4 * g4 + 3] * il);
                *(u32x2*)(Op + 32 * dt + 8 * g4 + 4 * hi) = wv; }
    }
}
constexpr int PL_STRIDE = 272;
constexpr int PL_UT = 0, PL_PT = 24576;
template <int W, class AT> __device__ __forceinline__ void pool_units_mfma(Frame& F, AT& a, int layer, int u0, int ustride, int n_units) {
    if (u0 >= n_units) return;
    const bf16* U = (const bf16*)(F.ws + WS_U);
    const int g = u0 & 3; constexpr int w = W;
    const int lane = F.lane, i16 = lane & 15, kq = lane >> 4, rt4 = F.wave & 3, ch = F.wave >> 2;
    const bf16* Wt = (const bf16*)(F.ws + WS_WPG) + (size_t)(layer * 4 + g) * 128 * 128;
    bf16x8 wb[4][4];
#pragma unroll
    for (int ks = 0; ks < 4; ++ks)
#pragma unroll
        for (int ct = 0; ct < 4; ++ct) wb[ks][ct] = *(const bf16x8*)(Wt + (size_t)(64 * ch + 16 * ct + i16) * 128 + 32 * ks + 8 * kq);
    f32x4 scv[4];
#pragma unroll
    for (int ct = 0; ct < 4; ++ct) scv[ct] = *(const f32x4*)(a.in[I_PSCALE] + layer * 512 + g * 128 + 64 * ch + 16 * ct + 4 * kq);
    u32x4 st[3];
    auto stage_load = [&](int u) {
        const int row0 = (u >> 2) * 64; int s0, len;
        if (row0 < NL) { s0 = row0 & ~(SEQ - 1); len = SEQ; } else { s0 = NL + ((row0 - NL) & ~(CTX - 1)); len = CTX; }
        const int t0 = row0 - s0;
#pragma unroll
        for (int i = 0; i < 3; ++i) { const int idx = F.tid + 512 * i, rr = idx >> 4, cc = idx & 15; const int t = t0 - 8 + rr;
            st[i] = (u32x4){0u, 0u, 0u, 0u};
            if (idx < 1280 && t >= 0 && t < len) st[i] = *(const u32x4*)(U + (size_t)(s0 + t) * 512 + g * 128 + 8 * cc); }
    };
    stage_load(u0);
    for (int u = u0; u < n_units; u += ustride) {
        const int row0 = (u >> 2) * 64; int s0, len;
        if (row0 < NL) { s0 = row0 & ~(SEQ - 1); len = SEQ; } else { s0 = NL + ((row0 - NL) & ~(CTX - 1)); len = CTX; }
        const int t0 = row0 - s0;
        __syncthreads();
#pragma unroll
        for (int i = 0; i < 3; ++i) { const int idx = F.tid + 512 * i, rr = idx >> 4, cc = idx & 15; if (idx < 1280) *(LAS u32x4*)(F.lds + PL_UT + rr * PL_STRIDE + cc * 16) = st[i]; }
        if (u + ustride < n_units) stage_load(u + ustride);
        __syncthreads();
        { const int r = F.tid >> 3, c16 = (F.tid & 7) * 16; const int t = t0 + r;
          int lo = t - w / 2, hi = t - w / 2 + w - 1; lo = lo < 0 ? 0 : lo; hi = hi > len - 1 ? len - 1 : hi;
          f32x4 sm[4];
#pragma unroll
          for (int j = 0; j < 4; ++j) sm[j] = (f32x4){0.f, 0.f, 0.f, 0.f};
#pragma unroll
          for (int i = 0; i < W; ++i) { const int tt = t - W / 2 + i; const bool ok = tt >= lo && tt <= hi; const int tc = tt < lo ? lo : (tt > hi ? hi : tt); const float wt = ok ? 1.0f : 0.0f;
              const LAS unsigned char* p = F.lds + PL_UT + (tc - t0 + 8) * PL_STRIDE + c16 * 2;
              const u32x4 w0 = *(const LAS u32x4*)p, w1 = *(const LAS u32x4*)(p + 16);
              sm[0] += (f32x4){bf_lo(w0.x), bf_hi(w0.x), bf_lo(w0.y), bf_hi(w0.y)} * wt; sm[1] += (f32x4){bf_lo(w0.z), bf_hi(w0.z), bf_lo(w0.w), bf_hi(w0.w)} * wt;
              sm[2] += (f32x4){bf_lo(w1.x), bf_hi(w1.x), bf_lo(w1.y), bf_hi(w1.y)} * wt; sm[3] += (f32x4){bf_lo(w1.z), bf_hi(w1.z), bf_lo(w1.w), bf_hi(w1.w)} * wt; }
          const float inv = 1.0f / (float)(hi - lo + 1);
          { const LAS unsigned char* p = F.lds + PL_UT + (r + 8) * PL_STRIDE + c16 * 2; const u32x4 w0 = *(const LAS u32x4*)p, w1 = *(const LAS u32x4*)(p + 16);
            sm[0] = sm[0] * inv - (f32x4){bf_lo(w0.x), bf_hi(w0.x), bf_lo(w0.y), bf_hi(w0.y)}; sm[1] = sm[1] * inv - (f32x4){bf_lo(w0.z), bf_hi(w0.z), bf_lo(w0.w), bf_hi(w0.w)};
            sm[2] = sm[2] * inv - (f32x4){bf_lo(w1.x), bf_hi(w1.x), bf_lo(w1.y), bf_hi(w1.y)}; sm[3] = sm[3] * inv - (f32x4){bf_lo(w1.z), bf_hi(w1.z), bf_lo(w1.w), bf_hi(w1.w)}; }
          u32x4 o0, o1; o0.x = cvt_pk_bf16(sm[0].x, sm[0].y); o0.y = cvt_pk_bf16(sm[0].z, sm[0].w); o0.z = cvt_pk_bf16(sm[1].x, sm[1].y); o0.w = cvt_pk_bf16(sm[1].z, sm[1].w);
          o1.x = cvt_pk_bf16(sm[2].x, sm[2].y); o1.y = cvt_pk_bf16(sm[2].z, sm[2].w); o1.z = cvt_pk_bf16(sm[3].x, sm[3].y); o1.w = cvt_pk_bf16(sm[3].z, sm[3].w);
          *(LAS u32x4*)(F.lds + PL_PT + r * PL_STRIDE + c16 * 2) = o0; *(LAS u32x4*)(F.lds + PL_PT + r * PL_STRIDE + c16 * 2 + 16) = o1; }
        __syncthreads();
        { f32x4 acc[4];
#pragma unroll
          for (int ct = 0; ct < 4; ++ct) acc[ct] = (f32x4){0.f, 0.f, 0.f, 0.f};
#pragma unroll
          for (int ks = 0; ks < 4; ++ks) {
              const bf16x8 pa = *(const LAS bf16x8*)(F.lds + PL_PT + (16 * rt4 + i16) * PL_STRIDE + (32 * ks + 8 * kq) * 2);
#pragma unroll
              for (int ct = 0; ct < 4; ++ct) acc[ct] = __builtin_amdgcn_mfma_f32_16x16x32_bf16(wb[ks][ct], pa, acc[ct], 0, 0, 0);
          }
          const int row = row0 + 16 * rt4 + i16; bf16* O = (bf16*)(F.ws + WS_PO) + (size_t)row * 1024 + g * 128;
#pragma unroll
          for (int ct = 0; ct < 4; ++ct) { const int d = 64 * ch + 16 * ct + 4 * kq;
              u32x2 wv; wv.x = cvt_pk_bf16(acc[ct].x * scv[ct].x, acc[ct].y * scv[ct].y); wv.y = cvt_pk_bf16(acc[ct].z * scv[ct].z, acc[ct].w * scv[ct].w); *(u32x2*)(O + d) = wv; }
        }
    }
}
template <class AT> __device__ __forceinline__ void attn_unit_v2(Frame& F, AT& a, int layer, int qrow0, int qpos0, int g, int lrow0, int jlo, int jhi, int crow0) {
    const bf16* Q = (const bf16*)(F.ws + WS_Q); const bf16* Kb = (const bf16*)(F.ws + WS_K); const bf16* Vb = (const bf16*)(F.ws + WS_V);
    const int lane = F.lane, r32 = lane & 31, hi = lane >> 5, w = F.wave, r = w >> 1, qh = w & 1, h = 4 * g + r;
    bf16x8 qf[4];
#pragma unroll
    for (int s = 0; s < 4; ++s) qf[s] = *(const bf16x8*)(Q + (size_t)(qrow0 + 32 * qh + r32) * 512 + h * 64 + 16 * s + 8 * hi);
    f32x16 O0, O1;
#pragma unroll
    for (int i = 0; i < 16; ++i) { O0[i] = 0.f; O1[i] = 0.f; }
    const float sink2 = a.in[I_SINK][layer * 8 + h] * LOG2E;
    float m = sink2, l = hi == 0 ? 1.0f : 0.0f;
    const int nloc = jhi >= jlo ? jhi - jlo + 1 : 0, NT = nloc + 4;
    const int skey = F.tid >> 3, sc8 = F.tid & 7;
    const int qa = qpos0 + 32 * qh;
    const unsigned lane_off = (unsigned)(skey * 128 + 8 * sc8) * 2u;
    const unsigned st_k = (unsigned)(skey * AK_STRIDE + sc8 * 16), st_v = (unsigned)(AK_BYTES + skey * AV_STRIDE + sc8 * 16);
    const unsigned kb0 = (unsigned)(r32 * AK_STRIDE + 16 * hi), vb0 = (unsigned)(AK_BYTES + (4 * hi + ((lane & 15) >> 2)) * AV_STRIDE + (16 * ((lane >> 4) & 1) + 4 * (lane & 3)) * 2);
#define A2_KROW(it_) (((it_) < nloc) ? lrow0 + 64 * (jlo + (it_)) : crow0 + 64 * ((it_) - nloc))
#define A2_GLOAD(kr_, vr_, it_) do { const int krow_ = A2_KROW(it_); kr_ = *(const u32x4*)((const char*)(Kb + (size_t)krow_ * 128 + g * 64) + lane_off); vr_ = *(const u32x4*)((const char*)(Vb + (size_t)krow_ * 128 + g * 64) + lane_off); } while (0)
#define A2_QK(S0_, S1_, bo_) do { unsigned kbase_ = (unsigned)(bo_) + kb0; asm volatile("" : "+v"(kbase_)); const LAS unsigned char* Kl_ = F.lds + kbase_; bf16x8 ka_[4], kb_[4]; \
        _Pragma("unroll") for (int i_ = 0; i_ < 16; ++i_) { S0_[i_] = 0.f; S1_[i_] = 0.f; } \
        _Pragma("unroll") for (int s_ = 0; s_ < 4; ++s_) ka_[s_] = *(const LAS bf16x8*)(Kl_ + 32 * s_); \
        _Pragma("unroll") for (int s_ = 0; s_ < 4; ++s_) asm volatile("" : "+v"(ka_[s_])); \
        _Pragma("unroll") for (int s_ = 0; s_ < 4; ++s_) kb_[s_] = *(const LAS bf16x8*)(Kl_ + 32 * AK_STRIDE + 32 * s_); \
        _Pragma("unroll") for (int s_ = 0; s_ < 4; ++s_) S0_ = __builtin_amdgcn_mfma_f32_32x32x16_bf16(ka_[s_], qf[s_], S0_, 0, 0, 0); \
        _Pragma("unroll") for (int s_ = 0; s_ < 4; ++s_) asm volatile("" : "+v"(kb_[s_])); \
        _Pragma("unroll") for (int s_ = 0; s_ < 4; ++s_) S1_ = __builtin_amdgcn_mfma_f32_32x32x16_bf16(kb_[s_], qf[s_], S1_, 0, 0, 0); } while (0)
    u32x4 kreg, vreg, kreg1, vreg1;
    A2_GLOAD(kreg, vreg, 0); A2_GLOAD(kreg1, vreg1, 1);
    __syncthreads();
    *(LAS u32x4*)(F.lds + st_k) = kreg; *(LAS u32x4*)(F.lds + st_v) = vreg;
    *(LAS u32x4*)(F.lds + ABUF_BYTES + st_k) = kreg1; *(LAS u32x4*)(F.lds + ABUF_BYTES + st_v) = vreg1;
    __syncthreads();
    f32x16 SA0, SA1, SB0, SB1;
    A2_QK(SA0, SA1, 0);
    int bcur = 0, bnx = ABUF_BYTES, bst = 2 * ABUF_BYTES;
#define A2_STEP(C0_, C1_, N0_, N1_, t_) do { \
        const bool more2_ = (t_) + 2 < NT; \
        if (more2_) A2_GLOAD(kreg, vreg, (t_) + 2); \
        if ((t_) + 1 < NT) { A2_QK(N0_, N1_, bnx); } \
        __builtin_amdgcn_sched_barrier(0); \
        { const int ka_t = 64 * (jlo + (t_)); \
          if ((t_) < nloc && (ka_t + 63 - qa > 128 || qa + 31 - ka_t > 128)) { const int qp_ = qa + r32; \
              _Pragma("unroll") for (int i_ = 0; i_ < 16; ++i_) { const int kp_ = ka_t + (i_ & 3) + 8 * (i_ >> 2) + 4 * hi; const int d0_ = qp_ - kp_, d1_ = d0_ - 32; \
                  if (d0_ > 128 || d0_ < -128) C0_[i_] = -INFINITY; if (d1_ > 128 || d1_ < -128) C1_[i_] = -INFINITY; } } } \
        float ta_ = fmaxf(fmaxf(C0_[0], C0_[1]), C0_[2]), tb_ = fmaxf(fmaxf(C1_[0], C1_[1]), C1_[2]); \
        _Pragma("unroll") for (int i_ = 3; i_ < 15; i_ += 2) { ta_ = fmaxf(fmaxf(ta_, C0_[i_]), C0_[i_ + 1]); tb_ = fmaxf(fmaxf(tb_, C1_[i_]), C1_[i_ + 1]); } \
        float tmax_ = fmaxf(fmaxf(ta_, tb_), fmaxf(C0_[15], C1_[15])); \
        tmax_ = fmaxf(tmax_, __shfl_xor(tmax_, 32)); \
        if (__any(tmax_ > m + ATT_THR)) { const float mn_ = fmaxf(m, tmax_), al_ = __builtin_amdgcn_exp2f(m - mn_); l *= al_; m = mn_; \
            _Pragma("unroll") for (int i_ = 0; i_ < 16; ++i_) { O0[i_] *= al_; O1[i_] *= al_; } } \
        { const f32x2 nm2_ = {-m, -m}; f32x2 ls2_ = {0.f, 0.f}; \
          _Pragma("unroll") for (int i_ = 0; i_ < 16; i_ += 2) { f32x2 a0_ = (f32x2){C0_[i_], C0_[i_ + 1]} + nm2_, a1_ = (f32x2){C1_[i_], C1_[i_ + 1]} + nm2_; \
              a0_.x = __builtin_amdgcn_exp2f(a0_.x); a0_.y = __builtin_amdgcn_exp2f(a0_.y); a1_.x = __builtin_amdgcn_exp2f(a1_.x); a1_.y = __builtin_amdgcn_exp2f(a1_.y); \
              C0_[i_] = a0_.x; C0_[i_ + 1] = a0_.y; C1_[i_] = a1_.x; C1_[i_ + 1] = a1_.y; ls2_ += a0_; ls2_ += a1_; } \
          l += ls2_.x + ls2_.y; } \
        bf16x8 pf_[2][2]; \
        _Pragma("unroll") for (int s2_ = 0; s2_ < 2; ++s2_) { u32x4 p0_, p1_; \
            p0_.x = cvt_pk_bf16(C0_[8 * s2_ + 0], C0_[8 * s2_ + 1]); p0_.y = cvt_pk_bf16(C0_[8 * s2_ + 2], C0_[8 * s2_ + 3]); p0_.z = cvt_pk_bf16(C0_[8 * s2_ + 4], C0_[8 * s2_ + 5]); p0_.w = cvt_pk_bf16(C0_[8 * s2_ + 6], C0_[8 * s2_ + 7]); \
            p1_.x = cvt_pk_bf16(C1_[8 * s2_ + 0], C1_[8 * s2_ + 1]); p1_.y = cvt_pk_bf16(C1_[8 * s2_ + 2], C1_[8 * s2_ + 3]); p1_.z = cvt_pk_bf16(C1_[8 * s2_ + 4], C1_[8 * s2_ + 5]); p1_.w = cvt_pk_bf16(C1_[8 * s2_ + 6], C1_[8 * s2_ + 7]); \
            pf_[0][s2_] = __builtin_bit_cast(bf16x8, p0_); pf_[1][s2_] = __builtin_bit_cast(bf16x8, p1_); } \
        { unsigned vbase_ = (unsigned)bcur + vb0; asm volatile("" : "+v"(vbase_)); const LAS unsigned char* Vl_ = F.lds + vbase_; bf16x8 g0_[2], g1_[2], g2_[2], g3_[2]; \
          A2_VG(g0_, 0, 0); A2_VG(g1_, 0, 1); A2_PIN2(g0_); A2_PV(g0_, 0, 0); \
          A2_VG(g2_, 1, 0); A2_PIN2(g1_); A2_PV(g1_, 0, 1); \
          A2_VG(g3_, 1, 1); A2_PIN2(g2_); A2_PV(g2_, 1, 0); \
          A2_PIN2(g3_); A2_PV(g3_, 1, 1); } \
        if (more2_) { *(LAS u32x4*)(F.lds + bst + st_k) = kreg; *(LAS u32x4*)(F.lds + bst + st_v) = vreg; } \
        __syncthreads(); \
        { const int tmp_ = bcur; bcur = bnx; bnx = bst; bst = tmp_; } } while (0)
#define A2_VG(dst, kt_, s2_) do { _Pragma("unroll") for (int dt_ = 0; dt_ < 2; ++dt_) { \
        const LAS unsigned char* vp_ = Vl_ + (32 * (kt_) + 16 * (s2_)) * AV_STRIDE + (32 * dt_) * 2; \
        const s16x4 lo_ = __builtin_bit_cast(s16x4, __builtin_amdgcn_ds_read_tr16_b64_v4i16((LAS v4i16_t*)vp_)); \
        const s16x4 hh_ = __builtin_bit_cast(s16x4, __builtin_amdgcn_ds_read_tr16_b64_v4i16((LAS v4i16_t*)(vp_ + 8 * AV_STRIDE))); \
        dst[dt_] = (bf16x8){lo_[0], lo_[1], lo_[2], lo_[3], hh_[0], hh_[1], hh_[2], hh_[3]}; } } while (0)
#define A2_PIN2(x) asm volatile("" : "+v"(x[0]), "+v"(x[1]))
#define A2_PV(x, kt_, s2_) do { O0 = __builtin_amdgcn_mfma_f32_32x32x16_bf16(x[0], pf_[kt_][s2_], O0, 0, 0, 0); O1 = __builtin_amdgcn_mfma_f32_32x32x16_bf16(x[1], pf_[kt_][s2_], O1, 0, 0, 0); } while (0)
#pragma unroll 1
    for (int t = 0; t < NT; t += 2) {
        A2_STEP(SA0, SA1, SB0, SB1, t);
        if (t + 1 < NT) A2_STEP(SB0, SB1, SA0, SA1, t + 1);
    }
#undef A2_KROW
#undef A2_GLOAD
#undef A2_QK
#undef A2_STEP
#undef A2_VG
#undef A2_PIN2
#undef A2_PV
    { const float lt = l + __shfl_xor(l, 32), il = 1.0f / lt;
      bf16* Op = (bf16*)(F.ws + WS_PO) + (size_t)(qrow0 + 32 * qh + r32) * 1024 + 512 + h * 64;
#pragma unroll
      for (int g4 = 0; g4 < 4; ++g4) { u32x2 wv; wv.x = cvt_pk_bf16(O0[4 * g4] * il, O0[4 * g4 + 1] * il); wv.y = cvt_pk_bf16(O0[4 * g4 + 2] * il, O0[4 * g4 + 3] * il); *(u32x2*)(Op + 8 * g4 + 4 * hi) = wv; }
#pragma unroll
      for (int g4 = 0; g4 < 4; ++g4) { u32x2 wv; wv.x = cvt_pk_bf16(O1[4 * g4] * il, O1[4 * g4 + 1] * il); wv.y = cvt_pk_bf16(O1[4 * g4 + 2] * il, O1[4 * g4 + 3] * il); *(u32x2*)(Op + 32 + 8 * g4 + 4 * hi) = wv; } }
}
constexpr int PW_BYTES = 12800, PW_PT = 8192;
template <int W, class AT> __device__ __forceinline__ void pool_wave(Frame& F, AT& a, int layer, int u0, int ustride, int n_units) {
    if (u0 >= n_units) return;
    const bf16* U = (const bf16*)(F.ws + WS_U);
    const int g = u0 & 3, ch = (u0 >> 2) & 1; constexpr int w = W;
    const int lane = F.lane, i16 = lane & 15, kq = lane >> 4;
    LAS unsigned char* UT = F.lds + F.wave * PW_BYTES; LAS unsigned char* PT = UT + PW_PT;
    const bf16* Wt = (const bf16*)(F.ws + WS_WPG) + (size_t)(layer * 4 + g) * 128 * 128;
    bf16x8 wb[4][4];
#pragma unroll
    for (int ks = 0; ks < 4; ++ks)
#pragma unroll
        for (int ct = 0; ct < 4; ++ct) wb[ks][ct] = *(const bf16x8*)(Wt + (size_t)(64 * ch + 16 * ct + i16) * 128 + 32 * ks + 8 * kq);
    f32x4 scv[4];
#pragma unroll
    for (int ct = 0; ct < 4; ++ct) scv[ct] = *(const f32x4*)(a.in[I_PSCALE] + layer * 512 + g * 128 + 64 * ch + 16 * ct + 4 * kq);
    u32x4 st[8];
    auto stage_load = [&](int u) {
        const int row0 = (u >> 3) * 16; int s0, len;
        if (row0 < NL) { s0 = row0 & ~(SEQ - 1); len = SEQ; } else { s0 = NL + ((row0 - NL) & ~(CTX - 1)); len = CTX; }
        const int t0 = row0 - s0;
#pragma unroll
        for (int i = 0; i < 8; ++i) { const int idx = lane + 64 * i, rr = idx >> 4, cc = idx & 15; const int t = t0 - 8 + rr;
            st[i] = (u32x4){0u, 0u, 0u, 0u};
            if (t >= 0 && t < len) st[i] = *(const u32x4*)(U + (size_t)(s0 + t) * 512 + g * 128 + 8 * cc); }
    };
    stage_load(u0);
    for (int u = u0; u < n_units; u += ustride) {
        const int row0 = (u >> 3) * 16; int s0, len;
        if (row0 < NL) { s0 = row0 & ~(SEQ - 1); len = SEQ; } else { s0 = NL + ((row0 - NL) & ~(CTX - 1)); len = CTX; }
        const int t0 = row0 - s0;
#pragma unroll
        for (int i = 0; i < 8; ++i) { const int idx = lane + 64 * i; *(LAS u32x4*)(UT + (idx >> 4) * 256 + (idx & 15) * 16) = st[i]; }
        if (u + ustride < n_units) stage_load(u + ustride);
        __builtin_amdgcn_sched_barrier(0);
        LDS_WAIT();
        { const LAS unsigned char* up = UT + 4 * lane;
          unsigned uv[32];
#pragma unroll
          for (int r = 0; r < 32; ++r) uv[r] = *(const LAS unsigned*)(up + r * 256);
          float sa = 0.f, sb = 0.f;
#pragma unroll
          for (int i = 0; i < W; ++i) { sa += bf_lo(uv[8 - W / 2 + i]); sb += bf_hi(uv[8 - W / 2 + i]); }
#pragma unroll
          for (int r = 0; r < 16; ++r) {
              if (r > 0) { sa += bf_lo(uv[8 - W / 2 + W - 1 + r]) - bf_lo(uv[8 - W / 2 + r - 1]); sb += bf_hi(uv[8 - W / 2 + W - 1 + r]) - bf_hi(uv[8 - W / 2 + r - 1]); }
              const int t = t0 + r; int lo = t - W / 2, hi = t - W / 2 + W - 1; lo = lo < 0 ? 0 : lo; hi = hi > len - 1 ? len - 1 : hi;
              const float inv = 1.0f / (float)(hi - lo + 1);
              *(LAS unsigned*)(PT + r * PL_STRIDE + 4 * lane) = cvt_pk_bf16(sa * inv - bf_lo(uv[r + 8]), sb * inv - bf_hi(uv[r + 8]));
          } }
        LDS_WAIT(); asm volatile("" ::: "memory");
        { f32x4 acc[4];
#pragma unroll
          for (int ct = 0; ct < 4; ++ct) acc[ct] = (f32x4){0.f, 0.f, 0.f, 0.f};
          bf16x8 pa[4];
#pragma unroll
          for (int ks = 0; ks < 4; ++ks) pa[ks] = *(const LAS bf16x8*)(PT + i16 * PL_STRIDE + (32 * ks + 8 * kq) * 2);
#pragma unroll
          for (int ks = 0; ks < 4; ++ks)
#pragma unroll
              for (int ct = 0; ct < 4; ++ct) acc[ct] = __builtin_amdgcn_mfma_f32_16x16x32_bf16(wb[ks][ct], pa[ks], acc[ct], 0, 0, 0);
          const int row = row0 + i16; bf16* O = (bf16*)(F.ws + WS_PO) + (size_t)row * 1024 + g * 128;
#pragma unroll
          for (int ct = 0; ct < 4; ++ct) { const int d = 64 * ch + 16 * ct + 4 * kq;
              u32x2 wv; wv.x = cvt_pk_bf16(acc[ct].x * scv[ct].x, acc[ct].y * scv[ct].y); wv.y = cvt_pk_bf16(acc[ct].z * scv[ct].z, acc[ct].w * scv[ct].w); *(u32x2*)(O + d) = wv; }
        }
        LDS_WAIT(); asm volatile("" ::: "memory");
    }
}
#ifndef MIX_SIMPLE
#define MIX_SIMPLE 0
#endif
template <class AT> __device__ __forceinline__ void phase_mix(Frame& F, AT& a, int layer) {
#ifndef MIX_DUP
#define MIX_DUP 0
#endif
#ifndef ATT_V2
#define ATT_V2 1
#endif
#if ATT_V2
    { const int n_lat = 1024, n_ctx = layer == 0 ? 16 : 0;
      for (int u = F.vcu; u < n_lat + n_ctx; u += F.G) {
          if (u < n_lat) { const int b = u >> 9, mm = (u & 511) >> 1, g = u & 1;
              int jlo = mm - 2, jhi = mm + 2; jlo = jlo < 0 ? 0 : jlo; jhi = jhi > 255 ? 255 : jhi;
              attn_unit_v2(F, a, layer, b * SEQ + 64 * mm, 64 * mm, g, b * SEQ, jlo, jhi, NL + b * CTX);
          } else { const int v = u - n_lat, b = v >> 3, g = (v >> 2) & 1, cb = v & 3;
              attn_unit_v2(F, a, layer, NL + b * CTX + 64 * cb, 0, g, 0, 0, -1, NL + b * CTX); }
      } }
#else
    const int n_lat = 512, n_ctx = layer == 0 ? 8 : 0;
    for (int rep = 0; rep < ((MIX_DUP & 1) ? 2 : 1); ++rep)
    for (int u = F.vcu; u < n_lat + n_ctx; u += F.G) {
        if (u < n_lat) { const int b = u >> 8, n = (u & 255) >> 1, g = u & 1;
            int jlo = 2 * n - 2, jhi = 2 * n + 3; jlo = jlo < 0 ? 0 : jlo; jhi = jhi > 255 ? 255 : jhi;
            if (MIX_SIMPLE & 1) attn_unit_simple(F, a, layer, b * SEQ + 128 * n, 128 * n, g, b * SEQ, jlo, jhi, NL + b * CTX);
            else attn_unit_mfma(F, a, layer, b * SEQ + 128 * n, 128 * n, g, b * SEQ, jlo, jhi, NL + b * CTX);
        } else { const int v = u - n_lat, b = v >> 2, g = (v >> 1) & 1, cb = v & 1;
            if (MIX_SIMPLE & 1) attn_unit_simple(F, a, layer, NL + b * CTX + 128 * cb, 0, g, 0, 0, -1, NL + b * CTX);
            else attn_unit_mfma(F, a, layer, NL + b * CTX + 128 * cb, 0, g, 0, 0, -1, NL + b * CTX); }
    }
#endif
    const int n_rt = (layer == 0 ? MT : NL) / 64;
    const int skip = (layer == 0 && F.G > 32) ? (ATT_V2 ? 16 : 8) : 0;
    if (F.vcu >= skip)
    for (int rep = 0; rep < ((MIX_DUP & 2) ? 2 : 1); ++rep) {
        if (MIX_SIMPLE & 2) { for (int u = F.vcu - skip; u < n_rt * 4; u += F.G - skip) pool_unit(F, a, layer, u >> 2, u & 3); }
        else { __syncthreads();
            const int u0 = (F.vcu - skip) * 8 + F.wave, us = (F.G - skip) * 8, nu = n_rt * 4 * 8;
            switch (F.wave & 3) { case 0: pool_wave<2>(F, a, layer, u0, us, nu); break; case 1: pool_wave<4>(F, a, layer, u0, us, nu); break;
                                  case 2: pool_wave<8>(F, a, layer, u0, us, nu); break; default: pool_wave<16>(F, a, layer, u0, us, nu); break; } }
    }
    __syncthreads();
}

__device__ __forceinline__ float top2sum(float a, float b, float c, float d) {
    const float h1 = fmaxf(a, b), l1 = fminf(a, b), h2 = fmaxf(c, d), l2 = fminf(c, d);
    return fmaxf(h1, h2) + fmaxf(fminf(h1, h2), fmaxf(l1, l2));
}
template <class AT> __device__ __forceinline__ void phase_ln1_route(Frame& F, AT& a, int layer, bool dry = false) {
    LAS float* WT = (LAS float*)F.lds;
    LAS int* lcnt = (LAS int*)(F.lds + MISC_OFF + L_LCNT); LAS int* lbase = (LAS int*)(F.lds + MISC_OFF + L_BASE);
    LAS unsigned* rinfo = (LAS unsigned*)(F.lds + MISC_OFF + L_ROW);
    const int rows_total = layer == 0 ? MT : NL; const int chunk = (rows_total + F.G - 1) / F.G;
    const int row_lo = F.vcu * chunk; int row_hi = row_lo + chunk; row_hi = row_hi > rows_total ? rows_total : row_hi;
    __syncthreads();
    { const f32x4* src = (const f32x4*)(F.ws + WS_WRT); f32x4 tv[16];
#pragma unroll
      for (int i = 0; i < 16; ++i) tv[i] = src[F.tid + 512 * i];
#pragma unroll
      for (int i = 0; i < 16; ++i) *(LAS f32x4*)(WT + 4 * (F.tid + 512 * i)) = tv[i]; }
    if (F.tid < 32) lcnt[F.tid] = 0;
    __syncthreads();
    const bf16* Yb = (const bf16*)(F.ws + WS_E);
    const int e_mine = 16 * (F.lane & 1) + 8 * ((F.lane >> 1) & 1) + 4 * ((F.lane >> 2) & 1) + 2 * ((F.lane >> 3) & 1) + ((F.lane >> 4) & 1);
    const float bias_mine = a.in[I_RB][e_mine];
    const int src_canon = e_mine | (F.lane & 32);
    f32x4 pg1[4], pb1[4], pga[4], psh[4], psc[4]; int cvec = -1;
    load_vec(a.in[I_LN1G] + layer * D, F.lane, pg1); load_vec(a.in[I_LN1B] + layer * D, F.lane, pb1);
    f32x4 nv[4]; u32x2 ny[4];
#define XROW(r_) (layer == 0 ? ((r_) < NL ? a.in[I_X] + (size_t)(r_) * D : a.in[I_CTX] + (size_t)((r_) - NL) * D) : (const float*)(F.ws + WS_C) + (size_t)(r_) * D)
    if (row_lo + F.wave < row_hi) { const int r0 = row_lo + F.wave; load_row(XROW(r0), F.lane, nv);
#pragma unroll
        for (int j = 0; j < 4; ++j) ny[j] = *(const u32x2*)(Yb + (size_t)r0 * D + 256 * j + 4 * F.lane); }
    for (int row = row_lo + F.wave; row < row_hi; ) {
      { const int vec = row_vec(row); cvec = vec; load_ada(ada_vec(F, layer, vec, 2), F.lane, pga); load_ada(ada_vec(F, layer, vec, 3), F.lane, psh); load_ada(ada_vec(F, layer, vec, 4), F.lane, psc);
        pin_vec(pga); pin_vec(psh); pin_vec(psc); pin_vec(pg1); pin_vec(pb1); }
      int seg_hi = cvec == 0 ? SEQ : (cvec == 1 ? NL : MT); seg_hi = seg_hi < row_hi ? seg_hi : row_hi;
      for (; row < seg_hi; row += 8) {
        f32x4 v[4]; u32x2 yv[4];
#pragma unroll
        for (int j = 0; j < 4; ++j) { v[j] = nv[j]; yv[j] = ny[j]; }
        if (row + 8 < row_hi) { const int r1 = row + 8; load_row(XROW(r1), F.lane, nv);
#pragma unroll
            for (int j = 0; j < 4; ++j) ny[j] = *(const u32x2*)(Yb + (size_t)r1 * D + 256 * j + 4 * F.lane); }
        __builtin_amdgcn_sched_barrier(0);
#pragma unroll
        for (int j = 0; j < 4; ++j) { const f32x4 yy = {bf_lo(yv[j].x), bf_hi(yv[j].x), bf_lo(yv[j].y), bf_hi(yv[j].y)}; v[j] = v[j] * ALPHA + pga[j] * yy; }
        float mean, rstd; ln_stats(v, mean, rstd);
#pragma unroll
        for (int j = 0; j < 4; ++j) v[j] = (v[j] - mean) * rstd * pg1[j] + pb1[j];
        float* x1 = row < NL ? a.out + (size_t)row * D : (float*)(F.ws + WS_X1C) + (size_t)(row - NL) * D;
        store_row(x1, F.lane, v);
        ln_stats(v, mean, rstd);
        f32x4 h[4];
#pragma unroll
        for (int j = 0; j < 4; ++j) h[j] = (v[j] - mean) * rstd * (psc[j] + 1.0f) + psh[j];
        store_row_bf16((bf16*)(F.ws + WS_E) + (size_t)row * D, F.lane, h);
        float lg[32];
        {
            f32x4 wA[4], wB[4];
#define RT_LOAD(dst, e_) do { _Pragma("unroll") for (int j = 0; j < 4; ++j) dst[j] = *(const LAS f32x4*)(WT + (e_) * D + 256 * j + 4 * F.lane); } while (0)
#define RT_MUL(src, e_) do { f32x2 sa = {0.f, 0.f}; _Pragma("unroll") for (int j = 0; j < 4; ++j) { \
                sa = __builtin_elementwise_fma((f32x2){h[j].x, h[j].y}, (f32x2){src[j].x, src[j].y}, sa); sa = __builtin_elementwise_fma((f32x2){h[j].z, h[j].w}, (f32x2){src[j].z, src[j].w}, sa); } \
                lg[(e_)] = sa.x + sa.y; } while (0)
            RT_LOAD(wA, 0);
#pragma unroll
            for (int e2 = 0; e2 < 32; e2 += 2) {
                RT_LOAD(wB, e2 + 1); __builtin_amdgcn_sched_barrier(0); RT_MUL(wA, e2); __builtin_amdgcn_sched_barrier(0);
                if (e2 + 2 < 32) { RT_LOAD(wA, e2 + 2); } __builtin_amdgcn_sched_barrier(0); RT_MUL(wB, e2 + 1); __builtin_amdgcn_sched_barrier(0);
            }
#undef RT_LOAD
#undef RT_MUL
        }
#pragma unroll
        for (int k = 0; k < 16; ++k) { const bool up = (F.lane & 1) != 0; const float send = up ? lg[k] : lg[k + 16], keep = up ? lg[k + 16] : lg[k]; lg[k] = keep + dppf<0xB1>(send); }
#pragma unroll
        for (int k = 0; k < 8; ++k) { const bool up = (F.lane & 2) != 0; const float send = up ? lg[k] : lg[k + 8], keep = up ? lg[k + 8] : lg[k]; lg[k] = keep + dppf<0x4E>(send); }
#pragma unroll
        for (int k = 0; k < 4; ++k) { const bool up = (F.lane & 4) != 0; const float send = up ? lg[k] : lg[k + 4], keep = up ? lg[k + 4] : lg[k]; lg[k] = keep + xor4f(send); }
#pragma unroll
        for (int k = 0; k < 2; ++k) { const bool up = (F.lane & 8) != 0; const float send = up ? lg[k] : lg[k + 2], keep = up ? lg[k + 2] : lg[k]; lg[k] = keep + dppf<0x128>(send); }
        { const bool up = (F.lane & 16) != 0; const float send = up ? lg[0] : lg[1], keep = up ? lg[1] : lg[0]; lg[0] = keep + __shfl_xor(send, 16); }
        const float logit = lg[0] + __shfl_xor(lg[0], 32);
        const float score_m = 1.0f / (1.0f + expf(-logit)); const float biased_m = score_m + bias_mine;
        const float score = __shfl(score_m, src_canon), biased = __shfl(biased_m, src_canon);
        const float ba = dppf<0x00>(biased), bb = dppf<0x55>(biased), bc = dppf<0xAA>(biased), bd = dppf<0xFF>(biased);
        float gs = top2sum(ba, bb, bc, bd); int gi = (F.lane & 31) >> 2;
        { const float os = xor4f(gs); const int oi = xor4i(gi); if (os > gs || (os == gs && oi < gi)) { gs = os; gi = oi; } }
        { const float os = dppf<0x128>(gs); const int oi = dppi<0x128>(gi); if (os > gs || (os == gs && oi < gi)) { gs = os; gi = oi; } }
        { const float os = __shfl_xor(gs, 16); const int oi = __shfl_xor(gi, 16); if (os > gs || (os == gs && oi < gi)) { gs = os; gi = oi; } }
        gi = __builtin_amdgcn_readfirstlane(gi);
        float bv[4], sv[4];
#pragma unroll
        for (int k = 0; k < 4; ++k) { bv[k] = __builtin_bit_cast(float, __builtin_amdgcn_readlane(__builtin_bit_cast(int, biased), gi * 4 + k)); sv[k] = __builtin_bit_cast(float, __builtin_amdgcn_readlane(__builtin_bit_cast(int, score), gi * 4 + k)); }
        int i0 = 0; float bb0 = bv[0];
#pragma unroll
        for (int k = 1; k < 4; ++k) if (bv[k] > bb0) { bb0 = bv[k]; i0 = k; }
        int i1 = -1; float bb1 = -INFINITY;
#pragma unroll
        for (int k = 0; k < 4; ++k) if (k != i0 && (i1 < 0 || bv[k] > bb1)) { bb1 = bv[k]; i1 = k; }
        float s0 = 0.f, s1 = 0.f;
#pragma unroll
        for (int k = 0; k < 4; ++k) { s0 = (k == i0) ? sv[k] : s0; s1 = (k == i1) ? sv[k] : s1; }
        const float wsum = s0 + s1;
        if (F.lane == 0) { const int e0 = gi * 4 + i0, e1 = gi * 4 + i1; const int lr = row - row_lo;
            const int p0 = __hip_atomic_fetch_add(&lcnt[e0], 1, __ATOMIC_RELAXED, __HIP_MEMORY_SCOPE_WORKGROUP), p1 = __hip_atomic_fetch_add(&lcnt[e1], 1, __ATOMIC_RELAXED, __HIP_MEMORY_SCOPE_WORKGROUP);
            rinfo[lr * 4 + 0] = (unsigned)e0 | ((unsigned)e1 << 8) | ((unsigned)p0 << 16); rinfo[lr * 4 + 1] = (unsigned)p1;
            rinfo[lr * 4 + 2] = __float_as_uint(s0 / wsum); rinfo[lr * 4 + 3] = __float_as_uint(s1 / wsum); }
      }
    }
    __syncthreads();
    if (dry) return;
    if (F.tid < 32) lbase[F.tid] = (int)__hip_atomic_fetch_add(F.ctl + CW_CNT + 64 * layer + F.tid, (unsigned)lcnt[F.tid], RLX_AGENT);
    __syncthreads();
    int* list = (int*)(F.ws + WS_LIST); unsigned* tok = (unsigned*)(F.ws + WS_TOK);
    for (int lr = F.tid; lr < row_hi - row_lo; lr += 512) {
        const unsigned w0 = rinfo[lr * 4 + 0], w1 = rinfo[lr * 4 + 1]; const int e0 = w0 & 255, e1 = (w0 >> 8) & 255;
        const int p0 = lbase[e0] + (int)(w0 >> 16), p1 = lbase[e1] + (int)w1; const int row = row_lo + lr;
        list[(size_t)e0 * LCAP + p0] = row; list[(size_t)e1 * LCAP + p1] = row;
        u32x4 o; o.x = (unsigned)e0 | ((unsigned)e1 << 8); o.y = (unsigned)p0; o.z = (unsigned)p1; o.w = rinfo[lr * 4 + 2];
        *(u32x4*)(tok + (size_t)row * 8) = o; tok[(size_t)row * 8 + 4] = rinfo[lr * 4 + 3];
    }
    __syncthreads();
}
__device__ __forceinline__ void moe_tables(Frame& F, int layer) {
    LAS int* blk = (LAS int*)(F.lds + MISC_OFF + L_BLK); LAS int* cnt = (LAS int*)(F.lds + MISC_OFF + L_CNT);
    __syncthreads();
    if (F.tid < 32) cnt[F.tid] = (int)__hip_atomic_load(F.ctl + CW_CNT + 64 * layer + F.tid, RLX_AGENT);
    __syncthreads();
    if (F.tid == 0) { int s = 0; for (int e = 0; e < 32; ++e) { blk[e] = s; s += (cnt[e] + 255) >> 8; } blk[32] = s; }
    __syncthreads();
}
template <class AT> __device__ __forceinline__ void phase_ln2(Frame& F, AT& a, int layer) {
    moe_tables(F, layer);
    const LAS int* blk = (const LAS int*)(F.lds + MISC_OFF + L_BLK);
    const int gw = F.vcu * 8 + F.wave, NGW = F.G * 8; const int rows_total = layer == 0 ? MT : NL;
    const bf16* YB = (const bf16*)(F.ws + WS_B); const unsigned* tok = (const unsigned*)(F.ws + WS_TOK);
    const float* g2g = a.in[I_LN2G] + layer * D; const float* g2b = a.in[I_LN2B] + layer * D;
    f32x4 pg2[4], pl2g[4], pl2b[4], qsh[4], qsc[4]; int cvec = -1;
    load_vec(g2g, F.lane, pl2g); load_vec(g2b, F.lane, pl2b);
    u32x4 tiA = {0u, 0u, 0u, 0u}, tiB = tiA; unsigned twA = 0u, twB = 0u;
    f32x4 nv[4]; u32x2 nya[4], nyb[4]; float nw0 = 0.f, nw1 = 0.f;
    int row = gw;
    if (row < rows_total) { tiB = *(const u32x4*)(tok + (size_t)row * 8); twB = tok[(size_t)row * 8 + 4]; }
    if (row + NGW < rows_total) { tiA = *(const u32x4*)(tok + (size_t)(row + NGW) * 8); twA = tok[(size_t)(row + NGW) * 8 + 4]; }
    if (row < rows_total) {
        const int e0 = tiB.x & 255, e1 = (tiB.x >> 8) & 255; const size_t r0 = (size_t)blk[e0] * 256 + tiB.y, r1 = (size_t)blk[e1] * 256 + tiB.z;
        load_row(row < NL ? a.out + (size_t)row * D : (const float*)(F.ws + WS_X1C) + (size_t)(row - NL) * D, F.lane, nv);
#pragma unroll
        for (int j = 0; j < 4; ++j) { nya[j] = *(const u32x2*)(YB + r0 * D + 256 * j + 4 * F.lane); nyb[j] = *(const u32x2*)(YB + r1 * D + 256 * j + 4 * F.lane); }
        nw0 = __uint_as_float(tiB.w); nw1 = __uint_as_float(twB);
    }
    while (row < rows_total) {
      { const int vec = row_vec(row); cvec = vec; load_ada(ada_vec(F, layer, vec, 5), F.lane, pg2); load_ada(ada_vec(F, 1, vec, 0), F.lane, qsh); load_ada(ada_vec(F, 1, vec, 1), F.lane, qsc);
        pin_vec(pg2); pin_vec(qsh); pin_vec(qsc); pin_vec(pl2g); pin_vec(pl2b); }
      int seg_hi = cvec == 0 ? SEQ : (cvec == 1 ? NL : MT); seg_hi = seg_hi < rows_total ? seg_hi : rows_total;
      while (row < seg_hi) {
        f32x4 v[4]; u32x2 ya[4], yb[4]; const float w0 = nw0, w1 = nw1;
#pragma unroll
        for (int j = 0; j < 4; ++j) { v[j] = nv[j]; ya[j] = nya[j]; yb[j] = nyb[j]; }
        const int nrow = row + NGW;
        u32x4 tiN; unsigned twN;
        { const int pr = nrow < rows_total ? nrow : rows_total - 1;
          const int e0 = tiA.x & 255, e1 = (tiA.x >> 8) & 255; const size_t r0 = (size_t)blk[e0] * 256 + tiA.y, r1 = (size_t)blk[e1] * 256 + tiA.z;
          load_row(pr < NL ? a.out + (size_t)pr * D : (const float*)(F.ws + WS_X1C) + (size_t)(pr - NL) * D, F.lane, nv);
#pragma unroll
          for (int j = 0; j < 4; ++j) { nya[j] = *(const u32x2*)(YB + r0 * D + 256 * j + 4 * F.lane); nyb[j] = *(const u32x2*)(YB + r1 * D + 256 * j + 4 * F.lane); }
          nw0 = __uint_as_float(tiA.w); nw1 = __uint_as_float(twA);
          const int r2 = (nrow + NGW < rows_total) ? nrow + NGW : rows_total - 1;
          tiN = *(const u32x4*)(tok + (size_t)r2 * 8); twN = tok[(size_t)r2 * 8 + 4]; }
        __builtin_amdgcn_sched_barrier(0);
#pragma unroll
        for (int j = 0; j < 4; ++j) {
            const f32x4 fa = {bf_lo(ya[j].x), bf_hi(ya[j].x), bf_lo(ya[j].y), bf_hi(ya[j].y)}, fb = {bf_lo(yb[j].x), bf_hi(yb[j].x), bf_lo(yb[j].y), bf_hi(yb[j].y)};
            v[j] = v[j] * ALPHA + pg2[j] * (fa * w0 + fb * w1); }
        float mean, rstd; ln_stats(v, mean, rstd);
#pragma unroll
        for (int j = 0; j < 4; ++j) v[j] = (v[j] - mean) * rstd * pl2g[j] + pl2b[j];
        if (layer == 0) { store_row((float*)(F.ws + WS_C) + (size_t)row * D, F.lane, v);
            ln_stats(v, mean, rstd); f32x4 hh[4];
#pragma unroll
            for (int j = 0; j < 4; ++j) hh[j] = (v[j] - mean) * rstd * (qsc[j] + 1.0f) + qsh[j];
            store_row_bf16((bf16*)(F.ws + WS_H) + (size_t)row * D, F.lane, hh); }
        else store_row(a.out + (size_t)row * D, F.lane, v);
        row = nrow; tiA = tiN; twA = twN;
      }
    }
}

constexpr int N_PHASES = 18;
typedef const __attribute__((address_space(4))) Args CArgs;
__device__ __forceinline__ CArgs& kargs() { CArgs* p = (CArgs*)__builtin_amdgcn_kernarg_segment_ptr(); asm volatile("" : "+s"(p)); return *p; }
#define args (kargs())
__global__ void __launch_bounds__(512, 2) fwd_kernel(Args args_unused) {
    extern __shared__ __attribute__((aligned(16))) unsigned char lds_raw[];
    Frame F;
    F.lds = (LAS unsigned char*)lds_raw; F.ws = args.ws; F.ctl = (unsigned*)(args.ws + WS_CTL);
    F.tid = threadIdx.x; F.lane = F.tid & 63; F.wave = __builtin_amdgcn_readfirstlane(F.tid >> 6);
    F.G = gridDim.x; { const int bx = blockIdx.x; F.vcu = (F.G % 8 == 0) ? (bx % 8) * (F.G / 8) + bx / 8 : bx; }
    for (int u = F.tid; u < (LDS_BYTES - MISC_OFF) / 4; u += 512) ((LAS unsigned*)(F.lds + MISC_OFF))[u] = 0u;
    __syncthreads();
    const int lo = args.ph_lo; int hi = args.ph_hi; const bool dry = hi > 100; if (dry) hi -= 100;
    XcdBarrier bar; bar.bar = F.ctl + CW_BAR; bar.x = 0; bar.st = nullptr;
    if (hi - lo > 1) bar = xcd_barrier_post(F.ctl + CW_BAR, (volatile LAS unsigned*)(F.lds + MISC_OFF + L_BARW));
#ifndef PH_MASK
#define PH_MASK 0xFFFFFFFFu
#endif
#define IN(k) (lo <= (k) && (k) < hi)
#define EN(b) ((PH_MASK >> (b)) & 1u)
#define FRESH() do { asm volatile("" : "+v"(F.tid)); F.lane = F.tid & 63; } while (0)
    const bool fused = (hi - lo) > 1;
#ifndef FILL_MASK
#define FILL_MASK 0u
#endif
#ifndef BG_DRAIN
#define BG_DRAIN 1
#endif
#define SEAMX(k, fillbit, lim) do { if (IN(k) && IN((k) + 1)) { if (BG_DRAIN && fused && (((FILL_MASK >> (fillbit)) & 1u) || (lim) > 0)) { FRESH(); seam_fill(F, args, (k), (lim)); } xcd_barrier(bar); } } while (0)
#define SEAM(k) do { if (IN(k) && IN((k) + 1)) xcd_barrier(bar); } while (0)
    if (EN(0) && IN(0)) { FRESH(); phase_pre(F, args, !fused || !BG_DRAIN); } SEAM(0);
    if (EN(1) && IN(1)) { FRESH(); phase_h0(F, args); } SEAMX(1, 1, 0);
    for (int l = 0; l < 2; ++l) {
        const int pb = 2 + 8 * l;
        const int nMall = l == 0 ? 130 : 128;
        if (EN(2) && IN(pb + 0)) {
            InProjOrder S; S.init(F.ws + WS_H, F.ws + WS_WIN + (size_t)l * IN_COLS * D * 2, D, nMall, 13, F.G, (int)blockIdx.x);
            if (l == 1) { S.exN = 2; S.exPm0 = 128; S.exPn = 4; }
            EpiInProj E{(bf16*)(F.ws + WS_U), (bf16*)(F.ws + WS_Q), (bf16*)(F.ws + WS_K), (bf16*)(F.ws + WS_V), (bf16*)(F.ws + WS_GATE), (const float*)(F.ws + WS_ROPE)};
            pg8::gemm_phase<EpiInProj, InProjOrder, true>(F.lds, D, S, E);
        } SEAMX(pb + 0, 2, 0);
        if (EN(3) && IN(pb + 1)) { FRESH(); phase_mix(F, args, l); } SEAMX(pb + 1, 3, 0);
        if (EN(4) && IN(pb + 2)) {
            if (l == 0) { FRESH(); ctx_gemm<0>(F, (const bf16*)(F.ws + WS_PO), (const bf16*)(F.ws + WS_WPB), (const bf16*)(F.ws + WS_GATE), (bf16*)(F.ws + WS_F)); }
            PlainOrder S; S.init(F.ws + WS_PO, F.ws + WS_WPB + (size_t)l * D * D * 2, D, 128, 4, F.G, (int)blockIdx.x);
            EpiMergeOne E{(const bf16*)(F.ws + WS_GATE), (bf16*)(F.ws + WS_F)};
            pg8::gemm_phase<EpiMergeOne, PlainOrder, true>(F.lds, D, S, E);
        } SEAMX(pb + 2, 4, 0);
        if (EN(5) && IN(pb + 3)) {
            if (l == 0) { FRESH(); ctx_gemm<1>(F, (const bf16*)(F.ws + WS_F), (const bf16*)(F.ws + WS_WO), nullptr, (bf16*)(F.ws + WS_E)); }
            PlainOrder S; S.init(F.ws + WS_F, F.ws + WS_WO + (size_t)l * D * D * 2, D, 128, 4, F.G, (int)blockIdx.x);
            EpiPlainBf16 E{(bf16*)(F.ws + WS_E)};
            pg8::gemm_phase<EpiPlainBf16, PlainOrder, true>(F.lds, D, S, E);
        } SEAMX(pb + 3, 5, 0);
        if (EN(6) && IN(pb + 4)) { FRESH(); phase_ln1_route(F, args, l, dry); } SEAMX(pb + 4, 6, l * BG_PER_LAYER + 16384);
        if (EN(7) && IN(pb + 5)) {
            FRESH(); moe_tables(F, l);
            MoeOrder<true> S{(const char*)(F.ws + WS_E), (const char*)(F.ws + WS_WEG + (size_t)l * 32 * D * D * 2), (const char*)(F.ws + WS_WEU + (size_t)l * 32 * D * D * 2), 8, F.G, F.vcu,
                             (const LAS int*)(F.lds + MISC_OFF + L_BLK), (const LAS int*)(F.lds + MISC_OFF + L_CNT), (const int*)(F.ws + WS_LIST)};
            EpiGateUp E{(bf16*)(F.ws + WS_A)};
            pg8::gemm_phase<EpiGateUp, MoeOrder<true>, true>(F.lds, D, S, E);
        } SEAMX(pb + 5, 7, (l + 1) * BG_PER_LAYER);
        if (EN(8) && IN(pb + 6)) {
            FRESH(); moe_tables(F, l);
            MoeOrder<false> S{(const char*)(F.ws + WS_A), (const char*)(F.ws + WS_WED + (size_t)l * 32 * D * D * 2), nullptr, 4, F.G, F.vcu,
                              (const LAS int*)(F.lds + MISC_OFF + L_BLK), (const LAS int*)(F.lds + MISC_OFF + L_CNT), (const int*)(F.ws + WS_LIST)};
            EpiPlainBf16 E{(bf16*)(F.ws + WS_B)};
            pg8::gemm_phase<EpiPlainBf16, MoeOrder<false>, true>(F.lds, D, S, E);
        } SEAMX(pb + 6, 8, 0);
        if (EN(9) && IN(pb + 7)) { FRESH(); phase_ln2(F, args, l); }
        if (l == 0) SEAMX(pb + 7, 9, 0);
    }
#undef IN
#undef SEAM
}

#undef args
extern "C" void kernel_launch(void* const* d_in, const int* in_sizes, int n_in, void* d_out, int out_size, void* d_ws, size_t ws_size, hipStream_t stream) {
    static int grid = 0;
    if (grid == 0) {
        if (n_in != 22 || out_size != NL * D || ws_size < WS_END) { fprintf(stderr, "kernel_launch: unexpected shapes (n_in %d, out %d, ws %zu, need %zu)\n", n_in, out_size, ws_size, (size_t)WS_END); grid = -1; return; }
        int dev = 0, cus = 0, per_cu = 0;
        if (hipGetDevice(&dev) != hipSuccess || hipDeviceGetAttribute(&cus, hipDeviceAttributeMultiprocessorCount, dev) != hipSuccess) { grid = -1; return; }
        if (hipFuncSetAttribute((const void*)fwd_kernel, hipFuncAttributeMaxDynamicSharedMemorySize, LDS_BYTES) != hipSuccess) { fprintf(stderr, "kernel_launch: hipFuncSetAttribute failed\n"); grid = -1; return; }
        if (hipOccupancyMaxActiveBlocksPerMultiprocessor(&per_cu, (const void*)fwd_kernel, 512, LDS_BYTES) != hipSuccess || per_cu < 1) fprintf(stderr, "kernel_launch: occupancy query reports %d\n", per_cu);
        (void)hipGetLastError();
        grid = cus;
    }
    if (grid < 0) return;
    static_assert((CW_PHDONE + 64 * 24) * 4 <= 512 * 1024, "every control word sits in the first 512 KiB");
    (void)hipMemsetAsync((char*)d_ws + WS_CTL, 0, 512 * 1024, stream);
    Args a{};
    for (int i = 0; i < 22; ++i) a.in[i] = (const float*)d_in[i];
    a.out = (float*)d_out; a.ws = (unsigned char*)d_ws;
#if MK_ONE_LAUNCH
    a.ph_lo = 0; a.ph_hi = N_PHASES;
    hipLaunchKernelGGL(fwd_kernel, dim3(grid), dim3(512), LDS_BYTES, stream, a);
#else
    for (int p = 0; p < N_PHASES; ++p) { a.ph_lo = p; a.ph_hi = p + 1;
#ifdef DUP_PHASE
        if (p == DUP_PHASE && (p == 6 || p == 14)) { a.ph_hi = p + 101; hipLaunchKernelGGL(fwd_kernel, dim3(grid), dim3(512), LDS_BYTES, stream, a); a.ph_hi = p + 1; }
#endif
        hipLaunchKernelGGL(fwd_kernel, dim3(grid), dim3(512), LDS_BYTES, stream, a);
#ifdef DUP_PHASE
        if (p == DUP_PHASE) { if (p == 0) (void)hipMemsetAsync((char*)d_ws + WS_CTL, 0, CTL_ZERO_BYTES, stream); if (p != 6 && p != 14) hipLaunchKernelGGL(fwd_kernel, dim3(grid), dim3(512), LDS_BYTES, stream, a); }
#endif
    }
#endif
}
```

```cpp
#include <hip/hip_runtime.h>
#include <cstdio>
#include <cstdint>

#ifndef MK_ONE_LAUNCH
#define MK_ONE_LAUNCH 1
#endif

#define GAS __attribute__((address_space(1)))
#define LAS __attribute__((address_space(3)))
typedef unsigned short bf16;
typedef short bf16x8 __attribute__((ext_vector_type(8)));
typedef float f32x4 __attribute__((ext_vector_type(4)));
typedef float f32x2 __attribute__((ext_vector_type(2)));
typedef unsigned u32x4 __attribute__((ext_vector_type(4)));
typedef unsigned u32x2 __attribute__((ext_vector_type(2)));
typedef GAS unsigned gu32;

constexpr int D = 1024, NB_ = 2, SEQ = 16384, CTX = 256;
constexpr int NL = NB_ * SEQ;
constexpr int NC = NB_ * CTX;
constexpr int MT = NL + NC;
constexpr int IN_COLS = 3328;
constexpr int NEXP = 32;
constexpr int LCAP = 2 * MT;
constexpr int MAXBLK = 291;
constexpr float LN_EPS = 1e-6f;
constexpr float ALPHA = 1.4142135623730951f;
constexpr float LOG2E = 1.4426950408889634f;
constexpr float QSCALE = 0.125f * LOG2E;

constexpr size_t WS_CTL = 0, CTL_ZERO_BYTES = 1u << 20;
constexpr int CW_TMO = 0;
constexpr int CW_BAR = 4096;
constexpr int CW_CNT = 8192;
constexpr int CW_QHEAD = 12288;
constexpr int CW_PHDONE = 12352;
constexpr int BG_PER_LAYER = 3 * 32 * 256, BG_TOTAL = 2 * BG_PER_LAYER;
constexpr size_t al256(size_t x) { return (x + 255) & ~(size_t)255; }
constexpr size_t WS_DUMMY = 768u << 10;
constexpr size_t WS_ROPE = CTL_ZERO_BYTES;
constexpr size_t WS_WRT  = WS_ROPE + 65536;
constexpr size_t WS_ADAP = WS_WRT + 131072;
constexpr size_t WS_WIN  = WS_ADAP + (size_t)36864 * 4;
constexpr size_t WS_WPG  = WS_WIN + (size_t)2 * IN_COLS * D * 2;
constexpr size_t WS_WPB  = WS_WPG + (size_t)2 * 4 * 128 * 128 * 2;
constexpr size_t WS_WAB  = WS_WPB + (size_t)2 * 1024 * 512 * 2;
constexpr size_t WS_WO   = WS_WAB + (size_t)2 * 1024 * 512 * 2;
constexpr size_t WS_WEG  = WS_WO + (size_t)2 * 1024 * 1024 * 2;
constexpr size_t WS_WEU  = WS_WEG + (size_t)64 * 1024 * 1024 * 2;
constexpr size_t WS_WED  = WS_WEU + (size_t)64 * 1024 * 1024 * 2;
constexpr size_t WS_LIST = WS_WED + (size_t)64 * 1024 * 1024 * 2;
constexpr size_t WS_TOK  = WS_LIST + (size_t)NEXP * LCAP * 4;
constexpr size_t WS_X1C  = WS_TOK + (size_t)MT * 32;
constexpr size_t WS_A    = al256(WS_X1C + (size_t)NC * D * 4);
constexpr size_t SZ_A    = (size_t)MT * 4608;
static_assert(SZ_A >= (size_t)MAXBLK * 256 * D * 2, "region A holds ACT");
constexpr size_t WS_H    = WS_A;
constexpr size_t WS_U    = WS_H + (size_t)MT * D * 2;
constexpr size_t WS_Q    = WS_U + (size_t)MT * 512 * 2;
constexpr size_t WS_K    = WS_Q + (size_t)MT * 512 * 2;
constexpr size_t WS_V    = WS_K + (size_t)MT * 128 * 2;
static_assert(WS_V + (size_t)MT * 128 * 2 <= WS_A + SZ_A, "region A");
constexpr size_t WS_B    = WS_A + SZ_A;
constexpr size_t WS_GATE = WS_B;
static_assert((size_t)MT * 2048 * 2 <= SZ_A, "region B");
constexpr size_t WS_C    = WS_B + SZ_A;
constexpr size_t WS_E    = WS_C + (size_t)MT * D * 4;
constexpr size_t WS_PO   = WS_E;
constexpr size_t WS_AO   = WS_E + (size_t)MT * 512 * 2;
constexpr size_t WS_F    = WS_E + (size_t)MT * D * 2;
constexpr size_t WS_END  = WS_F + (size_t)MT * D * 2;
static_assert(WS_END <= (size_t)1073741824, "d_ws map must fit 1 GiB");

constexpr int RING_BYTES = 131072;
constexpr int MISC_OFF = RING_BYTES;
constexpr int L_BARW = 0;
constexpr int L_QSLOT = 32;
constexpr int L_BLK = 64;
constexpr int L_CNT = 256;
constexpr int L_LCNT = 384;
constexpr int L_BASE = 512;
constexpr int L_ROW = 1024;
constexpr int L_CONV = 4096;
constexpr int LDS_BYTES = 151552;

#define RLX_AGENT __ATOMIC_RELAXED, __HIP_MEMORY_SCOPE_AGENT
#define LDS_WAIT() asm volatile("s_waitcnt lgkmcnt(0)" ::: "memory")
#define VM_WAIT() asm volatile("s_waitcnt vmcnt(0)" ::: "memory")

__device__ __forceinline__ unsigned cvt_pk_bf16(float lo, float hi) { unsigned r; asm volatile("v_cvt_pk_bf16_f32 %0, %1, %2" : "=v"(r) : "v"(lo), "v"(hi)); return r; }
__device__ __forceinline__ float bf_lo(unsigned w) { return __uint_as_float(w << 16); }
__device__ __forceinline__ float bf_hi(unsigned w) { return __uint_as_float(w & 0xffff0000u); }
__device__ __forceinline__ float bf2f(bf16 b) { return __uint_as_float(((unsigned)b) << 16); }
__device__ __forceinline__ float sigmoid_fast(float x) { return __builtin_amdgcn_rcpf(1.0f + __builtin_amdgcn_exp2f(-x * LOG2E)); }

namespace pg8 {
constexpr int BM = 256, BK = 64, HALF = 128, HTB = HALF * BK * 2, STAGE_BYTES = 8 * HTB, NXCD = 8, WGM = 8;
__host__ __device__ __forceinline__ int lds_byte(int r, int c) { const int st = (r >> 4) * 2 + (c >> 5), rr = r & 15, cc = c & 31, ob = rr * 64 + cc * 2; return st * 1024 + (ob ^ (((ob >> 9) & 1) << 5)); }
__host__ __device__ __forceinline__ void stage_rc(int b, int& R, int& C) { const int st = b / 1024, sb = b % 1024, swz = sb ^ (((sb >> 9) & 1) << 5); R = (st >> 1) * 16 + swz / 64; C = (st & 1) * 32 + (swz % 64) / 2; }
__host__ __device__ __forceinline__ int perm32(int rho) { const int n = rho >> 4, i = rho & 15; return 8 * (i >> 2) + 4 * n + (i & 3); }

struct Unit { int pm, pn, e, x0, x1; };

struct NoConv { static constexpr bool ON = false; static constexpr int RATE2 = 0; };
template <int RATE2_> struct ConvW { static constexpr bool ON = true; static constexpr int RATE2 = RATE2_; const __attribute__((address_space(4))) char* kin; unsigned char* ws; int base, limit, G, c; };
constexpr int CONV_HALVES = 2 * 3 * 32 * 32;
template <class Epi, class Sched, bool ALIGN_EPI, class Cv = NoConv>
__device__ __forceinline__ void gemm_phase(LAS unsigned char* lds, const int K, const Sched& S, const Epi& E, const Cv& CV = Cv{}) {
    int tid_l = threadIdx.x; asm volatile("" : "+v"(tid_l));
    const int tid = tid_l, wid = __builtin_amdgcn_readfirstlane(tid >> 6), lane = tid & 63, wr = wid >> 2, wc = wid & 3, fr = lane & 15, fq = lane >> 4;
    const int nt = K / BK;
    int Rr[2]; unsigned Cc[2], voffB[2];
#pragma unroll
    for (int i = 0; i < 2; ++i) { int R, C; stage_rc(tid * 16 + i * 8192, R, C); const int Rb = Epi::PERM ? ((R & ~31) + perm32(R & 31)) : R;
        Rr[i] = R; Cc[i] = (unsigned)C * 2u; voffB[i] = (unsigned)(Rb * K + C) * 2u; }
    const size_t kstep = (size_t)(BK * 2);
    const unsigned ldsw = (unsigned)wid * 1024u;
    const int aoff = lds_byte(wr * 64 + fr, fq * 8), boff = lds_byte(wc * 32 + fr, fq * 8);
#define PG8_SA(b, h) (((b) * 2 + (h)) * HTB)
#define PG8_SB(b, h) ((4 + (b) * 2 + (h)) * HTB)
#define PG8_STAGE(bufoff, gbase, voff) do { _Pragma("unroll") for (int _i = 0; _i < 2; ++_i) \
        __builtin_amdgcn_global_load_lds((const unsigned*)((const char*)(gbase) + (voff)[_i]), (LAS unsigned*)(lds + (bufoff) + ldsw + _i * 8192), 16, 0, 0); } while (0)
#define PG8_LDA(dst, b, h) do { _Pragma("unroll") for (int m = 0; m < 4; ++m) _Pragma("unroll") for (int k = 0; k < 2; ++k) dst[m][k] = *(const LAS bf16x8*)(lds + PG8_SA(b, h) + aoff + m * 2048 + k * 1024); } while (0)
#define PG8_LDB(dst, b, h) do { _Pragma("unroll") for (int n = 0; n < 2; ++n) _Pragma("unroll") for (int k = 0; k < 2; ++k) dst[n][k] = *(const LAS bf16x8*)(lds + PG8_SB(b, h) + boff + n * 2048 + k * 1024); } while (0)
#define PG8_MMA(ai, bj, At, Bt) do { __builtin_amdgcn_s_setprio(1); _Pragma("unroll") for (int m = 0; m < 4; ++m) _Pragma("unroll") for (int n = 0; n < 2; ++n) _Pragma("unroll") for (int k = 0; k < 2; ++k) \
        acc[ai][bj][m][n] = __builtin_amdgcn_mfma_f32_16x16x32_bf16(Bt[n][k], At[m][k], acc[ai][bj][m][n], 0, 0, 0); __builtin_amdgcn_s_setprio(0); } while (0)
#define PG8_WAIT_V(n) asm volatile("s_waitcnt vmcnt(" #n ")" ::: "memory")
#define PG8_WAIT_L(n) asm volatile("s_waitcnt lgkmcnt(" #n ")" ::: "memory")
#define PG8_BAR __builtin_amdgcn_s_barrier()
#define PG8_SCHED __builtin_amdgcn_sched_barrier(0)
    Unit cur, nxt; int ui = 0; cur.e = 0;
    if (!S.next(0, cur)) return;
    GAS const char* csrc = nullptr; GAS char* cdst = nullptr; unsigned cmask = 0u; int chb = 0;
    const unsigned clds = (unsigned)(RING_BYTES + L_CONV) + (unsigned)wid * 2048u;
#define PG8_CONV_UNIT(ui_) do { if constexpr (Cv::ON) { \
        int hc_ = CV.base + Cv::RATE2 * ((ui_) * CV.G + CV.c); const bool ok_ = hc_ < CV.limit; hc_ = ok_ ? hc_ : 0; int ch_ = hc_ >> 1; chb = Cv::RATE2 == 1 ? 8 * (hc_ & 1) : 0; \
        const int cl_ = ch_ / 1536, cr_ = ch_ - cl_ * 1536, cw_ = cr_ >> 9, cm_ = cl_ * 32 + ((cr_ & 511) >> 4), ck_ = (cr_ & 15) * 64; \
        const float* sb_ = *(const float* const __attribute__((address_space(4)))*)(CV.kin + 8 * cw_); const float* s0_ = *(const float* const __attribute__((address_space(4)))*)(CV.kin); \
        const size_t wo_ = cw_ == 0 ? WS_WEG : (cw_ == 1 ? WS_WEU : WS_WED); \
        csrc = (GAS const char*)(ok_ ? (const char*)(sb_ + (size_t)cm_ * 1048576 + (size_t)ck_ * 1024) : (const char*)s0_); \
        cdst = (GAS char*)(ok_ ? (char*)CV.ws + wo_ + ((size_t)cm_ * 1048576 + ck_) * 2 : (char*)CV.ws + WS_DUMMY + CV.c * 64); \
        cmask = ok_ ? 0xffffffffu : 0u; \
        } } while (0)
#define PG8_CONV_FLUSH(hp_, real_) do { const int hq_ = (hp_); const bool rl_ = (real_); \
        if constexpr (Cv::RATE2 == 2) PG8_WAIT_V(8); else PG8_WAIT_V(16); \
        int tl_ = tid; asm volatile("" : "+v"(tl_)); const int l_ = tl_ & 63; \
        const LAS float* rp_ = (const LAS float*)(lds + clds) + (8 * (l_ >> 4)) * 16 + (l_ & 15); float x_[8]; \
        _Pragma("unroll") for (int i_ = 0; i_ < 8; ++i_) x_[i_] = rp_[16 * i_]; \
        const unsigned do_ = ((unsigned)((128 * (hq_ & 7)) * 1024 + 32 * (hq_ >> 3)) * 2u) & cmask; \
        const unsigned cld_ = ((unsigned)((16 * wid + (l_ & 15)) * 1024 + 8 * (l_ >> 4)) * 2u) & cmask; \
        GAS char* dp_ = rl_ ? cdst : (GAS char*)((char*)CV.ws + WS_DUMMY + CV.c * 64); const unsigned lo_ = rl_ ? cld_ + do_ : 0u; \
        u32x4 o_; o_.x = cvt_pk_bf16(x_[0], x_[1]); o_.y = cvt_pk_bf16(x_[2], x_[3]); o_.z = cvt_pk_bf16(x_[4], x_[5]); o_.w = cvt_pk_bf16(x_[6], x_[7]); \
        __builtin_nontemporal_store(o_, (GAS u32x4*)(dp_ + lo_)); } while (0)
#define PG8_CONV_STEP(h_, tt_) do { if constexpr (Cv::ON) { PG8_SCHED; int hv_ = (h_), tv_ = (tt_); asm volatile("" : "+s"(hv_), "+s"(tv_)); const int hh_ = hv_; PG8_CONV_FLUSH(hh_ - 1, tv_ > 0); \
        int tm_ = tid; asm volatile("" : "+v"(tm_)); const int lm_ = tm_ & 63; \
        const unsigned so_ = ((unsigned)((32 * (hh_ >> 3)) * 1024 + 128 * (hh_ & 7)) * 4u + (unsigned)((lm_ >> 2) * 1024 + 16 * wid + 4 * (lm_ & 3)) * 4u) & cmask; \
        PG8_WAIT_L(0); \
        __builtin_amdgcn_global_load_lds((GAS const unsigned*)(csrc + so_), (LAS unsigned*)(lds + clds), 16, 0, 2); \
        __builtin_amdgcn_global_load_lds((GAS const unsigned*)(csrc + 65536 + so_), (LAS unsigned*)(lds + clds + 1024), 16, 0, 2); \
        PG8_SCHED; } } while (0)
#define PG8_WAIT_VC(nc, n) do { if constexpr (Cv::ON) PG8_WAIT_V(nc); else PG8_WAIT_V(n); } while (0)
#define PG8_WAIT_VC2(nc, n) do { if constexpr (Cv::RATE2 == 2) PG8_WAIT_V(nc); else PG8_WAIT_V(n); } while (0)
    PG8_CONV_UNIT(0);
    f32x4 acc[2][2][4][2];
#pragma unroll
    for (int a = 0; a < 2; ++a)
#pragma unroll
        for (int b = 0; b < 2; ++b)
#pragma unroll
            for (int m = 0; m < 4; ++m)
#pragma unroll
                for (int n = 0; n < 2; ++n) acc[a][b][m][n] = (f32x4){0.f, 0.f, 0.f, 0.f};
    bf16x8 At[4][2], B0[2][2], B1[2][2];
    unsigned voffA[2][2];
#pragma unroll
    for (int h = 0; h < 2; ++h)
#pragma unroll
        for (int i = 0; i < 2; ++i) voffA[h][i] = S.a_off(cur, Rr[i] + 128 * h) + Cc[i];
    const char* const Ab = S.A;
    const char *cB0, *cB1; S.b_ptr(cur, cB0, cB1);
    PG8_STAGE(PG8_SB(0, 0), cB0, voffB); PG8_STAGE(PG8_SB(0, 1), cB1, voffB); PG8_STAGE(PG8_SA(0, 0), Ab, voffA[0]); PG8_STAGE(PG8_SA(0, 1), Ab, voffA[1]);
    if (wr == 1) PG8_BAR;
    PG8_WAIT_V(2); PG8_BAR;
    PG8_STAGE(PG8_SB(1, 0), cB0 + kstep, voffB); PG8_STAGE(PG8_SA(1, 0), Ab + kstep, voffA[0]); PG8_STAGE(PG8_SB(1, 1), cB1 + kstep, voffB);
    PG8_WAIT_V(6); PG8_BAR;
    for (;;) {
        nxt = cur; const bool has_next = S.next(ui + 1, nxt);
        const char *nB0 = cB0, *nB1 = cB1; if (has_next) S.b_ptr(nxt, nB0, nB1);
        for (int t = 0; t < nt; t += 2) {
            const bool last = (t == nt - 2);
            const char* a1 = Ab + (size_t)(t + 1) * kstep;
            const char* a2 = last ? Ab : Ab + (size_t)(t + 2) * kstep;
            const char* b20 = last ? nB0 : cB0 + (size_t)(t + 2) * kstep; const char* b21 = last ? nB1 : cB1 + (size_t)(t + 2) * kstep;
            const char* a3 = a2 + kstep; const char* b30 = b20 + kstep; const char* b31 = b21 + kstep;
            if constexpr (Epi::MID) { if (t == nt / 2) E.mid(acc, cur, wr, wc, fr, fq); }
            PG8_CONV_STEP(chb + (Cv::RATE2 == 2 ? t : (t >> 1)), t);
            PG8_LDB(B0, 0, 0); PG8_LDB(B1, 0, 1); PG8_SCHED; PG8_LDA(At, 0, 0); PG8_STAGE(PG8_SA(1, 1), a1, voffA[1]);
            if (last && has_next) {
                int tt = tid; asm volatile("" : "+v"(tt));
#pragma unroll
                for (int i = 0; i < 2; ++i) { int R, C; stage_rc(tt * 16 + i * 8192, R, C);
#pragma unroll
                    for (int h = 0; h < 2; ++h) voffA[h][i] = S.a_off(nxt, R + 128 * h) + (unsigned)C * 2u; }
            }
            PG8_WAIT_VC(11, 8); PG8_WAIT_L(0); PG8_BAR; PG8_MMA(0, 0, At, B0); PG8_MMA(0, 1, At, B1); PG8_BAR; PG8_SCHED;
            PG8_LDA(At, 0, 1); PG8_STAGE(PG8_SB(0, 0), b20, voffB); PG8_STAGE(PG8_SB(0, 1), b21, voffB); PG8_STAGE(PG8_SA(0, 0), a2, voffA[0]);
            PG8_WAIT_VC(11, 8); PG8_WAIT_L(0); PG8_BAR; PG8_MMA(1, 0, At, B0); PG8_MMA(1, 1, At, B1); PG8_BAR; PG8_SCHED;
            if constexpr (Cv::RATE2 == 2) PG8_CONV_STEP(t + 1, 1);
            PG8_LDB(B0, 1, 0); PG8_LDB(B1, 1, 1); PG8_SCHED; PG8_LDA(At, 1, 0); PG8_STAGE(PG8_SA(0, 1), a2, voffA[1]);
            PG8_WAIT_VC2(11, 8); PG8_WAIT_L(0); PG8_BAR; PG8_MMA(0, 0, At, B0); PG8_MMA(0, 1, At, B1); PG8_BAR; PG8_SCHED;
            PG8_LDA(At, 1, 1); PG8_STAGE(PG8_SB(1, 0), b30, voffB); PG8_STAGE(PG8_SB(1, 1), b31, voffB); PG8_STAGE(PG8_SA(1, 0), a3, voffA[0]);
            PG8_WAIT_VC2(11, 8); PG8_WAIT_L(0); PG8_BAR; PG8_MMA(1, 0, At, B0); PG8_MMA(1, 1, At, B1); PG8_BAR; PG8_SCHED;
        }
        if constexpr (Cv::ON) { PG8_CONV_FLUSH(chb + (Cv::RATE2 == 2 ? nt - 1 : nt / 2 - 1), true); PG8_SCHED; }
        if constexpr (ALIGN_EPI) { if (wr == 0) PG8_BAR; }
        E(acc, cur, wr, wc, fr, fq);
        if (!has_next) break;
#pragma unroll
        for (int a = 0; a < 2; ++a)
#pragma unroll
            for (int b = 0; b < 2; ++b)
#pragma unroll
                for (int m = 0; m < 4; ++m)
#pragma unroll
                    for (int n = 0; n < 2; ++n) acc[a][b][m][n] = (f32x4){0.f, 0.f, 0.f, 0.f};
        cur = nxt; cB0 = nB0; cB1 = nB1; ++ui;
        PG8_CONV_UNIT(ui);
        if constexpr (ALIGN_EPI) { if (wr == 1) PG8_BAR; }
    }
    PG8_WAIT_V(0);
    if constexpr (!ALIGN_EPI) { if (wr == 0) PG8_BAR; }
    PG8_BAR;
#undef PG8_SA
#undef PG8_SB
#undef PG8_STAGE
#undef PG8_LDA
#undef PG8_LDB
#undef PG8_MMA
#undef PG8_WAIT_V
#undef PG8_WAIT_VC
#undef PG8_WAIT_VC2
#undef PG8_CONV_UNIT
#undef PG8_CONV_STEP
#undef PG8_CONV_FLUSH
#undef PG8_WAIT_L
#undef PG8_BAR
#undef PG8_SCHED
}
}
using pg8::Unit;

#define XB_TMO      128
#define XB_XCNT(j)  (256  + 64 * (j))
#define XB_XSUB(j)  (1280 + 64 * (j))
#define XB_XGEN(j)  (2304 + 64 * (j))
#define XB_TOP      3328
#define XB_TOPGEN   3392
#define XCD_BAR_WORDS 3456
#define XB_SPIN_CAP (1u << 18)
__device__ __forceinline__ unsigned xb_ld(unsigned* p)              { return __hip_atomic_load(p, __ATOMIC_RELAXED, __HIP_MEMORY_SCOPE_AGENT); }
__device__ __forceinline__ unsigned xb_add(unsigned* p, unsigned v) { return __hip_atomic_fetch_add(p, v, __ATOMIC_RELAXED, __HIP_MEMORY_SCOPE_AGENT); }
__device__ __forceinline__ unsigned xb_xcc_id() { return (unsigned)__builtin_amdgcn_s_getreg((3 << 11) | 20) & 0xFu; }
#define XB_SPIN(cond, bar) do { unsigned _sp = 0; while (cond) { __builtin_amdgcn_s_sleep(1); \
    if ((++_sp & 255u) == 0u) { if (xb_ld(&(bar)[XB_TMO])) break; if (_sp > XB_SPIN_CAP) { atomicAdd(&(bar)[XB_TMO], 1u); break; } } } } while (0)
struct XcdBarrier { unsigned* bar; unsigned x; volatile LAS unsigned* st; };
__device__ __forceinline__ XcdBarrier xcd_barrier_post(unsigned* bar, volatile LAS unsigned* st) {
    XcdBarrier b; b.bar = bar; b.x = xb_xcc_id(); b.st = st;
    if (threadIdx.x == 0) (void)xb_add(&bar[XB_XCNT(b.x)], 1u);
    return b;
}
__device__ __forceinline__ void xcd_barrier_complete(unsigned* bar, unsigned x, unsigned& nloc, unsigned& nx) {
    const unsigned G = gridDim.x * gridDim.y * gridDim.z;
    unsigned sum, cnt, mine, sp = 0u;
    for (;;) {
        sum = 0u; cnt = 0u; mine = 0u;
#pragma unroll
        for (unsigned j = 0; j < 16; ++j) { const unsigned c = xb_ld(&bar[XB_XCNT(j)]); sum += c; cnt += (c > 0u) ? 1u : 0u; mine = (j == x) ? c : mine; }
        if (sum == G) break;
        __builtin_amdgcn_s_sleep(1);
        if ((++sp & 255u) == 0u) { if (xb_ld(&bar[XB_TMO])) break; if (sp > XB_SPIN_CAP) { atomicAdd(&bar[XB_TMO], 1u); break; } }
    }
    nloc = mine > 0u ? mine : 1u; nx = cnt > 0u ? cnt : 1u;
}
__device__ __forceinline__ void xcd_barrier(const XcdBarrier& b) {
    asm volatile("s_waitcnt vmcnt(0)" ::: "memory");
    __syncthreads();
    if (threadIdx.x == 0) {
        unsigned* bar = b.bar;
        __builtin_amdgcn_s_waitcnt(0);
        unsigned nloc = b.st[0], nx = b.st[1];
        if (nloc == 0u) { xcd_barrier_complete(bar, b.x, nloc, nx); b.st[0] = nloc; b.st[1] = nx; }
        const unsigned old = xb_add(&bar[XB_XSUB(b.x)], 1u);
        const unsigned gen = old / nloc;
        if (old + 1u == (gen + 1u) * nloc) {
            __builtin_amdgcn_fence(__ATOMIC_RELEASE, "agent");
            asm volatile("s_waitcnt vmcnt(0)" ::: "memory");
            const unsigned og = xb_add(&bar[XB_TOP], 1u);
            const unsigned tg = og / nx;
            if (og + 1u == (tg + 1u) * nx) xb_add(&bar[XB_TOPGEN], 1u);
            else XB_SPIN(xb_ld(&bar[XB_TOPGEN]) == tg, bar);
            __builtin_amdgcn_fence(__ATOMIC_ACQUIRE, "agent");
            xb_add(&bar[XB_XGEN(b.x)], 1u);
            asm volatile("s_waitcnt vmcnt(0)" ::: "memory");
        } else {
            XB_SPIN(xb_ld(&bar[XB_XGEN(b.x)]) == gen, bar);
            __builtin_amdgcn_fence(__ATOMIC_ACQUIRE, "agent");
            asm volatile("s_waitcnt vmcnt(0)" ::: "memory");
        }
    }
    __syncthreads();
}

struct Args { const float* in[22]; float* out; unsigned char* ws; int ph_lo, ph_hi; };
struct Frame {
    LAS unsigned char* lds; unsigned char* ws; unsigned* ctl;
    int tid, lane, wave, vcu, G;
};
enum { I_X = 0, I_C, I_CTX, I_CCTX, I_WADA, I_BADA, I_WIN, I_WPG, I_PSCALE, I_WPB, I_WAB, I_SINK, I_WO, I_LN1G, I_LN1B, I_WR, I_RB, I_WEG, I_WEU, I_WED, I_LN2G, I_LN2B };

template <int CTRL> __device__ __forceinline__ float dppf(float v) { return __builtin_bit_cast(float, __builtin_amdgcn_update_dpp(0, __builtin_bit_cast(int, v), CTRL, 0xf, 0xf, true)); }
template <int CTRL> __device__ __forceinline__ int dppi(int v) { return __builtin_amdgcn_update_dpp(0, v, CTRL, 0xf, 0xf, true); }
__device__ __forceinline__ float xor4f(float v) { return dppf<0x1B>(dppf<0x141>(v)); }
__device__ __forceinline__ int xor4i(int v) { return dppi<0x1B>(dppi<0x141>(v)); }
__device__ __forceinline__ float wave_sum(float v) {
#pragma unroll
    for (int o = 1; o < 64; o <<= 1) v += __shfl_xor(v, o);
    return v;
}
__device__ __forceinline__ void ln_stats(const f32x4 (&v)[4], float& mean, float& rstd) {
    float s = 0.f, q = 0.f;
#pragma unroll
    for (int j = 0; j < 4; ++j) { s += (v[j].x + v[j].y) + (v[j].z + v[j].w); q += (v[j].x * v[j].x + v[j].y * v[j].y) + (v[j].z * v[j].z + v[j].w * v[j].w); }
    s += dppf<0xB1>(s); q += dppf<0xB1>(q); s += dppf<0x4E>(s); q += dppf<0x4E>(q); s += dppf<0x141>(s); q += dppf<0x141>(q); s += dppf<0x140>(s); q += dppf<0x140>(q);
    s += __shfl_xor(s, 16); q += __shfl_xor(q, 16); s += __shfl_xor(s, 32); q += __shfl_xor(q, 32);
    mean = s * (1.f / D);
    const float var = fmaxf(q * (1.f / D) - mean * mean, 0.f);
    rstd = 1.0f / sqrtf(var + LN_EPS);
}
__device__ __forceinline__ void load_row(const float* p, int lane, f32x4 (&v)[4]) {
#pragma unroll
    for (int j = 0; j < 4; ++j) v[j] = *(const f32x4*)(p + 256 * j + 4 * lane);
}
__device__ __forceinline__ void store_row(float* p, int lane, const f32x4 (&v)[4]) {
#pragma unroll
    for (int j = 0; j < 4; ++j) *(f32x4*)(p + 256 * j + 4 * lane) = v[j];
}
__device__ __forceinline__ void store_row_bf16(bf16* p, int lane, const f32x4 (&v)[4]) {
#pragma unroll
    for (int j = 0; j < 4; ++j) { u32x2 w; w.x = cvt_pk_bf16(v[j].x, v[j].y); w.y = cvt_pk_bf16(v[j].z, v[j].w); *(u32x2*)(p + 256 * j + 4 * lane) = w; }
}
__device__ __forceinline__ void load_vec(const float* p, int lane, f32x4 (&v)[4]) {
#pragma unroll
    for (int j = 0; j < 4; ++j) v[j] = *(const f32x4*)(p + 256 * j + 4 * lane);
}
__device__ __forceinline__ void pin_vec(f32x4 (&v)[4]) {
#pragma unroll
    for (int j = 0; j < 4; ++j) asm volatile("" : "+v"(v[j]));
}
__device__ __forceinline__ int row_vec(int row) { return row < NL ? (row >> 14) : 2; }
__device__ __forceinline__ const float* ada_vec(const Frame& F, int layer, int vec, int chunk) { return (const float*)(F.ws + WS_ADAP) + ((size_t)(layer * 3 + vec) * 6 + chunk) * D; }
__device__ __forceinline__ void load_ada(const float* p, int lane, f32x4 (&v)[4]) { load_vec(p, lane, v); }
__device__ __forceinline__ void modulate_store(const f32x4 (&v)[4], const float* sh, const float* sc, bf16* out, int lane) {
    float mean, rstd; ln_stats(v, mean, rstd);
    f32x4 h[4];
#pragma unroll
    for (int j = 0; j < 4; ++j) { const f32x4 s1 = *(const f32x4*)(sc + 256 * j + 4 * lane), s0 = *(const f32x4*)(sh + 256 * j + 4 * lane); h[j] = (v[j] - mean) * rstd * (s1 + 1.0f) + s0; }
    store_row_bf16(out, lane, h);
}

__device__ __forceinline__ void transpose_item(const float* W, int K, int N, bf16* WT, int k0, int n0, bool perm, LAS float* scr, int lane, int ldk = 0, int kd0 = -1) {
    if (ldk == 0) ldk = K; if (kd0 < 0) kd0 = k0;
    f32x4 r[16];
#pragma unroll
    for (int q = 0; q < 16; ++q) r[q] = *(const f32x4*)(W + (size_t)(k0 + 4 * q + (lane >> 4)) * N + n0 + 4 * (lane & 15));
#pragma unroll
    for (int hf = 0; hf < 2; ++hf) {
#pragma unroll
        for (int q = 0; q < 8; ++q) { const int kk = 4 * q + (lane >> 4); LAS float* d = scr + kk * 65 + 4 * (lane & 15); const f32x4 x = r[hf * 8 + q]; d[0] = x.x; d[1] = x.y; d[2] = x.z; d[3] = x.w; }
        LDS_WAIT(); asm volatile("" ::: "memory");
        const int c = lane & 3;
#pragma unroll
        for (int i = 0; i < 4; ++i) {
            const int n = (lane >> 2) + 16 * i;
            int ns = n;
            if (perm) { const int hh = n >> 5, rem = n & 31; ns = 32 * hh + 16 * (rem & 1) + (rem >> 1); }
            const LAS float* s = scr + (8 * c) * 65 + ns;
            u32x4 o; o.x = cvt_pk_bf16(s[0 * 65], s[1 * 65]); o.y = cvt_pk_bf16(s[2 * 65], s[3 * 65]); o.z = cvt_pk_bf16(s[4 * 65], s[5 * 65]); o.w = cvt_pk_bf16(s[6 * 65], s[7 * 65]);
            *(u32x4*)(WT + (size_t)(n0 + n) * ldk + kd0 + 32 * hf + 8 * c) = o;
        }
        LDS_WAIT(); asm volatile("" ::: "memory");
    }
}
__device__ __forceinline__ float silu_f(float x) { return x / (1.0f + expf(-x)); }
struct TDesc { const float* src; bf16* dst; int N, ldk, k0, kd0, n0, perm; };
__device__ __forceinline__ void t_load(const TDesc& d, int lane, f32x4 (&r)[16]) {
#pragma unroll
    for (int q = 0; q < 16; ++q) r[q] = *(const f32x4*)(d.src + (size_t)(d.k0 + 4 * q + (lane >> 4)) * d.N + d.n0 + 4 * (lane & 15));
}
__device__ __forceinline__ void t_process(const TDesc& d, int lane, const f32x4 (&r)[16], LAS float* scr) {
#pragma unroll
    for (int hf = 0; hf < 2; ++hf) {
#pragma unroll
        for (int q = 0; q < 8; ++q) { const int kk = 4 * q + (lane >> 4); LAS float* p = scr + kk * 65 + 4 * (lane & 15); const f32x4 x = r[hf * 8 + q]; p[0] = x.x; p[1] = x.y; p[2] = x.z; p[3] = x.w; }
        LDS_WAIT(); asm volatile("" ::: "memory");
        const int c = lane & 3;
#pragma unroll
        for (int i = 0; i < 4; ++i) {
            const int n = (lane >> 2) + 16 * i;
            int ns = n;
            if (d.perm) { const int hh = n >> 5, rem = n & 31; ns = 32 * hh + 16 * (rem & 1) + (rem >> 1); }
            const LAS float* sp = scr + (8 * c) * 65 + ns;
            u32x4 o; o.x = cvt_pk_bf16(sp[0 * 65], sp[1 * 65]); o.y = cvt_pk_bf16(sp[2 * 65], sp[3 * 65]); o.z = cvt_pk_bf16(sp[4 * 65], sp[5 * 65]); o.w = cvt_pk_bf16(sp[6 * 65], sp[7 * 65]);
            *(u32x4*)(d.dst + (size_t)(d.n0 + n) * d.ldk + d.kd0 + 32 * hf + 8 * c) = o;
        }
        LDS_WAIT(); asm volatile("" ::: "memory");
    }
}
template <class AT> __device__ __forceinline__ TDesc t_decode(Frame& F, AT& a, int r) {
    constexpr int I_WINn = 2 * 16 * 52, I_WPGn = 2 * 4 * 2 * 2, I_WPBn = 2 * 8 * 16, I_WOn = 2 * 16 * 16, I_EXn = 64 * 256;
    TDesc d; d.perm = 0; d.src = nullptr; d.dst = nullptr; d.N = 0; d.ldk = 0; d.k0 = 0; d.kd0 = 0; d.n0 = 0;
    if (r < I_WINn) { const int l = r / 832, q = r % 832, kb = q / 52, nb = q % 52; d.src = a.in[I_WIN] + (size_t)l * D * IN_COLS; d.dst = (bf16*)(F.ws + WS_WIN) + (size_t)l * IN_COLS * D; d.N = IN_COLS; d.ldk = D; d.k0 = 64 * kb; d.kd0 = d.k0; d.n0 = 64 * nb; d.perm = (d.n0 >= 512 && d.n0 < 1152) ? 1 : 0; return d; }
    r -= I_WINn;
    if (r < I_WPGn) { const int m = r / 4, q = r % 4; d.src = a.in[I_WPG] + (size_t)m * 128 * 128; d.dst = (bf16*)(F.ws + WS_WPG) + (size_t)m * 128 * 128; d.N = 128; d.ldk = 128; d.k0 = 64 * (q >> 1); d.kd0 = d.k0; d.n0 = 64 * (q & 1); return d; }
    r -= I_WPGn;
    if (r < 2 * I_WPBn) { const int second = r >= I_WPBn; if (second) r -= I_WPBn; const int l = r / 128, q = r % 128; d.src = a.in[second ? I_WAB : I_WPB] + (size_t)l * 512 * D; d.dst = (bf16*)(F.ws + WS_WPB) + (size_t)l * D * D; d.N = D; d.ldk = D; d.k0 = 64 * (q / 16); d.kd0 = (second ? 512 : 0) + d.k0; d.n0 = 64 * (q % 16); return d; }
    r -= 2 * I_WPBn;
    if (r < I_WOn) { const int l = r / 256, q = r % 256; d.src = a.in[I_WO] + (size_t)l * D * D; d.dst = (bf16*)(F.ws + WS_WO) + (size_t)l * D * D; d.N = D; d.ldk = D; d.k0 = 64 * (q / 16); d.kd0 = d.k0; d.n0 = 64 * (q % 16); return d; }
    r -= I_WOn;
    { const int which = r / I_EXn, q = r % I_EXn, m = q / 256, t = q % 256;
      d.src = a.in[which == 0 ? I_WEG : (which == 1 ? I_WEU : I_WED)] + (size_t)m * D * D;
      d.dst = (bf16*)(F.ws + (which == 0 ? WS_WEG : (which == 1 ? WS_WEU : WS_WED))) + (size_t)m * D * D;
      d.N = D; d.ldk = D; d.k0 = 64 * (t / 16); d.kd0 = d.k0; d.n0 = 64 * (t % 16); }
    return d;
}
template <class AT> __device__ __forceinline__ void phase_pre(Frame& F, AT& a, bool with_experts) {
    LAS float* scr = (LAS float*)(F.lds + F.wave * 8448);
    const int gw = F.vcu * 8 + F.wave, NGW = F.G * 8;
    { float* tab = (float*)(F.ws + WS_ROPE);
      for (int idx = blockIdx.x * 512 + F.tid; idx < 320 * 16; idx += F.G * 512) {
          const int p = idx >> 4, i = idx & 15; const int pos = p < 256 ? p : p - 256;
          const float inv = powf(10000.0f, -(float)i / 16.0f); const float ang = (float)pos * inv;
          tab[2 * idx] = cosf(ang); tab[2 * idx + 1] = sinf(ang); } }
    { const float* wr = a.in[I_WR]; float* wt = (float*)(F.ws + WS_WRT);
      for (int idx = blockIdx.x * 512 + F.tid; idx < D * NEXP; idx += F.G * 512) { const int c = idx >> 5, e = idx & 31; wt[e * D + c] = wr[idx]; } }
    if (F.vcu < 48) {
        const int l = F.vcu / 24, cg = F.vcu % 24, kc = F.wave; const int col = cg * 256 + 4 * F.lane;
        const float* W = a.in[I_WADA] + (size_t)l * D * 6144 + col;
        f32x4 a0 = {0.f, 0.f, 0.f, 0.f}, a1 = a0, a2 = a0;
        for (int kb = kc * 128; kb < kc * 128 + 128; kb += 16) {
            f32x4 w[16];
#pragma unroll
            for (int i = 0; i < 16; ++i) w[i] = *(const f32x4*)(W + (size_t)(kb + i) * 6144);
            const int kl = kb + (F.lane & 15);
            const float m0 = silu_f(a.in[I_C][kl]), m1 = silu_f(a.in[I_C][D + kl]), m2 = silu_f(a.in[I_CCTX][kl]);
#pragma unroll
            for (int i = 0; i < 16; ++i) {
                const float s0 = __builtin_bit_cast(float, __builtin_amdgcn_readlane(__builtin_bit_cast(int, m0), i)), s1 = __builtin_bit_cast(float, __builtin_amdgcn_readlane(__builtin_bit_cast(int, m1), i)), s2 = __builtin_bit_cast(float, __builtin_amdgcn_readlane(__builtin_bit_cast(int, m2), i));
                a0 += w[i] * s0; a1 += w[i] * s1; a2 += w[i] * s2; }
        }
        LAS f32x4* part = (LAS f32x4*)(F.lds + 69632);
        part[(kc * 3 + 0) * 64 + F.lane] = a0; part[(kc * 3 + 1) * 64 + F.lane] = a1; part[(kc * 3 + 2) * 64 + F.lane] = a2;
        __syncthreads();
        if (F.tid < 192) { const int v = F.tid >> 6, ln = F.tid & 63;
            f32x4 sum = part[(0 * 3 + v) * 64 + ln];
#pragma unroll
            for (int w8 = 1; w8 < 8; ++w8) sum += part[(w8 * 3 + v) * 64 + ln];
            sum += *(const f32x4*)(a.in[I_BADA] + (size_t)l * 6144 + cg * 256 + 4 * ln);
            *(f32x4*)((float*)(F.ws + WS_ADAP) + (size_t)(l * 3 + v) * 6144 + cg * 256 + 4 * ln) = sum; }
        __syncthreads();
    }
    constexpr int I_SMALL = 2 * 16 * 52 + 2 * 4 * 2 * 2 + 2 * 2 * 8 * 16 + 2 * 16 * 16, I_EXn = 64 * 256;
    const int NT = I_SMALL + (with_experts ? 3 * I_EXn : 0);
    int it = gw;
    if (it < NT) {
        f32x4 rc[16]; { const TDesc d0 = t_decode(F, a, it); t_load(d0, F.lane, rc); }
        for (;;) {
            const int nx = it + NGW; const bool more = nx < NT;
            f32x4 rn[16];
            if (more) { const TDesc nd = t_decode(F, a, nx); t_load(nd, F.lane, rn); }
            { const TDesc cd = t_decode(F, a, it); t_process(cd, F.lane, rc, scr); }
            if (!more) break;
            it = nx;
#pragma unroll
            for (int q = 0; q < 16; ++q) rc[q] = rn[q];
        }
    }
}
template <class AT> __device__ __forceinline__ void bg_item(Frame& F, AT& a, int it, LAS float* scr) {
    const int layer = it / BG_PER_LAYER, r = it % BG_PER_LAYER, which = r >> 13, q = r & 8191, m = layer * 32 + (q >> 8), t = q & 255;
    const float* src = a.in[which == 0 ? I_WEG : (which == 1 ? I_WEU : I_WED)] + (size_t)m * D * D;
    bf16* dst = (bf16*)(F.ws + (which == 0 ? WS_WEG : (which == 1 ? WS_WEU : WS_WED))) + (size_t)m * D * D;
    transpose_item(src, D, D, dst, 64 * (t / 16), 64 * (t % 16), false, scr, F.lane);
}
template <class AT> __device__ __forceinline__ TDesc bg_desc(Frame& F, AT& a, int it) {
    const int layer = it / BG_PER_LAYER, r = it % BG_PER_LAYER, which = r >> 13, q = r & 8191, m = layer * 32 + (q >> 8), t = q & 255;
    TDesc d; d.perm = 0;
    d.src = a.in[which == 0 ? I_WEG : (which == 1 ? I_WEU : I_WED)] + (size_t)m * D * D;
    d.dst = (bf16*)(F.ws + (which == 0 ? WS_WEG : (which == 1 ? WS_WEU : WS_WED))) + (size_t)m * D * D;
    d.N = D; d.ldk = D; d.k0 = 64 * (t / 16); d.kd0 = d.k0; d.n0 = 64 * (t % 16);
    return d;
}
template <class AT> __device__ __forceinline__ void seam_fill(Frame& F, AT& a, int k, int drain_limit) {
    LAS int* slot = (LAS int*)(F.lds + MISC_OFF + L_QSLOT);
    LAS float* scr = (LAS float*)(F.lds + F.wave * 8448);
    __syncthreads();
    if (F.tid == 0) (void)__hip_atomic_fetch_add(F.ctl + CW_PHDONE + 64 * k, 1u, RLX_AGENT);
    for (;;) {
        if (F.tid == 0) {
            int base = 0x7fffffff, cnt = 0;
            const int head = (int)__hip_atomic_load(F.ctl + CW_QHEAD, RLX_AGENT);
            if (head < drain_limit) { cnt = 64; base = (int)__hip_atomic_fetch_add(F.ctl + CW_QHEAD, 64u, RLX_AGENT); }
            else if (head < BG_TOTAL && (int)__hip_atomic_load(F.ctl + CW_PHDONE + 64 * k, RLX_AGENT) < F.G) { cnt = 8; base = (int)__hip_atomic_fetch_add(F.ctl + CW_QHEAD, 8u, RLX_AGENT); }
            slot[0] = base; slot[1] = cnt;
        }
        __syncthreads();
        const int base = slot[0], cnt = slot[1];
        if (base >= BG_TOTAL) break;
        int it = base + F.wave; const int end = (base + cnt < BG_TOTAL) ? base + cnt : BG_TOTAL;
        if (it < end) {
            f32x4 rc[16]; { const TDesc d0 = bg_desc(F, a, it); t_load(d0, F.lane, rc); }
            for (;;) {
                const int nx = it + 8; const bool more = nx < end;
                f32x4 rn[16];
                if (more) { const TDesc nd = bg_desc(F, a, nx); t_load(nd, F.lane, rn); }
                { const TDesc cd = bg_desc(F, a, it); t_process(cd, F.lane, rc, scr); }
                if (!more) break;
                it = nx;
#pragma unroll
                for (int q = 0; q < 16; ++q) rc[q] = rn[q];
            }
        }
        __syncthreads();
    }
}

template <class AT> __device__ __forceinline__ void phase_h0(Frame& F, AT& a) {
    const int gw = F.vcu * 8 + F.wave, NGW = F.G * 8;
    f32x4 psh[4], psc[4]; int cvec = -1;
    f32x4 nv[4]; int row = gw;
    if (row < MT) load_row(row < NL ? a.in[I_X] + (size_t)row * D : a.in[I_CTX] + (size_t)(row - NL) * D, F.lane, nv);
    while (row < MT) {
      { const int vec = row_vec(row); cvec = vec; load_ada(ada_vec(F, 0, vec, 0), F.lane, psh); load_ada(ada_vec(F, 0, vec, 1), F.lane, psc); pin_vec(psh); pin_vec(psc); }
      const int seg_hi = cvec == 0 ? SEQ : (cvec == 1 ? NL : MT);
      while (row < seg_hi) {
        f32x4 v[4];
#pragma unroll
        for (int j = 0; j < 4; ++j) v[j] = nv[j];
        const int nrow = row + NGW;
        if (nrow < MT) load_row(nrow < NL ? a.in[I_X] + (size_t)nrow * D : a.in[I_CTX] + (size_t)(nrow - NL) * D, F.lane, nv);
        __builtin_amdgcn_sched_barrier(0);
        { float mean, rstd; ln_stats(v, mean, rstd); f32x4 hh[4];
#pragma unroll
          for (int j = 0; j < 4; ++j) hh[j] = (v[j] - mean) * rstd * (psc[j] + 1.0f) + psh[j];
          store_row_bf16((bf16*)(F.ws + WS_H) + (size_t)row * D, F.lane, hh); }
        row = nrow;
      }
    }
}

struct PlainOrder {
    const char* A; const char* Bt; int K, nM, nN, nwg, G, c, exN, exPm0, exPn;
    __device__ __forceinline__ void init(const void* A_, const void* Bt_, int K_, int nM_, int nN_, int G_, int c_) { A = (const char*)A_; Bt = (const char*)Bt_; K = K_; nM = nM_; nN = nN_; nwg = nM * nN; G = G_; c = c_; exN = 0; exPm0 = 0; exPn = 0; }
    __device__ __forceinline__ bool next(int i, Unit& u) const {
        int L = i * G + c; u.e = 0; u.x0 = 0; u.x1 = 0;
        if (L >= nwg) { L -= nwg; if (L < exN) { u.pm = exPm0 + L; u.pn = exPn; return true; } return false; }
        int wgid = L; { const int q = nwg / 8, r = nwg % 8, xcd = wgid % 8, off = wgid / 8; wgid = (xcd < r ? xcd * (q + 1) : r * (q + 1) + (xcd - r) * q) + off; }
        const int nig = 8 * nN, gid = wgid / nig, fm = gid * 8, gsz = (nM - fm) < 8 ? (nM - fm) : 8;
        u.pm = fm + ((wgid % nig) % gsz); u.pn = (wgid % nig) / gsz; return true;
    }
    __device__ __forceinline__ unsigned a_off(const Unit& u, int R) const { return (unsigned)(u.pm * 256 + R) * (unsigned)(K * 2); }
    __device__ __forceinline__ void b_ptr(const Unit& u, const char*& b0, const char*& b1) const { b0 = Bt + (size_t)u.pn * 256 * K * 2; b1 = b0 + (size_t)128 * K * 2; }
};
struct InProjOrder : PlainOrder {
    __device__ __forceinline__ void b_ptr(const Unit& u, const char*& b0, const char*& b1) const {
        if (u.pn < 5) { b0 = Bt + (size_t)u.pn * 256 * K * 2; b1 = b0 + (size_t)128 * K * 2; }
        else { b0 = Bt + (size_t)(1280 + 128 * (u.pn - 5)) * K * 2; b1 = Bt + (size_t)(2304 + 128 * (u.pn - 5)) * K * 2; }
    }
};
template <bool GATHER> struct MoeOrder {
    const char* A; const char* B0; const char* B1; int NPN, G, vcu; const LAS int* blk; const LAS int* cnt; const int* list;
    __device__ __forceinline__ bool next(int i, Unit& u) const {
        const int L = i * G + vcu; const int NB = blk[32];
        if (L >= NB * NPN) return false;
        const int rbg = L / NPN; u.pn = L % NPN; int e = (i > 0) ? u.e : 0;
        if (e < 0 || e > 31 || rbg < blk[e]) e = 0;
        while (e < 31 && rbg >= blk[e + 1]) ++e;
        const int rb = rbg - blk[e]; u.pm = rbg; u.e = e; u.x0 = e * LCAP + rb * 256; u.x1 = cnt[e] - rb * 256; return true;
    }
    __device__ __forceinline__ unsigned a_off(const Unit& u, int R) const {
        if (GATHER) { int tok = list[u.x0 + R]; tok = (R < u.x1) ? tok : 0; return (unsigned)tok * 2048u; }
        return (unsigned)(u.pm * 256 + R) * 2048u;
    }
    __device__ __forceinline__ void b_ptr(const Unit& u, const char*& b0, const char*& b1) const {
        if (GATHER) { const size_t o = ((size_t)u.e * 1024 + (size_t)u.pn * 128) * 2048; b0 = B0 + o; b1 = B1 + o; }
        else { b0 = B0 + ((size_t)u.e * 1024 + (size_t)u.pn * 256) * 2048; b1 = b0 + (size_t)128 * 2048; }
    }
};

typedef const f32x4 (&AccRef)[2][2][4][2];
__device__ __forceinline__ void store8(bf16* p, const f32x4& a, const f32x4& b) { u32x4 w; w.x = cvt_pk_bf16(a.x, a.y); w.y = cvt_pk_bf16(a.z, a.w); w.z = cvt_pk_bf16(b.x, b.y); w.w = cvt_pk_bf16(b.z, b.w); *(u32x4*)p = w; }
struct EpiInProj {
    static constexpr bool PERM = true; static constexpr bool MID = false;
    bf16 *U, *Q, *Kb, *Vb, *GT; const float* rope;
    __device__ __forceinline__ void rot(f32x4& a, f32x4& b, const f32x4& c0, const f32x4& c1) const {
        const f32x4 ia = a, ib = b;
        a.x = ia.x * c0.x - ia.y * c0.y; a.y = ia.y * c0.x + ia.x * c0.y; a.z = ia.z * c0.z - ia.w * c0.w; a.w = ia.w * c0.z + ia.z * c0.w;
        b.x = ib.x * c1.x - ib.y * c1.y; b.y = ib.y * c1.x + ib.x * c1.y; b.z = ib.z * c1.z - ib.w * c1.w; b.w = ib.w * c1.z + ib.z * c1.w;
    }
    __device__ __forceinline__ void operator()(AccRef acc, const Unit& u, int wr, int wc, int fr, int fq) const {
        const int pn = u.pn; int rowb = u.pm * 256 + wr * 64 + fr; const int cl = wc * 32 + 8 * fq; asm volatile("" : "+v"(rowb));
        const bool lat = u.pm < 128;
        if (pn >= 2 && pn <= 4) {
#pragma unroll
            for (int ai = 0; ai < 2; ++ai) {
                f32x4 cs[4][2];
                if (lat) {
#pragma unroll
                    for (int m = 0; m < 4; ++m) { const int t = (rowb + ai * 128 + m * 16) & (SEQ - 1); const int p = (wc & 1) ? 256 + (t & 63) : (t >> 6);
                        cs[m][0] = *(const f32x4*)(rope + (size_t)(p * 16 + 4 * fq) * 2); cs[m][1] = *(const f32x4*)(rope + (size_t)(p * 16 + 4 * fq) * 2 + 4); }
#pragma unroll
                    for (int m = 0; m < 4; ++m) asm volatile("" : "+v"(cs[m][0]), "+v"(cs[m][1]));
                }
#pragma unroll
                for (int m = 0; m < 4; ++m) { const int row = rowb + ai * 128 + m * 16;
#pragma unroll
                    for (int bj = 0; bj < 2; ++bj) { f32x4 v0 = acc[ai][bj][m][0], v1 = acc[ai][bj][m][1];
                        if (pn < 4) { if (lat) rot(v0, v1, cs[m][0], cs[m][1]); v0 *= QSCALE; v1 *= QSCALE; store8(Q + (size_t)row * 512 + (pn - 2) * 256 + bj * 128 + cl, v0, v1); }
                        else if (bj == 0) { if (lat) rot(v0, v1, cs[m][0], cs[m][1]); store8(Kb + (size_t)row * 128 + cl, v0, v1); }
                        else store8(Vb + (size_t)row * 128 + cl, v0, v1); } }
            }
            return;
        }
#pragma unroll
        for (int ai = 0; ai < 2; ++ai)
#pragma unroll
            for (int m = 0; m < 4; ++m) {
                const int row = rowb + ai * 128 + m * 16;
#pragma unroll
                for (int bj = 0; bj < 2; ++bj) {
                    const f32x4 v0 = acc[ai][bj][m][0], v1 = acc[ai][bj][m][1];
                    if (pn < 2) { store8(U + (size_t)row * 512 + pn * 256 + bj * 128 + cl, v0, v1); }
                    else if (bj == 0) {
                        f32x4 a0 = acc[ai][1][m][0], a1 = acc[ai][1][m][1]; f32x4 r0, r1, g0, g1;
#pragma unroll
                        for (int j = 0; j < 4; ++j) { a0[j] = fmaxf(a0[j], -30.0f); a1[j] = fmaxf(a1[j], -30.0f); }
#pragma unroll
                        for (int j = 0; j < 4; ++j) { const float ea0 = __builtin_amdgcn_exp2f(-a0[j] * LOG2E), ea1 = __builtin_amdgcn_exp2f(-a1[j] * LOG2E);
                            g0[j] = __builtin_amdgcn_rcpf(1.0f + ea0); g1[j] = __builtin_amdgcn_rcpf(1.0f + ea1);
                            r0[j] = sigmoid_fast(v0[j]) * (1.0f + ea0); r1[j] = sigmoid_fast(v1[j]) * (1.0f + ea1); }
                        store8(GT + (size_t)row * 2048 + (pn - 5) * 128 + cl, r0, r1); store8(GT + (size_t)row * 2048 + 1024 + (pn - 5) * 128 + cl, g0, g1); }
                }
            }
    }
};
__device__ __forceinline__ void load8(const bf16* p, f32x4& a, f32x4& b) { const u32x4 w = *(const u32x4*)p; a = (f32x4){bf_lo(w.x), bf_hi(w.x), bf_lo(w.y), bf_hi(w.y)}; b = (f32x4){bf_lo(w.z), bf_hi(w.z), bf_lo(w.w), bf_hi(w.w)}; }
struct EpiMergeOne {
    static constexpr bool PERM = true; static constexpr bool MID = true;
    const bf16* GT; bf16* G;
    __device__ __forceinline__ void mid(f32x4 (&acc)[2][2][4][2], const Unit& u, int wr, int wc, int fr, int fq) const {
        int rowb = u.pm * 256 + wr * 64 + fr; const int colb = u.pn * 256 + wc * 32 + 8 * fq; asm volatile("" : "+v"(rowb));
        const bf16* gp = GT + (size_t)rowb * 2048 + colb;
        u32x4 g[2][4][2];
#pragma unroll
        for (int ai = 0; ai < 2; ++ai)
#pragma unroll
            for (int m = 0; m < 4; ++m)
#pragma unroll
                for (int bj = 0; bj < 2; ++bj) g[ai][m][bj] = *(const u32x4*)(gp + (size_t)(ai * 128 + m * 16) * 2048 + bj * 128);
#pragma unroll
        for (int ai = 0; ai < 2; ++ai)
#pragma unroll
            for (int m = 0; m < 4; ++m)
#pragma unroll
                for (int bj = 0; bj < 2; ++bj) asm volatile("" : "+v"(g[ai][m][bj]));
#pragma unroll
        for (int ai = 0; ai < 2; ++ai)
#pragma unroll
            for (int m = 0; m < 4; ++m)
#pragma unroll
                for (int bj = 0; bj < 2; ++bj) { const u32x4 w = g[ai][m][bj];
                    acc[ai][bj][m][0] *= (f32x4){bf_lo(w.x), bf_hi(w.x), bf_lo(w.y), bf_hi(w.y)}; acc[ai][bj][m][1] *= (f32x4){bf_lo(w.z), bf_hi(w.z), bf_lo(w.w), bf_hi(w.w)}; }
    }
    __device__ __forceinline__ void operator()(AccRef acc, const Unit& u, int wr, int wc, int fr, int fq) const {
        int rowb = u.pm * 256 + wr * 64 + fr; const int colb = u.pn * 256 + wc * 32 + 8 * fq; asm volatile("" : "+v"(rowb));
        const bf16* gp = GT + (size_t)rowb * 2048 + 1024 + colb;
        u32x4 g[2][4][2];
#pragma unroll
        for (int ai = 0; ai < 2; ++ai)
#pragma unroll
            for (int m = 0; m < 4; ++m)
#pragma unroll
                for (int bj = 0; bj < 2; ++bj) g[ai][m][bj] = *(const u32x4*)(gp + (size_t)(ai * 128 + m * 16) * 2048 + bj * 128);
#pragma unroll
        for (int ai = 0; ai < 2; ++ai)
#pragma unroll
            for (int m = 0; m < 4; ++m)
#pragma unroll
                for (int bj = 0; bj < 2; ++bj) asm volatile("" : "+v"(g[ai][m][bj]));
#pragma unroll
        for (int ai = 0; ai < 2; ++ai)
#pragma unroll
            for (int m = 0; m < 4; ++m) { const int row = rowb + ai * 128 + m * 16;
#pragma unroll
                for (int bj = 0; bj < 2; ++bj) { const int col = colb + bj * 128; const u32x4 w = g[ai][m][bj];
                    const f32x4 g0 = {bf_lo(w.x), bf_hi(w.x), bf_lo(w.y), bf_hi(w.y)}, g1 = {bf_lo(w.z), bf_hi(w.z), bf_lo(w.w), bf_hi(w.w)};
                    store8(G + (size_t)row * D + col, acc[ai][bj][m][0] * g0, acc[ai][bj][m][1] * g1); } }
    }
};
struct EpiGateUp {
    static constexpr bool PERM = true; static constexpr bool MID = false;
    bf16* ACT;
    __device__ __forceinline__ void operator()(AccRef acc, const Unit& u, int wr, int wc, int fr, int fq) const {
        const int rowb = u.pm * 256 + wr * 64 + fr, col = u.pn * 128 + wc * 32 + 8 * fq;
#pragma unroll
        for (int ai = 0; ai < 2; ++ai)
#pragma unroll
            for (int m = 0; m < 4; ++m) {
                const int row = rowb + ai * 128 + m * 16; f32x4 o[2];
#pragma unroll
                for (int n = 0; n < 2; ++n)
#pragma unroll
                    for (int j = 0; j < 4; ++j) { const float g = acc[ai][0][m][n][j]; o[n][j] = g * sigmoid_fast(g) * acc[ai][1][m][n][j]; }
                store8(ACT + (size_t)row * D + col, o[0], o[1]);
            }
    }
};
struct EpiPlainBf16 {
    static constexpr bool PERM = true; static constexpr bool MID = false;
    bf16* O;
    __device__ __forceinline__ void operator()(AccRef acc, const Unit& u, int wr, int wc, int fr, int fq) const {
        const int rowb = u.pm * 256 + wr * 64 + fr, colb = u.pn * 256 + wc * 32 + 8 * fq;
#pragma unroll
        for (int ai = 0; ai < 2; ++ai)
#pragma unroll
            for (int m = 0; m < 4; ++m) {
                const int row = rowb + ai * 128 + m * 16;
#pragma unroll
                for (int bj = 0; bj < 2; ++bj) store8(O + (size_t)row * D + colb + bj * 128, acc[ai][bj][m][0], acc[ai][bj][m][1]);
            }
    }
};

template <int MODE> __device__ __forceinline__ void ctx_gemm(Frame& F, const bf16* A, const bf16* Bt, const bf16* GT, bf16* O) {
    const int lane = F.lane, i16 = lane & 15, kq = lane >> 4;
    const int rg = F.vcu >> 5, cg = F.vcu & 31;
    if (F.vcu >= 256) return;
    const int row = NL + 64 * rg + 16 * (F.wave & 3) + i16, n0 = 32 * cg + 16 * (F.wave >> 2);
    const bf16* ap = A + (size_t)row * D + 8 * kq; const bf16* bp = Bt + (size_t)(n0 + i16) * D + 8 * kq;
    f32x4 acc = {0.f, 0.f, 0.f, 0.f};
#pragma unroll 1
    for (int kb = 0; kb < 4; ++kb) {
        bf16x8 af[8], bfg[8];
#pragma unroll
        for (int s = 0; s < 8; ++s) { af[s] = *(const bf16x8*)(ap + 256 * kb + 32 * s); bfg[s] = *(const bf16x8*)(bp + 256 * kb + 32 * s); }
        if (MODE == 0 && kb == 2) { const int col = n0 + 4 * kq; const u32x2 w = *(const u32x2*)(GT + (size_t)row * 2048 + col);
            acc *= (f32x4){bf_lo(w.x), bf_hi(w.x), bf_lo(w.y), bf_hi(w.y)}; }
#pragma unroll
        for (int s = 0; s < 8; ++s) acc = __builtin_amdgcn_mfma_f32_16x16x32_bf16(bfg[s], af[s], acc, 0, 0, 0);
    }
    const int col = n0 + 4 * kq;
    if (MODE == 0) { const u32x2 w = *(const u32x2*)(GT + (size_t)row * 2048 + 1024 + col); acc *= (f32x4){bf_lo(w.x), bf_hi(w.x), bf_lo(w.y), bf_hi(w.y)}; }
    u32x2 o; o.x = cvt_pk_bf16(acc.x, acc.y); o.y = cvt_pk_bf16(acc.z, acc.w);
    *(u32x2*)(O + (size_t)row * D + col) = o;
}

template <class AT> __device__ __forceinline__ void pool_unit(Frame& F, AT& a, int layer, int rt, int g) {
    LAS float* P = (LAS float*)F.lds;
    const bf16* U = (const bf16*)(F.ws + WS_U);
    const int w = 2 << g;
    __syncthreads();
    { const int r = F.tid >> 3, c16 = (F.tid & 7) * 16; const int row = rt * 64 + r;
      int s0, len, t;
      if (row < NL) { s0 = row & ~(SEQ - 1); len = SEQ; t = row - s0; } else { s0 = NL + ((row - NL) & ~(CTX - 1)); len = CTX; t = row - s0; }
      int lo = t - w / 2, hi = t - w / 2 + w - 1; lo = lo < 0 ? 0 : lo; hi = hi > len - 1 ? len - 1 : hi;
      float sum[16];
#pragma unroll
      for (int j = 0; j < 16; ++j) sum[j] = 0.f;
      for (int tt = lo; tt <= hi; ++tt) { f32x4 x0, x1, x2, x3; const bf16* p = U + (size_t)(s0 + tt) * 512 + g * 128 + c16; load8(p, x0, x1); load8(p + 8, x2, x3);
#pragma unroll
          for (int j = 0; j < 4; ++j) { sum[j] += x0[j]; sum[4 + j] += x1[j]; sum[8 + j] += x2[j]; sum[12 + j] += x3[j]; } }
      const float inv = 1.0f / (float)(hi - lo + 1);
      f32x4 x0, x1, x2, x3; const bf16* p = U + (size_t)row * 512 + g * 128 + c16; load8(p, x0, x1); load8(p + 8, x2, x3);
#pragma unroll
      for (int j = 0; j < 4; ++j) { P[r * 128 + c16 + j] = sum[j] * inv - x0[j]; P[r * 128 + c16 + 4 + j] = sum[4 + j] * inv - x1[j]; P[r * 128 + c16 + 8 + j] = sum[8 + j] * inv - x2[j]; P[r * 128 + c16 + 12 + j] = sum[12 + j] * inv - x3[j]; } }
    __syncthreads();
    { const int d = F.tid & 127, rg = F.tid >> 7;
      const float* Wg = a.in[I_WPG] + ((size_t)(layer * 4 + g) * 128) * 128 + d;
      float acc[16];
#pragma unroll
      for (int j = 0; j < 16; ++j) acc[j] = 0.f;
      for (int c = 0; c < 128; ++c) { const float wv = Wg[(size_t)c * 128];
#pragma unroll
          for (int j = 0; j < 16; ++j) acc[j] += P[(rg * 16 + j) * 128 + c] * wv; }
      const float sc = a.in[I_PSCALE][layer * 512 + g * 128 + d];
      bf16* O = (bf16*)(F.ws + WS_PO);
#pragma unroll
      for (int j = 0; j < 16; ++j) O[(size_t)(rt * 64 + rg * 16 + j) * 1024 + g * 128 + d] = (bf16)(cvt_pk_bf16(acc[j] * sc, 0.f) & 0xffffu); }
}
template <class AT> __device__ __forceinline__ void attn_unit_simple(Frame& F, AT& a, int layer, int qrow0, int qpos0, int g, int lrow0, int jlo, int jhi, int crow0) {
    LAS float* Ks = (LAS float*)F.lds; LAS float* Vs = Ks + 64 * 64;
    const bf16* Q = (const bf16*)(F.ws + WS_Q); const bf16* Kb = (const bf16*)(F.ws + WS_K); const bf16* Vb = (const bf16*)(F.ws + WS_V);
    const int qi = F.tid & 127, r = F.tid >> 7, h = 4 * g + r; const int qrow = qrow0 + qi, qpos = qpos0 + qi;
    float q[64], o[64];
#pragma unroll
    for (int c = 0; c < 8; ++c) { f32x4 x0, x1; load8(Q + (size_t)qrow * 512 + h * 64 + 8 * c, x0, x1);
#pragma unroll
        for (int j = 0; j < 4; ++j) { q[8 * c + j] = x0[j]; q[8 * c + 4 + j] = x1[j]; } }
#pragma unroll
    for (int d = 0; d < 64; ++d) o[d] = 0.f;
    float m = a.in[I_SINK][layer * 8 + h] * LOG2E, l = 1.0f;
    const int nloc = jhi >= jlo ? jhi - jlo + 1 : 0;
    for (int ch = 0; ch < nloc + 4; ++ch) {
        const bool local = ch < nloc; const int j = jlo + ch;
        const int krow0 = local ? lrow0 + 64 * j : crow0 + 64 * (ch - nloc);
        __syncthreads();
        { const int key = F.tid >> 3, d8 = (F.tid & 7) * 8; f32x4 x0, x1;
          load8(Kb + (size_t)(krow0 + key) * 128 + g * 64 + d8, x0, x1); *(LAS f32x4*)(Ks + key * 64 + d8) = x0; *(LAS f32x4*)(Ks + key * 64 + d8 + 4) = x1;
          load8(Vb + (size_t)(krow0 + key) * 128 + g * 64 + d8, x0, x1); *(LAS f32x4*)(Vs + key * 64 + d8) = x0; *(LAS f32x4*)(Vs + key * 64 + d8 + 4) = x1; }
        __syncthreads();
#pragma unroll 1
        for (int kk = 0; kk < 64; ++kk) {
            const LAS float* kr = Ks + kk * 64; float dsum = 0.f;
#pragma unroll
            for (int d = 0; d < 64; d += 4) { const f32x4 kv = *(const LAS f32x4*)(kr + d); dsum += q[d] * kv.x + q[d + 1] * kv.y + q[d + 2] * kv.z + q[d + 3] * kv.w; }
            bool valid = true;
            if (local) { const int kpos = 64 * j + kk; const int df = qpos - kpos; valid = (df <= 128) && (df >= -128); }
            const float sc = valid ? dsum : -INFINITY;
            const float mn = fmaxf(m, sc), al = __builtin_amdgcn_exp2f(m - mn), p = __builtin_amdgcn_exp2f(sc - mn);
            l = l * al + p; m = mn;
            const LAS float* vr = Vs + kk * 64;
#pragma unroll
            for (int d = 0; d < 64; d += 4) { const f32x4 vv = *(const LAS f32x4*)(vr + d); o[d] = o[d] * al + p * vv.x; o[d + 1] = o[d + 1] * al + p * vv.y; o[d + 2] = o[d + 2] * al + p * vv.z; o[d + 3] = o[d + 3] * al + p * vv.w; }
        }
    }
    const float il = 1.0f / l; bf16* O = (bf16*)(F.ws + WS_PO) + (size_t)qrow * 1024 + 512 + h * 64;
#pragma unroll
    for (int c = 0; c < 8; ++c) { f32x4 x0, x1;
#pragma unroll
        for (int j = 0; j < 4; ++j) { x0[j] = o[8 * c + j] * il; x1[j] = o[8 * c + 4 + j] * il; }
        store8(O + 8 * c, x0, x1); }
}
typedef float f32x16 __attribute__((ext_vector_type(16)));
typedef short s16x4 __attribute__((ext_vector_type(4)));
typedef short v4i16_t __attribute__((ext_vector_type(4)));
constexpr int AK_STRIDE = 144, AV_STRIDE = 192, AK_BYTES = 64 * AK_STRIDE, AV_BYTES = 64 * AV_STRIDE, ABUF_BYTES = AK_BYTES + AV_BYTES;
#ifndef ATT_THR
#define ATT_THR 8.0f
#endif
template <class AT> __device__ __forceinline__ void attn_unit_mfma(Frame& F, AT& a, int layer, int qrow0, int qpos0, int g, int lrow0, int jlo, int jhi, int crow0) {
    const bf16* Q = (const bf16*)(F.ws + WS_Q); const bf16* Kb = (const bf16*)(F.ws + WS_K); const bf16* Vb = (const bf16*)(F.ws + WS_V);
    const int lane = F.lane, r32 = lane & 31, hi = lane >> 5, w = F.wave, r = w >> 1, hq = w & 1, h = 4 * g + r;
    bf16x8 qf[2][4];
#pragma unroll
    for (int qt = 0; qt < 2; ++qt)
#pragma unroll
        for (int s = 0; s < 4; ++s) qf[qt][s] = *(const bf16x8*)(Q + (size_t)(qrow0 + 64 * hq + 32 * qt + r32) * 512 + h * 64 + 16 * s + 8 * hi);
    f32x16 O[2][2];
#pragma unroll
    for (int dt = 0; dt < 2; ++dt)
#pragma unroll
        for (int qt = 0; qt < 2; ++qt)
#pragma unroll
            for (int i = 0; i < 16; ++i) O[dt][qt][i] = 0.f;
    const float sink2 = a.in[I_SINK][layer * 8 + h] * LOG2E;
    float m[2] = {sink2, sink2}, l[2]; l[0] = hi == 0 ? 1.0f : 0.0f; l[1] = l[0];
    const int nloc = jhi >= jlo ? jhi - jlo + 1 : 0, NT = nloc + 4;
    const int skey = F.tid >> 3, sc8 = F.tid & 7;
    const int qa = qpos0 + 64 * hq;
    u32x4 kreg, vreg;
    const unsigned lane_off = (unsigned)(skey * 128 + 8 * sc8) * 2u;
    { const int krow = nloc > 0 ? lrow0 + 64 * jlo : crow0;
      kreg = *(const u32x4*)((const char*)(Kb + (size_t)krow * 128 + g * 64) + lane_off); vreg = *(const u32x4*)((const char*)(Vb + (size_t)krow * 128 + g * 64) + lane_off); }
    __syncthreads();
    *(LAS u32x4*)(F.lds + skey * AK_STRIDE + sc8 * 16) = kreg; *(LAS u32x4*)(F.lds + AK_BYTES + skey * AV_STRIDE + sc8 * 16) = vreg;
    __syncthreads();
#pragma unroll 1
    for (int it = 0; it < NT; ++it) {
        const int bo = (it & 1) * ABUF_BYTES;
        if (it + 1 < NT) { const int krow = (it + 1 < nloc) ? lrow0 + 64 * (jlo + it + 1) : crow0 + 64 * (it + 1 - nloc);
            kreg = *(const u32x4*)((const char*)(Kb + (size_t)krow * 128 + g * 64) + lane_off); vreg = *(const u32x4*)((const char*)(Vb + (size_t)krow * 128 + g * 64) + lane_off); }
        int mode = 1; const int ka = 64 * (jlo + it);
        if (it < nloc) { if (ka - (qa + 63) > 128 || qa - (ka + 63) > 128) mode = 0; else if (ka + 63 - qa > 128 || qa + 63 - ka > 128) mode = 2; }
        if (mode != 0) {
            unsigned kbase = (unsigned)bo + (unsigned)(r32 * AK_STRIDE + 16 * hi), vbase = (unsigned)bo + (unsigned)(AK_BYTES + (4 * hi + ((lane & 15) >> 2)) * AV_STRIDE + (16 * ((lane >> 4) & 1) + 4 * (lane & 3)) * 2);
            asm volatile("" : "+v"(kbase), "+v"(vbase));
            const LAS unsigned char* Kl = F.lds + kbase; const LAS unsigned char* Vl = F.lds + vbase;
#define ATT_VLOAD(dst, kt_) do { _Pragma("unroll") for (int s2 = 0; s2 < 2; ++s2) _Pragma("unroll") for (int dt = 0; dt < 2; ++dt) { \
                const LAS unsigned char* vp = Vl + (32 * (kt_) + 16 * s2) * AV_STRIDE + (32 * dt) * 2; \
                const s16x4 lo = __builtin_bit_cast(s16x4, __builtin_amdgcn_ds_read_tr16_b64_v4i16((LAS v4i16_t*)vp)); \
                const s16x4 hh = __builtin_bit_cast(s16x4, __builtin_amdgcn_ds_read_tr16_b64_v4i16((LAS v4i16_t*)(vp + 8 * AV_STRIDE))); \
                dst[s2][dt] = (bf16x8){lo[0], lo[1], lo[2], lo[3], hh[0], hh[1], hh[2], hh[3]}; } } while (0)
#pragma unroll
            for (int qt = 0; qt < 2; ++qt) {
                f32x16 S0, S1;
#pragma unroll
                for (int i = 0; i < 16; ++i) { S0[i] = 0.f; S1[i] = 0.f; }
                { bf16x8 ka[4], kb[4];
#pragma unroll
                  for (int s = 0; s < 4; ++s) ka[s] = *(const LAS bf16x8*)(Kl + 32 * s);
#pragma unroll
                  for (int s = 0; s < 4; ++s) asm volatile("" : "+v"(ka[s]));
#pragma unroll
                  for (int s = 0; s < 4; ++s) kb[s] = *(const LAS bf16x8*)(Kl + 32 * AK_STRIDE + 32 * s);
#pragma unroll
                  for (int s = 0; s < 4; ++s) S0 = __builtin_amdgcn_mfma_f32_32x32x16_bf16(ka[s], qf[qt][s], S0, 0, 0, 0);
#pragma unroll
                  for (int s = 0; s < 4; ++s) asm volatile("" : "+v"(kb[s]));
#pragma unroll
                  for (int s = 0; s < 4; ++s) S1 = __builtin_amdgcn_mfma_f32_32x32x16_bf16(kb[s], qf[qt][s], S1, 0, 0, 0); }
                if (mode == 2) { const int qp = qa + 32 * qt + r32;
#pragma unroll
                    for (int i = 0; i < 16; ++i) { const int kp = ka + (i & 3) + 8 * (i >> 2) + 4 * hi; const int d0 = qp - kp, d1 = d0 - 32;
                        if (d0 > 128 || d0 < -128) S0[i] = -INFINITY; if (d1 > 128 || d1 < -128) S1[i] = -INFINITY; } }
                float ta = fmaxf(fmaxf(S0[0], S0[1]), S0[2]), tb = fmaxf(fmaxf(S1[0], S1[1]), S1[2]);
#pragma unroll
                for (int i = 3; i < 15; i += 2) { ta = fmaxf(fmaxf(ta, S0[i]), S0[i + 1]); tb = fmaxf(fmaxf(tb, S1[i]), S1[i + 1]); }
                float tmax = fmaxf(fmaxf(ta, tb), fmaxf(S0[15], S1[15]));
                tmax = fmaxf(tmax, __shfl_xor(tmax, 32));
                if (__any(tmax > m[qt] + ATT_THR)) {
                    const float mn = fmaxf(m[qt], tmax), al = __builtin_amdgcn_exp2f(m[qt] - mn);
                    l[qt] *= al; m[qt] = mn;
#pragma unroll
                    for (int i = 0; i < 16; ++i) { O[0][qt][i] *= al; O[1][qt][i] *= al; }
                }
                const float mm = m[qt]; const f32x2 nm2 = {-mm, -mm}; f32x2 ls2 = {0.f, 0.f};
#pragma unroll
                for (int i = 0; i < 16; i += 2) {
                    f32x2 a0 = (f32x2){S0[i], S0[i + 1]} + nm2, a1 = (f32x2){S1[i], S1[i + 1]} + nm2;
                    a0.x = __builtin_amdgcn_exp2f(a0.x); a0.y = __builtin_amdgcn_exp2f(a0.y); a1.x = __builtin_amdgcn_exp2f(a1.x); a1.y = __builtin_amdgcn_exp2f(a1.y);
                    S0[i] = a0.x; S0[i + 1] = a0.y; S1[i] = a1.x; S1[i + 1] = a1.y; ls2 += a0; ls2 += a1; }
                l[qt] += ls2.x + ls2.y;
                bf16x8 pf[2][2];
#pragma unroll
                for (int s2 = 0; s2 < 2; ++s2) {
                    u32x4 p0, p1;
                    p0.x = cvt_pk_bf16(S0[8 * s2 + 0], S0[8 * s2 + 1]); p0.y = cvt_pk_bf16(S0[8 * s2 + 2], S0[8 * s2 + 3]); p0.z = cvt_pk_bf16(S0[8 * s2 + 4], S0[8 * s2 + 5]); p0.w = cvt_pk_bf16(S0[8 * s2 + 6], S0[8 * s2 + 7]);
                    p1.x = cvt_pk_bf16(S1[8 * s2 + 0], S1[8 * s2 + 1]); p1.y = cvt_pk_bf16(S1[8 * s2 + 2], S1[8 * s2 + 3]); p1.z = cvt_pk_bf16(S1[8 * s2 + 4], S1[8 * s2 + 5]); p1.w = cvt_pk_bf16(S1[8 * s2 + 6], S1[8 * s2 + 7]);
                    pf[0][s2] = __builtin_bit_cast(bf16x8, p0); pf[1][s2] = __builtin_bit_cast(bf16x8, p1);
                }
                { bf16x8 g0[2], g1[2], g2[2], g3[2];
#define ATT_VG(dst, kt_, s2_) do { _Pragma("unroll") for (int dt = 0; dt < 2; ++dt) { \
                const LAS unsigned char* vp = Vl + (32 * (kt_) + 16 * (s2_)) * AV_STRIDE + (32 * dt) * 2; \
                const s16x4 lo = __builtin_bit_cast(s16x4, __builtin_amdgcn_ds_read_tr16_b64_v4i16((LAS v4i16_t*)vp)); \
                const s16x4 hh = __builtin_bit_cast(s16x4, __builtin_amdgcn_ds_read_tr16_b64_v4i16((LAS v4i16_t*)(vp + 8 * AV_STRIDE))); \
                dst[dt] = (bf16x8){lo[0], lo[1], lo[2], lo[3], hh[0], hh[1], hh[2], hh[3]}; } } while (0)
#define ATT_PIN2(x) asm volatile("" : "+v"(x[0]), "+v"(x[1]))
#define ATT_PV(x, kt_, s2_) do { O[0][qt] = __builtin_amdgcn_mfma_f32_32x32x16_bf16(x[0], pf[kt_][s2_], O[0][qt], 0, 0, 0); O[1][qt] = __builtin_amdgcn_mfma_f32_32x32x16_bf16(x[1], pf[kt_][s2_], O[1][qt], 0, 0, 0); } while (0)
                  ATT_VG(g0, 0, 0); ATT_VG(g1, 0, 1); ATT_PIN2(g0); ATT_PV(g0, 0, 0);
                  ATT_VG(g2, 1, 0); ATT_PIN2(g1); ATT_PV(g1, 0, 1);
                  ATT_VG(g3, 1, 1); ATT_PIN2(g2); ATT_PV(g2, 1, 0);
                  ATT_PIN2(g3); ATT_PV(g3, 1, 1); }
            }
        }
        if (it + 1 < NT) { const int bn = ((it + 1) & 1) * ABUF_BYTES;
            *(LAS u32x4*)(F.lds + bn + skey * AK_STRIDE + sc8 * 16) = kreg; *(LAS u32x4*)(F.lds + bn + AK_BYTES + skey * AV_STRIDE + sc8 * 16) = vreg; }
        __syncthreads();
    }
#pragma unroll
    for (int qt = 0; qt < 2; ++qt) {
        const float lt = l[qt] + __shfl_xor(l[qt], 32), il = 1.0f / lt;
        bf16* Op = (bf16*)(F.ws + WS_PO) + (size_t)(qrow0 + 64 * hq + 32 * qt + r32) * 1024 + 512 + h * 64;
#pragma unroll
        for (int dt = 0; dt < 2; ++dt)
#pragma unroll
            for (int g4 = 0; g4 < 4; ++g4) { u32x2 wv; wv.x = cvt_pk_bf16(O[dt][qt][4 * g4] * il, O[dt][qt][4 * g4 + 1] * il); wv.y = cvt_pk_bf16(O[dt][qt][4 * g4 + 2] * il, O[dt][qt][4 * g4 + 3] * il);
                *(u32x2*)(Op + 32 * dt + 8 * g4 + 4 * hi) = wv; }
    }
}
constexpr int PL_STRIDE = 272;
constexpr int PL_UT = 0, PL_PT = 24576;
template <int W, class AT> __device__ __forceinline__ void pool_units_mfma(Frame& F, AT& a, int layer, int u0, int ustride, int n_units) {
    if (u0 >= n_units) return;
    const bf16* U = (const bf16*)(F.ws + WS_U);
    const int g = u0 & 3; constexpr int w = W;
    const int lane = F.lane, i16 = lane & 15, kq = lane >> 4, rt4 = F.wave & 3, ch = F.wave >> 2;
    const bf16* Wt = (const bf16*)(F.ws + WS_WPG) + (size_t)(layer * 4 + g) * 128 * 128;
    bf16x8 wb[4][4];
#pragma unroll
    for (int ks = 0; ks < 4; ++ks)
#pragma unroll
        for (int ct = 0; ct < 4; ++ct) wb[ks][ct] = *(const bf16x8*)(Wt + (size_t)(64 * ch + 16 * ct + i16) * 128 + 32 * ks + 8 * kq);
    f32x4 scv[4];
#pragma unroll
    for (int ct = 0; ct < 4; ++ct) scv[ct] = *(const f32x4*)(a.in[I_PSCALE] + layer * 512 + g * 128 + 64 * ch + 16 * ct + 4 * kq);
    u32x4 st[3];
    auto stage_load = [&](int u) {
        const int row0 = (u >> 2) * 64; int s0, len;
        if (row0 < NL) { s0 = row0 & ~(SEQ - 1); len = SEQ; } else { s0 = NL + ((row0 - NL) & ~(CTX - 1)); len = CTX; }
        const int t0 = row0 - s0;
#pragma unroll
        for (int i = 0; i < 3; ++i) { const int idx = F.tid + 512 * i, rr = idx >> 4, cc = idx & 15; const int t = t0 - 8 + rr;
            st[i] = (u32x4){0u, 0u, 0u, 0u};
            if (idx < 1280 && t >= 0 && t < len) st[i] = *(const u32x4*)(U + (size_t)(s0 + t) * 512 + g * 128 + 8 * cc); }
    };
    stage_load(u0);
    for (int u = u0; u < n_units; u += ustride) {
        const int row0 = (u >> 2) * 64; int s0, len;
        if (row0 < NL) { s0 = row0 & ~(SEQ - 1); len = SEQ; } else { s0 = NL + ((row0 - NL) & ~(CTX - 1)); len = CTX; }
        const int t0 = row0 - s0;
        __syncthreads();
#pragma unroll
        for (int i = 0; i < 3; ++i) { const int idx = F.tid + 512 * i, rr = idx >> 4, cc = idx & 15; if (idx < 1280) *(LAS u32x4*)(F.lds + PL_UT + rr * PL_STRIDE + cc * 16) = st[i]; }
        if (u + ustride < n_units) stage_load(u + ustride);
        __syncthreads();
        { const int r = F.tid >> 3, c16 = (F.tid & 7) * 16; const int t = t0 + r;
          int lo = t - w / 2, hi = t - w / 2 + w - 1; lo = lo < 0 ? 0 : lo; hi = hi > len - 1 ? len - 1 : hi;
          f32x4 sm[4];
#pragma unroll
          for (int j = 0; j < 4; ++j) sm[j] = (f32x4){0.f, 0.f, 0.f, 0.f};
#pragma unroll
          for (int i = 0; i < W; ++i) { const int tt = t - W / 2 + i; const bool ok = tt >= lo && tt <= hi; const int tc = tt < lo ? lo : (tt > hi ? hi : tt); const float wt = ok ? 1.0f : 0.0f;
              const LAS unsigned char* p = F.lds + PL_UT + (tc - t0 + 8) * PL_STRIDE + c16 * 2;
              const u32x4 w0 = *(const LAS u32x4*)p, w1 = *(const LAS u32x4*)(p + 16);
              sm[0] += (f32x4){bf_lo(w0.x), bf_hi(w0.x), bf_lo(w0.y), bf_hi(w0.y)} * wt; sm[1] += (f32x4){bf_lo(w0.z), bf_hi(w0.z), bf_lo(w0.w), bf_hi(w0.w)} * wt;
              sm[2] += (f32x4){bf_lo(w1.x), bf_hi(w1.x), bf_lo(w1.y), bf_hi(w1.y)} * wt; sm[3] += (f32x4){bf_lo(w1.z), bf_hi(w1.z), bf_lo(w1.w), bf_hi(w1.w)} * wt; }
          const float inv = 1.0f / (float)(hi - lo + 1);
          { const LAS unsigned char* p = F.lds + PL_UT + (r + 8) * PL_STRIDE + c16 * 2; const u32x4 w0 = *(const LAS u32x4*)p, w1 = *(const LAS u32x4*)(p + 16);
            sm[0] = sm[0] * inv - (f32x4){bf_lo(w0.x), bf_hi(w0.x), bf_lo(w0.y), bf_hi(w0.y)}; sm[1] = sm[1] * inv - (f32x4){bf_lo(w0.z), bf_hi(w0.z), bf_lo(w0.w), bf_hi(w0.w)};
            sm[2] = sm[2] * inv - (f32x4){bf_lo(w1.x), bf_hi(w1.x), bf_lo(w1.y), bf_hi(w1.y)}; sm[3] = sm[3] * inv - (f32x4){bf_lo(w1.z), bf_hi(w1.z), bf_lo(w1.w), bf_hi(w1.w)}; }
          u32x4 o0, o1; o0.x = cvt_pk_bf16(sm[0].x, sm[0].y); o0.y = cvt_pk_bf16(sm[0].z, sm[0].w); o0.z = cvt_pk_bf16(sm[1].x, sm[1].y); o0.w = cvt_pk_bf16(sm[1].z, sm[1].w);
          o1.x = cvt_pk_bf16(sm[2].x, sm[2].y); o1.y = cvt_pk_bf16(sm[2].z, sm[2].w); o1.z = cvt_pk_bf16(sm[3].x, sm[3].y); o1.w = cvt_pk_bf16(sm[3].z, sm[3].w);
          *(LAS u32x4*)(F.lds + PL_PT + r * PL_STRIDE + c16 * 2) = o0; *(LAS u32x4*)(F.lds + PL_PT + r * PL_STRIDE + c16 * 2 + 16) = o1; }
        __syncthreads();
        { f32x4 acc[4];
#pragma unroll
          for (int ct = 0; ct < 4; ++ct) acc[ct] = (f32x4){0.f, 0.f, 0.f, 0.f};
#pragma unroll
          for (int ks = 0; ks < 4; ++ks) {
              const bf16x8 pa = *(const LAS bf16x8*)(F.lds + PL_PT + (16 * rt4 + i16) * PL_STRIDE + (32 * ks + 8 * kq) * 2);
#pragma unroll
              for (int ct = 0; ct < 4; ++ct) acc[ct] = __builtin_amdgcn_mfma_f32_16x16x32_bf16(wb[ks][ct], pa, acc[ct], 0, 0, 0);
          }
          const int row = row0 + 16 * rt4 + i16; bf16* O = (bf16*)(F.ws + WS_PO) + (size_t)row * 1024 + g * 128;
#pragma unroll
          for (int ct = 0; ct < 4; ++ct) { const int d = 64 * ch + 16 * ct + 4 * kq;
              u32x2 wv; wv.x = cvt_pk_bf16(acc[ct].x * scv[ct].x, acc[ct].y * scv[ct].y); wv.y = cvt_pk_bf16(acc[ct].z * scv[ct].z, acc[ct].w * scv[ct].w); *(u32x2*)(O + d) = wv; }
        }
    }
}
template <class AT> __device__ __forceinline__ void attn_unit_v2(Frame& F, AT& a, int layer, int qrow0, int qpos0, int g, int lrow0, int jlo, int jhi, int crow0) {
    const bf16* Q = (const bf16*)(F.ws + WS_Q); const bf16* Kb = (const bf16*)(F.ws + WS_K); const bf16* Vb = (const bf16*)(F.ws + WS_V);
    const int lane = F.lane, r32 = lane & 31, hi = lane >> 5, w = F.wave, r = w >> 1, qh = w & 1, h = 4 * g + r;
    bf16x8 qf[4];
#pragma unroll
    for (int s = 0; s < 4; ++s) qf[s] = *(const bf16x8*)(Q + (size_t)(qrow0 + 32 * qh + r32) * 512 + h * 64 + 16 * s + 8 * hi);
    f32x16 O0, O1;
#pragma unroll
    for (int i = 0; i < 16; ++i) { O0[i] = 0.f; O1[i] = 0.f; }
    const float sink2 = a.in[I_SINK][layer * 8 + h] * LOG2E;
    float m = sink2, l = hi == 0 ? 1.0f : 0.0f;
    const int nloc = jhi >= jlo ? jhi - jlo + 1 : 0, NT = nloc + 4;
    const int skey = F.tid >> 3, sc8 = F.tid & 7;
    const int qa = qpos0 + 32 * qh;
    const unsigned lane_off = (unsigned)(skey * 128 + 8 * sc8) * 2u;
    const unsigned st_k = (unsigned)(skey * AK_STRIDE + sc8 * 16), st_v = (unsigned)(AK_BYTES + skey * AV_STRIDE + sc8 * 16);
    const unsigned kb0 = (unsigned)(r32 * AK_STRIDE + 16 * hi), vb0 = (unsigned)(AK_BYTES + (4 * hi + ((lane & 15) >> 2)) * AV_STRIDE + (16 * ((lane >> 4) & 1) + 4 * (lane & 3)) * 2);
#define A2_KROW(it_) (((it_) < nloc) ? lrow0 + 64 * (jlo + (it_)) : crow0 + 64 * ((it_) - nloc))
#define A2_GLOAD(kr_, vr_, it_) do { const int krow_ = A2_KROW(it_); kr_ = *(const u32x4*)((const char*)(Kb + (size_t)krow_ * 128 + g * 64) + lane_off); vr_ = *(const u32x4*)((const char*)(Vb + (size_t)krow_ * 128 + g * 64) + lane_off); } while (0)
#define A2_QK(S0_, S1_, bo_) do { unsigned kbase_ = (unsigned)(bo_) + kb0; asm volatile("" : "+v"(kbase_)); const LAS unsigned char* Kl_ = F.lds + kbase_; bf16x8 ka_[4], kb_[4]; \
        _Pragma("unroll") for (int i_ = 0; i_ < 16; ++i_) { S0_[i_] = 0.f; S1_[i_] = 0.f; } \
        _Pragma("unroll") for (int s_ = 0; s_ < 4; ++s_) ka_[s_] = *(const LAS bf16x8*)(Kl_ + 32 * s_); \
        _Pragma("unroll") for (int s_ = 0; s_ < 4; ++s_) asm volatile("" : "+v"(ka_[s_])); \
        _Pragma("unroll") for (int s_ = 0; s_ < 4; ++s_) kb_[s_] = *(const LAS bf16x8*)(Kl_ + 32 * AK_STRIDE + 32 * s_); \
        _Pragma("unroll") for (int s_ = 0; s_ < 4; ++s_) S0_ = __builtin_amdgcn_mfma_f32_32x32x16_bf16(ka_[s_], qf[s_], S0_, 0, 0, 0); \
        _Pragma("unroll") for (int s_ = 0; s_ < 4; ++s_) asm volatile("" : "+v"(kb_[s_])); \
        _Pragma("unroll") for (int s_ = 0; s_ < 4; ++s_) S1_ = __builtin_amdgcn_mfma_f32_32x32x16_bf16(kb_[s_], qf[s_], S1_, 0, 0, 0); } while (0)
    u32x4 kreg, vreg, kreg1, vreg1;
    A2_GLOAD(kreg, vreg, 0); A2_GLOAD(kreg1, vreg1, 1);
    __syncthreads();
    *(LAS u32x4*)(F.lds + st_k) = kreg; *(LAS u32x4*)(F.lds + st_v) = vreg;
    *(LAS u32x4*)(F.lds + ABUF_BYTES + st_k) = kreg1; *(LAS u32x4*)(F.lds + ABUF_BYTES + st_v) = vreg1;
    A2_GLOAD(kreg, vreg, 2);
    __syncthreads();
    f32x16 SA0, SA1, SB0, SB1;
    A2_QK(SA0, SA1, 0);
    int bcur = 0, bnx = ABUF_BYTES, bst = 2 * ABUF_BYTES;
#define A2_STEP(C0_, C1_, N0_, N1_, t_) do { \
        if ((t_) + 2 < NT) { *(LAS u32x4*)(F.lds + bst + st_k) = kreg; *(LAS u32x4*)(F.lds + bst + st_v) = vreg; }     \
        { const int nt3_ = (t_) + 3 < NT ? (t_) + 3 : NT - 1; A2_GLOAD(kreg, vreg, nt3_); }                             \
        __builtin_amdgcn_sched_barrier(0); \
        if ((t_) + 1 < NT) { A2_QK(N0_, N1_, bnx); } \
        __builtin_amdgcn_sched_barrier(0); \
        { const int ka_t = 64 * (jlo + (t_)); \
          if ((t_) < nloc && (ka_t + 63 - qa > 128 || qa + 31 - ka_t > 128)) { const int qp_ = qa + r32; \
              _Pragma("unroll") for (int i_ = 0; i_ < 16; ++i_) { const int kp_ = ka_t + (i_ & 3) + 8 * (i_ >> 2) + 4 * hi; const int d0_ = qp_ - kp_, d1_ = d0_ - 32; \
                  if (d0_ > 128 || d0_ < -128) C0_[i_] = -INFINITY; if (d1_ > 128 || d1_ < -128) C1_[i_] = -INFINITY; } } } \
        float ta_ = fmaxf(fmaxf(C0_[0], C0_[1]), C0_[2]), tb_ = fmaxf(fmaxf(C1_[0], C1_[1]), C1_[2]); \
        _Pragma("unroll") for (int i_ = 3; i_ < 15; i_ += 2) { ta_ = fmaxf(fmaxf(ta_, C0_[i_]), C0_[i_ + 1]); tb_ = fmaxf(fmaxf(tb_, C1_[i_]), C1_[i_ + 1]); } \
        float tmax_ = fmaxf(fmaxf(ta_, tb_), fmaxf(C0_[15], C1_[15])); \
        tmax_ = fmaxf(tmax_, __shfl_xor(tmax_, 32)); \
        if (__any(tmax_ > m + ATT_THR)) { const float mn_ = fmaxf(m, tmax_), al_ = __builtin_amdgcn_exp2f(m - mn_); l *= al_; m = mn_; \
            _Pragma("unroll") for (int i_ = 0; i_ < 16; ++i_) { O0[i_] *= al_; O1[i_] *= al_; } } \
        { const f32x2 nm2_ = {-m, -m}; f32x2 ls2_ = {0.f, 0.f}; \
          _Pragma("unroll") for (int i_ = 0; i_ < 16; i_ += 2) { f32x2 a0_ = (f32x2){C0_[i_], C0_[i_ + 1]} + nm2_, a1_ = (f32x2){C1_[i_], C1_[i_ + 1]} + nm2_; \
              a0_.x = __builtin_amdgcn_exp2f(a0_.x); a0_.y = __builtin_amdgcn_exp2f(a0_.y); a1_.x = __builtin_amdgcn_exp2f(a1_.x); a1_.y = __builtin_amdgcn_exp2f(a1_.y); \
              C0_[i_] = a0_.x; C0_[i_ + 1] = a0_.y; C1_[i_] = a1_.x; C1_[i_ + 1] = a1_.y; ls2_ += a0_; ls2_ += a1_; } \
          l += ls2_.x + ls2_.y; } \
        bf16x8 pf_[2][2]; \
        _Pragma("unroll") for (int s2_ = 0; s2_ < 2; ++s2_) { u32x4 p0_, p1_; \
            p0_.x = cvt_pk_bf16(C0_[8 * s2_ + 0], C0_[8 * s2_ + 1]); p0_.y = cvt_pk_bf16(C0_[8 * s2_ + 2], C0_[8 * s2_ + 3]); p0_.z = cvt_pk_bf16(C0_[8 * s2_ + 4], C0_[8 * s2_ + 5]); p0_.w = cvt_pk_bf16(C0_[8 * s2_ + 6], C0_[8 * s2_ + 7]); \
            p1_.x = cvt_pk_bf16(C1_[8 * s2_ + 0], C1_[8 * s2_ + 1]); p1_.y = cvt_pk_bf16(C1_[8 * s2_ + 2], C1_[8 * s2_ + 3]); p1_.z = cvt_pk_bf16(C1_[8 * s2_ + 4], C1_[8 * s2_ + 5]); p1_.w = cvt_pk_bf16(C1_[8 * s2_ + 6], C1_[8 * s2_ + 7]); \
            pf_[0][s2_] = __builtin_bit_cast(bf16x8, p0_); pf_[1][s2_] = __builtin_bit_cast(bf16x8, p1_); } \
        { unsigned vbase_ = (unsigned)bcur + vb0; asm volatile("" : "+v"(vbase_)); const LAS unsigned char* Vl_ = F.lds + vbase_; bf16x8 g0_[2], g1_[2], g2_[2], g3_[2]; \
          A2_VG(g0_, 0, 0); A2_VG(g1_, 0, 1); A2_PIN2(g0_); A2_PV(g0_, 0, 0); \
          A2_VG(g2_, 1, 0); A2_PIN2(g1_); A2_PV(g1_, 0, 1); \
          A2_VG(g3_, 1, 1); A2_PIN2(g2_); A2_PV(g2_, 1, 0); \
          A2_PIN2(g3_); A2_PV(g3_, 1, 1); } \
        __syncthreads(); \
        { const int tmp_ = bcur; bcur = bnx; bnx = bst; bst = tmp_; } } while (0)
#define A2_VG(dst, kt_, s2_) do { _Pragma("unroll") for (int dt_ = 0; dt_ < 2; ++dt_) { \
        const LAS unsigned char* vp_ = Vl_ + (32 * (kt_) + 16 * (s2_)) * AV_STRIDE + (32 * dt_) * 2; \
        const s16x4 lo_ = __builtin_bit_cast(s16x4, __builtin_amdgcn_ds_read_tr16_b64_v4i16((LAS v4i16_t*)vp_)); \
        const s16x4 hh_ = __builtin_bit_cast(s16x4, __builtin_amdgcn_ds_read_tr16_b64_v4i16((LAS v4i16_t*)(vp_ + 8 * AV_STRIDE))); \
        dst[dt_] = (bf16x8){lo_[0], lo_[1], lo_[2], lo_[3], hh_[0], hh_[1], hh_[2], hh_[3]}; } } while (0)
#define A2_PIN2(x) asm volatile("" : "+v"(x[0]), "+v"(x[1]))
#define A2_PV(x, kt_, s2_) do { O0 = __builtin_amdgcn_mfma_f32_32x32x16_bf16(x[0], pf_[kt_][s2_], O0, 0, 0, 0); O1 = __builtin_amdgcn_mfma_f32_32x32x16_bf16(x[1], pf_[kt_][s2_], O1, 0, 0, 0); } while (0)
#pragma unroll 1
    for (int t = 0; t < NT; t += 2) {
        A2_STEP(SA0, SA1, SB0, SB1, t);
        if (t + 1 < NT) A2_STEP(SB0, SB1, SA0, SA1, t + 1);
    }
#undef A2_KROW
#undef A2_GLOAD
#undef A2_QK
#undef A2_STEP
#undef A2_VG
#undef A2_PIN2
#undef A2_PV
    { const float lt = l + __shfl_xor(l, 32), il = 1.0f / lt;
      bf16* Op = (bf16*)(F.ws + WS_PO) + (size_t)(qrow0 + 32 * qh + r32) * 1024 + 512 + h * 64;
#pragma unroll
      for (int g4 = 0; g4 < 4; ++g4) { u32x2 wv; wv.x = cvt_pk_bf16(O0[4 * g4] * il, O0[4 * g4 + 1] * il); wv.y = cvt_pk_bf16(O0[4 * g4 + 2] * il, O0[4 * g4 + 3] * il); *(u32x2*)(Op + 8 * g4 + 4 * hi) = wv; }
#pragma unroll
      for (int g4 = 0; g4 < 4; ++g4) { u32x2 wv; wv.x = cvt_pk_bf16(O1[4 * g4] * il, O1[4 * g4 + 1] * il); wv.y = cvt_pk_bf16(O1[4 * g4 + 2] * il, O1[4 * g4 + 3] * il); *(u32x2*)(Op + 32 + 8 * g4 + 4 * hi) = wv; } }
}
constexpr int PW_BYTES = 12800, PW_PT = 8192;
template <int W, class AT> __device__ __forceinline__ void pool_wave(Frame& F, AT& a, int layer, int u0, int ustride, int n_units) {
    if (u0 >= n_units) return;
    const bf16* U = (const bf16*)(F.ws + WS_U);
    const int g = u0 & 3, ch = (u0 >> 2) & 1; constexpr int w = W;
    const int lane = F.lane, i16 = lane & 15, kq = lane >> 4;
    LAS unsigned char* UT = F.lds + F.wave * PW_BYTES; LAS unsigned char* PT = UT + PW_PT;
    const bf16* Wt = (const bf16*)(F.ws + WS_WPG) + (size_t)(layer * 4 + g) * 128 * 128;
    bf16x8 wb[4][4];
#pragma unroll
    for (int ks = 0; ks < 4; ++ks)
#pragma unroll
        for (int ct = 0; ct < 4; ++ct) wb[ks][ct] = *(const bf16x8*)(Wt + (size_t)(64 * ch + 16 * ct + i16) * 128 + 32 * ks + 8 * kq);
    f32x4 scv[4];
#pragma unroll
    for (int ct = 0; ct < 4; ++ct) scv[ct] = *(const f32x4*)(a.in[I_PSCALE] + layer * 512 + g * 128 + 64 * ch + 16 * ct + 4 * kq);
    u32x4 st[8];
    auto stage_load = [&](int u) {
        const int row0 = (u >> 3) * 16; int s0, len;
        if (row0 < NL) { s0 = row0 & ~(SEQ - 1); len = SEQ; } else { s0 = NL + ((row0 - NL) & ~(CTX - 1)); len = CTX; }
        const int t0 = row0 - s0;
#pragma unroll
        for (int i = 0; i < 8; ++i) { const int idx = lane + 64 * i, rr = idx >> 4, cc = idx & 15; const int t = t0 - 8 + rr;
            st[i] = (u32x4){0u, 0u, 0u, 0u};
            if (t >= 0 && t < len) st[i] = *(const u32x4*)(U + (size_t)(s0 + t) * 512 + g * 128 + 8 * cc); }
    };
    stage_load(u0);
    for (int u = u0; u < n_units; u += ustride) {
        const int row0 = (u >> 3) * 16; int s0, len;
        if (row0 < NL) { s0 = row0 & ~(SEQ - 1); len = SEQ; } else { s0 = NL + ((row0 - NL) & ~(CTX - 1)); len = CTX; }
        const int t0 = row0 - s0;
#pragma unroll
        for (int i = 0; i < 8; ++i) { const int idx = lane + 64 * i; *(LAS u32x4*)(UT + (idx >> 4) * 256 + (idx & 15) * 16) = st[i]; }
        if (u + ustride < n_units) stage_load(u + ustride);
        __builtin_amdgcn_sched_barrier(0);
        LDS_WAIT();
        { const LAS unsigned char* up = UT + 4 * lane;
          unsigned uv[32];
#pragma unroll
          for (int r = 0; r < 32; ++r) uv[r] = *(const LAS unsigned*)(up + r * 256);
          float sa = 0.f, sb = 0.f;
#pragma unroll
          for (int i = 0; i < W; ++i) { sa += bf_lo(uv[8 - W / 2 + i]); sb += bf_hi(uv[8 - W / 2 + i]); }
#pragma unroll
          for (int r = 0; r < 16; ++r) {
              if (r > 0) { sa += bf_lo(uv[8 - W / 2 + W - 1 + r]) - bf_lo(uv[8 - W / 2 + r - 1]); sb += bf_hi(uv[8 - W / 2 + W - 1 + r]) - bf_hi(uv[8 - W / 2 + r - 1]); }
              const int t = t0 + r; int lo = t - W / 2, hi = t - W / 2 + W - 1; lo = lo < 0 ? 0 : lo; hi = hi > len - 1 ? len - 1 : hi;
              const float inv = 1.0f / (float)(hi - lo + 1);
              *(LAS unsigned*)(PT + r * PL_STRIDE + 4 * lane) = cvt_pk_bf16(sa * inv - bf_lo(uv[r + 8]), sb * inv - bf_hi(uv[r + 8]));
          } }
        LDS_WAIT(); asm volatile("" ::: "memory");
        { f32x4 acc[4];
#pragma unroll
          for (int ct = 0; ct < 4; ++ct) acc[ct] = (f32x4){0.f, 0.f, 0.f, 0.f};
          bf16x8 pa[4];
#pragma unroll
          for (int ks = 0; ks < 4; ++ks) pa[ks] = *(const LAS bf16x8*)(PT + i16 * PL_STRIDE + (32 * ks + 8 * kq) * 2);
#pragma unroll
          for (int ks = 0; ks < 4; ++ks)
#pragma unroll
              for (int ct = 0; ct < 4; ++ct) acc[ct] = __builtin_amdgcn_mfma_f32_16x16x32_bf16(wb[ks][ct], pa[ks], acc[ct], 0, 0, 0);
          const int row = row0 + i16; bf16* O = (bf16*)(F.ws + WS_PO) + (size_t)row * 1024 + g * 128;
#pragma unroll
          for (int ct = 0; ct < 4; ++ct) { const int d = 64 * ch + 16 * ct + 4 * kq;
              u32x2 wv; wv.x = cvt_pk_bf16(acc[ct].x * scv[ct].x, acc[ct].y * scv[ct].y); wv.y = cvt_pk_bf16(acc[ct].z * scv[ct].z, acc[ct].w * scv[ct].w); *(u32x2*)(O + d) = wv; }
        }
        LDS_WAIT(); asm volatile("" ::: "memory");
    }
}
#ifndef MIX_SIMPLE
#define MIX_SIMPLE 0
#endif
template <class AT> __device__ __forceinline__ void phase_mix(Frame& F, AT& a, int layer) {
#ifndef MIX_DUP
#define MIX_DUP 0
#endif
#ifndef ATT_V2
#define ATT_V2 1
#endif
#if ATT_V2
    { const int n_lat = 1024, n_ctx = layer == 0 ? 16 : 0;
      for (int rep = 0; rep < ((MIX_DUP & 1) ? 2 : 1); ++rep)
      for (int u = F.vcu; u < n_lat + n_ctx; u += F.G) {
          if (u < n_lat) { const int b = u >> 9, mm = (u & 511) >> 1, g = u & 1;
              int jlo = mm - 2, jhi = mm + 2; jlo = jlo < 0 ? 0 : jlo; jhi = jhi > 255 ? 255 : jhi;
              attn_unit_v2(F, a, layer, b * SEQ + 64 * mm, 64 * mm, g, b * SEQ, jlo, jhi, NL + b * CTX);
          } else { const int v = u - n_lat, b = v >> 3, g = (v >> 2) & 1, cb = v & 3;
              attn_unit_v2(F, a, layer, NL + b * CTX + 64 * cb, 0, g, 0, 0, -1, NL + b * CTX); }
      } }
#else
    const int n_lat = 512, n_ctx = layer == 0 ? 8 : 0;
    for (int rep = 0; rep < ((MIX_DUP & 1) ? 2 : 1); ++rep)
    for (int u = F.vcu; u < n_lat + n_ctx; u += F.G) {
        if (u < n_lat) { const int b = u >> 8, n = (u & 255) >> 1, g = u & 1;
            int jlo = 2 * n - 2, jhi = 2 * n + 3; jlo = jlo < 0 ? 0 : jlo; jhi = jhi > 255 ? 255 : jhi;
            if (MIX_SIMPLE & 1) attn_unit_simple(F, a, layer, b * SEQ + 128 * n, 128 * n, g, b * SEQ, jlo, jhi, NL + b * CTX);
            else attn_unit_mfma(F, a, layer, b * SEQ + 128 * n, 128 * n, g, b * SEQ, jlo, jhi, NL + b * CTX);
        } else { const int v = u - n_lat, b = v >> 2, g = (v >> 1) & 1, cb = v & 1;
            if (MIX_SIMPLE & 1) attn_unit_simple(F, a, layer, NL + b * CTX + 128 * cb, 0, g, 0, 0, -1, NL + b * CTX);
            else attn_unit_mfma(F, a, layer, NL + b * CTX + 128 * cb, 0, g, 0, 0, -1, NL + b * CTX); }
    }
#endif
    const int n_rt = (layer == 0 ? MT : NL) / 64;
    const int skip = (layer == 0 && F.G > 32) ? (ATT_V2 ? 16 : 8) : 0;
    if (F.vcu >= skip)
    for (int rep = 0; rep < ((MIX_DUP & 2) ? 2 : 1); ++rep) {
        if (MIX_SIMPLE & 2) { for (int u = F.vcu - skip; u < n_rt * 4; u += F.G - skip) pool_unit(F, a, layer, u >> 2, u & 3); }
        else { __syncthreads();
            const int u0 = (F.vcu - skip) * 8 + F.wave, us = (F.G - skip) * 8, nu = n_rt * 4 * 8;
            switch (F.wave & 3) { case 0: pool_wave<2>(F, a, layer, u0, us, nu); break; case 1: pool_wave<4>(F, a, layer, u0, us, nu); break;
                                  case 2: pool_wave<8>(F, a, layer, u0, us, nu); break; default: pool_wave<16>(F, a, layer, u0, us, nu); break; } }
    }
    __syncthreads();
}

__device__ __forceinline__ float top2sum(float a, float b, float c, float d) {
    const float h1 = fmaxf(a, b), l1 = fminf(a, b), h2 = fmaxf(c, d), l2 = fminf(c, d);
    return fmaxf(h1, h2) + fmaxf(fminf(h1, h2), fmaxf(l1, l2));
}
template <class AT> __device__ __forceinline__ void phase_ln1_route(Frame& F, AT& a, int layer, bool dry = false) {
    LAS float* WT = (LAS float*)F.lds;
    LAS int* lcnt = (LAS int*)(F.lds + MISC_OFF + L_LCNT); LAS int* lbase = (LAS int*)(F.lds + MISC_OFF + L_BASE);
    LAS unsigned* rinfo = (LAS unsigned*)(F.lds + MISC_OFF + L_ROW);
    const int rows_total = layer == 0 ? MT : NL; const int chunk = (rows_total + F.G - 1) / F.G;
    const int row_lo = F.vcu * chunk; int row_hi = row_lo + chunk; row_hi = row_hi > rows_total ? rows_total : row_hi;
    __syncthreads();
    { const f32x4* src = (const f32x4*)(F.ws + WS_WRT); f32x4 tv[16];
#pragma unroll
      for (int i = 0; i < 16; ++i) tv[i] = src[F.tid + 512 * i];
#pragma unroll
      for (int i = 0; i < 16; ++i) *(LAS f32x4*)(WT + 4 * (F.tid + 512 * i)) = tv[i]; }
    if (F.tid < 32) lcnt[F.tid] = 0;
    __syncthreads();
    const bf16* Yb = (const bf16*)(F.ws + WS_E);
    const int e_mine = 16 * (F.lane & 1) + 8 * ((F.lane >> 1) & 1) + 4 * ((F.lane >> 2) & 1) + 2 * ((F.lane >> 3) & 1) + ((F.lane >> 4) & 1);
    const float bias_mine = a.in[I_RB][e_mine];
    const int src_canon = e_mine | (F.lane & 32);
    f32x4 pg1[4], pb1[4], pga[4], psh[4], psc[4]; int cvec = -1;
    load_vec(a.in[I_LN1G] + layer * D, F.lane, pg1); load_vec(a.in[I_LN1B] + layer * D, F.lane, pb1);
    f32x4 nv[4]; u32x2 ny[4];
#define XROW(r_) (layer == 0 ? ((r_) < NL ? a.in[I_X] + (size_t)(r_) * D : a.in[I_CTX] + (size_t)((r_) - NL) * D) : (const float*)(F.ws + WS_C) + (size_t)(r_) * D)
    if (row_lo + F.wave < row_hi) { const int r0 = row_lo + F.wave; load_row(XROW(r0), F.lane, nv);
#pragma unroll
        for (int j = 0; j < 4; ++j) ny[j] = *(const u32x2*)(Yb + (size_t)r0 * D + 256 * j + 4 * F.lane); }
    for (int row = row_lo + F.wave; row < row_hi; ) {
      { const int vec = row_vec(row); cvec = vec; load_ada(ada_vec(F, layer, vec, 2), F.lane, pga); load_ada(ada_vec(F, layer, vec, 3), F.lane, psh); load_ada(ada_vec(F, layer, vec, 4), F.lane, psc);
        pin_vec(pga); pin_vec(psh); pin_vec(psc); pin_vec(pg1); pin_vec(pb1); }
      int seg_hi = cvec == 0 ? SEQ : (cvec == 1 ? NL : MT); seg_hi = seg_hi < row_hi ? seg_hi : row_hi;
      for (; row < seg_hi; row += 8) {
        f32x4 v[4]; u32x2 yv[4];
#pragma unroll
        for (int j = 0; j < 4; ++j) { v[j] = nv[j]; yv[j] = ny[j]; }
        if (row + 8 < row_hi) { const int r1 = row + 8; load_row(XROW(r1), F.lane, nv);
#pragma unroll
            for (int j = 0; j < 4; ++j) ny[j] = *(const u32x2*)(Yb + (size_t)r1 * D + 256 * j + 4 * F.lane); }
        __builtin_amdgcn_sched_barrier(0);
#pragma unroll
        for (int j = 0; j < 4; ++j) { const f32x4 yy = {bf_lo(yv[j].x), bf_hi(yv[j].x), bf_lo(yv[j].y), bf_hi(yv[j].y)}; v[j] = v[j] * ALPHA + pga[j] * yy; }
        float mean, rstd; ln_stats(v, mean, rstd);
#pragma unroll
        for (int j = 0; j < 4; ++j) v[j] = (v[j] - mean) * rstd * pg1[j] + pb1[j];
        float* x1 = row < NL ? a.out + (size_t)row * D : (float*)(F.ws + WS_X1C) + (size_t)(row - NL) * D;
        store_row(x1, F.lane, v);
        ln_stats(v, mean, rstd);
        f32x4 h[4];
#pragma unroll
        for (int j = 0; j < 4; ++j) h[j] = (v[j] - mean) * rstd * (psc[j] + 1.0f) + psh[j];
        store_row_bf16((bf16*)(F.ws + WS_E) + (size_t)row * D, F.lane, h);
        float lg[32];
        {
            f32x4 wA[4], wB[4];
#define RT_LOAD(dst, e_) do { _Pragma("unroll") for (int j = 0; j < 4; ++j) dst[j] = *(const LAS f32x4*)(WT + (e_) * D + 256 * j + 4 * F.lane); } while (0)
#define RT_MUL(src, e_) do { f32x2 sa = {0.f, 0.f}; _Pragma("unroll") for (int j = 0; j < 4; ++j) { \
                sa = __builtin_elementwise_fma((f32x2){h[j].x, h[j].y}, (f32x2){src[j].x, src[j].y}, sa); sa = __builtin_elementwise_fma((f32x2){h[j].z, h[j].w}, (f32x2){src[j].z, src[j].w}, sa); } \
                lg[(e_)] = sa.x + sa.y; } while (0)
            RT_LOAD(wA, 0);
#pragma unroll
            for (int e2 = 0; e2 < 32; e2 += 2) {
                RT_LOAD(wB, e2 + 1); __builtin_amdgcn_sched_barrier(0); RT_MUL(wA, e2); __builtin_amdgcn_sched_barrier(0);
                if (e2 + 2 < 32) { RT_LOAD(wA, e2 + 2); } __builtin_amdgcn_sched_barrier(0); RT_MUL(wB, e2 + 1); __builtin_amdgcn_sched_barrier(0);
            }
#undef RT_LOAD
#undef RT_MUL
        }
#pragma unroll
        for (int k = 0; k < 16; ++k) { const bool up = (F.lane & 1) != 0; const float send = up ? lg[k] : lg[k + 16], keep = up ? lg[k + 16] : lg[k]; lg[k] = keep + dppf<0xB1>(send); }
#pragma unroll
        for (int k = 0; k < 8; ++k) { const bool up = (F.lane & 2) != 0; const float send = up ? lg[k] : lg[k + 8], keep = up ? lg[k + 8] : lg[k]; lg[k] = keep + dppf<0x4E>(send); }
#pragma unroll
        for (int k = 0; k < 4; ++k) { const bool up = (F.lane & 4) != 0; const float send = up ? lg[k] : lg[k + 4], keep = up ? lg[k + 4] : lg[k]; lg[k] = keep + xor4f(send); }
#pragma unroll
        for (int k = 0; k < 2; ++k) { const bool up = (F.lane & 8) != 0; const float send = up ? lg[k] : lg[k + 2], keep = up ? lg[k + 2] : lg[k]; lg[k] = keep + dppf<0x128>(send); }
        { const bool up = (F.lane & 16) != 0; const float send = up ? lg[0] : lg[1], keep = up ? lg[1] : lg[0]; lg[0] = keep + __shfl_xor(send, 16); }
        const float logit = lg[0] + __shfl_xor(lg[0], 32);
        const float score_m = 1.0f / (1.0f + expf(-logit)); const float biased_m = score_m + bias_mine;
        const float score = __shfl(score_m, src_canon), biased = __shfl(biased_m, src_canon);
        const float ba = dppf<0x00>(biased), bb = dppf<0x55>(biased), bc = dppf<0xAA>(biased), bd = dppf<0xFF>(biased);
        float gs = top2sum(ba, bb, bc, bd); int gi = (F.lane & 31) >> 2;
        { const float os = xor4f(gs); const int oi = xor4i(gi); if (os > gs || (os == gs && oi < gi)) { gs = os; gi = oi; } }
        { const float os = dppf<0x128>(gs); const int oi = dppi<0x128>(gi); if (os > gs || (os == gs && oi < gi)) { gs = os; gi = oi; } }
        { const float os = __shfl_xor(gs, 16); const int oi = __shfl_xor(gi, 16); if (os > gs || (os == gs && oi < gi)) { gs = os; gi = oi; } }
        gi = __builtin_amdgcn_readfirstlane(gi);
        float bv[4], sv[4];
#pragma unroll
        for (int k = 0; k < 4; ++k) { bv[k] = __builtin_bit_cast(float, __builtin_amdgcn_readlane(__builtin_bit_cast(int, biased), gi * 4 + k)); sv[k] = __builtin_bit_cast(float, __builtin_amdgcn_readlane(__builtin_bit_cast(int, score), gi * 4 + k)); }
        int i0 = 0; float bb0 = bv[0];
#pragma unroll
        for (int k = 1; k < 4; ++k) if (bv[k] > bb0) { bb0 = bv[k]; i0 = k; }
        int i1 = -1; float bb1 = -INFINITY;
#pragma unroll
        for (int k = 0; k < 4; ++k) if (k != i0 && (i1 < 0 || bv[k] > bb1)) { bb1 = bv[k]; i1 = k; }
        float s0 = 0.f, s1 = 0.f;
#pragma unroll
        for (int k = 0; k < 4; ++k) { s0 = (k == i0) ? sv[k] : s0; s1 = (k == i1) ? sv[k] : s1; }
        const float wsum = s0 + s1;
        if (F.lane == 0) { const int e0 = gi * 4 + i0, e1 = gi * 4 + i1; const int lr = row - row_lo;
            const int p0 = __hip_atomic_fetch_add(&lcnt[e0], 1, __ATOMIC_RELAXED, __HIP_MEMORY_SCOPE_WORKGROUP), p1 = __hip_atomic_fetch_add(&lcnt[e1], 1, __ATOMIC_RELAXED, __HIP_MEMORY_SCOPE_WORKGROUP);
            rinfo[lr * 4 + 0] = (unsigned)e0 | ((unsigned)e1 << 8) | ((unsigned)p0 << 16); rinfo[lr * 4 + 1] = (unsigned)p1;
            rinfo[lr * 4 + 2] = __float_as_uint(s0 / wsum); rinfo[lr * 4 + 3] = __float_as_uint(s1 / wsum); }
      }
    }
    __syncthreads();
    if (dry) return;
    if (F.tid < 32) lbase[F.tid] = (int)__hip_atomic_fetch_add(F.ctl + CW_CNT + 64 * layer + F.tid, (unsigned)lcnt[F.tid], RLX_AGENT);
    __syncthreads();
    int* list = (int*)(F.ws + WS_LIST); unsigned* tok = (unsigned*)(F.ws + WS_TOK);
    for (int lr = F.tid; lr < row_hi - row_lo; lr += 512) {
        const unsigned w0 = rinfo[lr * 4 + 0], w1 = rinfo[lr * 4 + 1]; const int e0 = w0 & 255, e1 = (w0 >> 8) & 255;
        const int p0 = lbase[e0] + (int)(w0 >> 16), p1 = lbase[e1] + (int)w1; const int row = row_lo + lr;
        list[(size_t)e0 * LCAP + p0] = row; list[(size_t)e1 * LCAP + p1] = row;
        u32x4 o; o.x = (unsigned)e0 | ((unsigned)e1 << 8); o.y = (unsigned)p0; o.z = (unsigned)p1; o.w = rinfo[lr * 4 + 2];
        *(u32x4*)(tok + (size_t)row * 8) = o; tok[(size_t)row * 8 + 4] = rinfo[lr * 4 + 3];
    }
    __syncthreads();
}
__device__ __forceinline__ void moe_tables(Frame& F, int layer) {
    LAS int* blk = (LAS int*)(F.lds + MISC_OFF + L_BLK); LAS int* cnt = (LAS int*)(F.lds + MISC_OFF + L_CNT);
    __syncthreads();
    if (F.tid < 32) cnt[F.tid] = (int)__hip_atomic_load(F.ctl + CW_CNT + 64 * layer + F.tid, RLX_AGENT);
    __syncthreads();
    if (F.tid == 0) { int s = 0; for (int e = 0; e < 32; ++e) { blk[e] = s; s += (cnt[e] + 255) >> 8; } blk[32] = s; }
    __syncthreads();
}
template <class AT> __device__ __forceinline__ void phase_ln2(Frame& F, AT& a, int layer) {
    moe_tables(F, layer);
    const LAS int* blk = (const LAS int*)(F.lds + MISC_OFF + L_BLK);
    const int gw = F.vcu * 8 + F.wave, NGW = F.G * 8; const int rows_total = layer == 0 ? MT : NL;
    const bf16* YB = (const bf16*)(F.ws + WS_B); const unsigned* tok = (const unsigned*)(F.ws + WS_TOK);
    const float* g2g = a.in[I_LN2G] + layer * D; const float* g2b = a.in[I_LN2B] + layer * D;
    f32x4 pg2[4], pl2g[4], pl2b[4], qsh[4], qsc[4]; int cvec = -1;
    load_vec(g2g, F.lane, pl2g); load_vec(g2b, F.lane, pl2b);
    u32x4 tiA = {0u, 0u, 0u, 0u}, tiB = tiA; unsigned twA = 0u, twB = 0u;
    f32x4 nv[4]; u32x2 nya[4], nyb[4]; float nw0 = 0.f, nw1 = 0.f;
    int row = gw;
    if (row < rows_total) { tiB = *(const u32x4*)(tok + (size_t)row * 8); twB = tok[(size_t)row * 8 + 4]; }
    if (row + NGW < rows_total) { tiA = *(const u32x4*)(tok + (size_t)(row + NGW) * 8); twA = tok[(size_t)(row + NGW) * 8 + 4]; }
    if (row < rows_total) {
        const int e0 = tiB.x & 255, e1 = (tiB.x >> 8) & 255; const size_t r0 = (size_t)blk[e0] * 256 + tiB.y, r1 = (size_t)blk[e1] * 256 + tiB.z;
        load_row(row < NL ? a.out + (size_t)row * D : (const float*)(F.ws + WS_X1C) + (size_t)(row - NL) * D, F.lane, nv);
#pragma unroll
        for (int j = 0; j < 4; ++j) { nya[j] = *(const u32x2*)(YB + r0 * D + 256 * j + 4 * F.lane); nyb[j] = *(const u32x2*)(YB + r1 * D + 256 * j + 4 * F.lane); }
        nw0 = __uint_as_float(tiB.w); nw1 = __uint_as_float(twB);
    }
    while (row < rows_total) {
      { const int vec = row_vec(row); cvec = vec; load_ada(ada_vec(F, layer, vec, 5), F.lane, pg2); load_ada(ada_vec(F, 1, vec, 0), F.lane, qsh); load_ada(ada_vec(F, 1, vec, 1), F.lane, qsc);
        pin_vec(pg2); pin_vec(qsh); pin_vec(qsc); pin_vec(pl2g); pin_vec(pl2b); }
      int seg_hi = cvec == 0 ? SEQ : (cvec == 1 ? NL : MT); seg_hi = seg_hi < rows_total ? seg_hi : rows_total;
      while (row < seg_hi) {
        f32x4 v[4]; u32x2 ya[4], yb[4]; const float w0 = nw0, w1 = nw1;
#pragma unroll
        for (int j = 0; j < 4; ++j) { v[j] = nv[j]; ya[j] = nya[j]; yb[j] = nyb[j]; }
        const int nrow = row + NGW;
        u32x4 tiN; unsigned twN;
        { const int pr = nrow < rows_total ? nrow : rows_total - 1;
          const int e0 = tiA.x & 255, e1 = (tiA.x >> 8) & 255; const size_t r0 = (size_t)blk[e0] * 256 + tiA.y, r1 = (size_t)blk[e1] * 256 + tiA.z;
          load_row(pr < NL ? a.out + (size_t)pr * D : (const float*)(F.ws + WS_X1C) + (size_t)(pr - NL) * D, F.lane, nv);
#pragma unroll
          for (int j = 0; j < 4; ++j) { nya[j] = *(const u32x2*)(YB + r0 * D + 256 * j + 4 * F.lane); nyb[j] = *(const u32x2*)(YB + r1 * D + 256 * j + 4 * F.lane); }
          nw0 = __uint_as_float(tiA.w); nw1 = __uint_as_float(twA);
          const int r2 = (nrow + NGW < rows_total) ? nrow + NGW : rows_total - 1;
          tiN = *(const u32x4*)(tok + (size_t)r2 * 8); twN = tok[(size_t)r2 * 8 + 4]; }
        __builtin_amdgcn_sched_barrier(0);
#pragma unroll
        for (int j = 0; j < 4; ++j) {
            const f32x4 fa = {bf_lo(ya[j].x), bf_hi(ya[j].x), bf_lo(ya[j].y), bf_hi(ya[j].y)}, fb = {bf_lo(yb[j].x), bf_hi(yb[j].x), bf_lo(yb[j].y), bf_hi(yb[j].y)};
            v[j] = v[j] * ALPHA + pg2[j] * (fa * w0 + fb * w1); }
        float mean, rstd; ln_stats(v, mean, rstd);
#pragma unroll
        for (int j = 0; j < 4; ++j) v[j] = (v[j] - mean) * rstd * pl2g[j] + pl2b[j];
        if (layer == 0) { store_row((float*)(F.ws + WS_C) + (size_t)row * D, F.lane, v);
            ln_stats(v, mean, rstd); f32x4 hh[4];
#pragma unroll
            for (int j = 0; j < 4; ++j) hh[j] = (v[j] - mean) * rstd * (qsc[j] + 1.0f) + qsh[j];
            store_row_bf16((bf16*)(F.ws + WS_H) + (size_t)row * D, F.lane, hh); }
        else store_row(a.out + (size_t)row * D, F.lane, v);
        row = nrow; tiA = tiN; twA = twN;
      }
    }
}

constexpr int N_PHASES = 18;
typedef const __attribute__((address_space(4))) Args CArgs;
__device__ __forceinline__ CArgs& kargs() { CArgs* p = (CArgs*)__builtin_amdgcn_kernarg_segment_ptr(); asm volatile("" : "+s"(p)); return *p; }
#define args (kargs())
__global__ void __launch_bounds__(512, 2) fwd_kernel(Args args_unused) {
    extern __shared__ __attribute__((aligned(16))) unsigned char lds_raw[];
    Frame F;
    F.lds = (LAS unsigned char*)lds_raw; F.ws = args.ws; F.ctl = (unsigned*)(args.ws + WS_CTL);
    F.tid = threadIdx.x; F.lane = F.tid & 63; F.wave = __builtin_amdgcn_readfirstlane(F.tid >> 6);
    F.G = gridDim.x; { const int bx = blockIdx.x; F.vcu = (F.G % 8 == 0) ? (bx % 8) * (F.G / 8) + bx / 8 : bx; }
    for (int u = F.tid; u < (LDS_BYTES - MISC_OFF) / 4; u += 512) ((LAS unsigned*)(F.lds + MISC_OFF))[u] = 0u;
    __syncthreads();
    const int lo = args.ph_lo; int hi = args.ph_hi; const bool dry = hi > 100; if (dry) hi -= 100;
    XcdBarrier bar; bar.bar = F.ctl + CW_BAR; bar.x = 0; bar.st = nullptr;
    if (hi - lo > 1) bar = xcd_barrier_post(F.ctl + CW_BAR, (volatile LAS unsigned*)(F.lds + MISC_OFF + L_BARW));
#ifndef PH_MASK
#define PH_MASK 0xFFFFFFFFu
#endif
#define IN(k) (lo <= (k) && (k) < hi)
#define EN(b) ((PH_MASK >> (b)) & 1u)
#define FRESH() do { asm volatile("" : "+v"(F.tid)); F.lane = F.tid & 63; } while (0)
    const bool fused = (hi - lo) > 1;
#ifndef FILL_MASK
#define FILL_MASK 0u
#endif
#ifndef BG_DRAIN
#define BG_DRAIN 2
#endif
    constexpr int CONV_B1 = 130 * 13, CONV_B2 = CONV_B1 + 2 * 512, CONV_B3 = CONV_B2 + 2 * 512, CONV_B4 = CONV_B3 + 128 * 13;
    static_assert(CONV_B1 % 2 == 0 && CONV_B4 % 2 == 0 && CONV_B3 >= 3072 && CONV_B4 >= 5120 && CONV_B4 + 2 * 512 >= pg8::CONV_HALVES, "every expert matrix is converted before the phase that reads it");
#define SEAMX(k, fillbit, lim) do { if (IN(k) && IN((k) + 1)) { if (BG_DRAIN == 1 && fused && (((FILL_MASK >> (fillbit)) & 1u) || (lim) > 0)) { FRESH(); seam_fill(F, args, (k), (lim)); } xcd_barrier(bar); } } while (0)
#define SEAM(k) do { if (IN(k) && IN((k) + 1)) xcd_barrier(bar); } while (0)
    if (EN(0) && IN(0)) { FRESH(); phase_pre(F, args, BG_DRAIN == 2 ? !fused : (!fused || !BG_DRAIN)); } SEAM(0);
    if (EN(1) && IN(1)) { FRESH(); phase_h0(F, args); } SEAMX(1, 1, 0);
    for (int l = 0; l < 2; ++l) {
        const int pb = 2 + 8 * l;
        const int nMall = l == 0 ? 130 : 128;
        if (EN(2) && IN(pb + 0)) {
            InProjOrder S; S.init(F.ws + WS_H, F.ws + WS_WIN + (size_t)l * IN_COLS * D * 2, D, nMall, 13, F.G, (int)blockIdx.x);
            if (l == 1) { S.exN = 2; S.exPm0 = 128; S.exPn = 4; }
            EpiInProj E{(bf16*)(F.ws + WS_U), (bf16*)(F.ws + WS_Q), (bf16*)(F.ws + WS_K), (bf16*)(F.ws + WS_V), (bf16*)(F.ws + WS_GATE), (const float*)(F.ws + WS_ROPE)};
#if BG_DRAIN == 2
            const pg8::ConvW<1> CV{(const __attribute__((address_space(4))) char*)&args.in[I_WEG], F.ws, l == 0 ? 0 : CONV_B3, pg8::CONV_HALVES, F.G, (int)blockIdx.x};
            pg8::gemm_phase<EpiInProj, InProjOrder, true, pg8::ConvW<1>>(F.lds, D, S, E, CV);
#else
            pg8::gemm_phase<EpiInProj, InProjOrder, true>(F.lds, D, S, E);
#endif
        } SEAMX(pb + 0, 2, 0);
        if (EN(3) && IN(pb + 1)) { FRESH(); phase_mix(F, args, l); } SEAMX(pb + 1, 3, 0);
        if (EN(4) && IN(pb + 2)) {
            if (l == 0) { FRESH(); ctx_gemm<0>(F, (const bf16*)(F.ws + WS_PO), (const bf16*)(F.ws + WS_WPB), (const bf16*)(F.ws + WS_GATE), (bf16*)(F.ws + WS_F)); }
            PlainOrder S; S.init(F.ws + WS_PO, F.ws + WS_WPB + (size_t)l * D * D * 2, D, 128, 4, F.G, (int)blockIdx.x);
            EpiMergeOne E{(const bf16*)(F.ws + WS_GATE), (bf16*)(F.ws + WS_F)};
#if BG_DRAIN == 2
            { const pg8::ConvW<2> CV{(const __attribute__((address_space(4))) char*)&args.in[I_WEG], F.ws, l == 0 ? CONV_B1 : CONV_B4, pg8::CONV_HALVES, F.G, (int)blockIdx.x};
                pg8::gemm_phase<EpiMergeOne, PlainOrder, true, pg8::ConvW<2>>(F.lds, D, S, E, CV); }
#else
            pg8::gemm_phase<EpiMergeOne, PlainOrder, true>(F.lds, D, S, E);
#endif
        } SEAMX(pb + 2, 4, 0);
        if (EN(5) && IN(pb + 3)) {
            if (l == 0) { FRESH(); ctx_gemm<1>(F, (const bf16*)(F.ws + WS_F), (const bf16*)(F.ws + WS_WO), nullptr, (bf16*)(F.ws + WS_E)); }
            PlainOrder S; S.init(F.ws + WS_F, F.ws + WS_WO + (size_t)l * D * D * 2, D, 128, 4, F.G, (int)blockIdx.x);
            EpiPlainBf16 E{(bf16*)(F.ws + WS_E)};
#if BG_DRAIN == 2
            if (l == 0) { const pg8::ConvW<2> CV{(const __attribute__((address_space(4))) char*)&args.in[I_WEG], F.ws, CONV_B2, pg8::CONV_HALVES, F.G, (int)blockIdx.x};
                pg8::gemm_phase<EpiPlainBf16, PlainOrder, true, pg8::ConvW<2>>(F.lds, D, S, E, CV); }
            else
#endif
            pg8::gemm_phase<EpiPlainBf16, PlainOrder, true>(F.lds, D, S, E);
        } SEAMX(pb + 3, 5, 0);
        if (EN(6) && IN(pb + 4)) { FRESH(); phase_ln1_route(F, args, l, dry); } SEAMX(pb + 4, 6, l * BG_PER_LAYER + 16384);
        if (EN(7) && IN(pb + 5)) {
            FRESH(); moe_tables(F, l);
            MoeOrder<true> S{(const char*)(F.ws + WS_E), (const char*)(F.ws + WS_WEG + (size_t)l * 32 * D * D * 2), (const char*)(F.ws + WS_WEU + (size_t)l * 32 * D * D * 2), 8, F.G, F.vcu,
                             (const LAS int*)(F.lds + MISC_OFF + L_BLK), (const LAS int*)(F.lds + MISC_OFF + L_CNT), (const int*)(F.ws + WS_LIST)};
            EpiGateUp E{(bf16*)(F.ws + WS_A)};
            pg8::gemm_phase<EpiGateUp, MoeOrder<true>, true>(F.lds, D, S, E);
        } SEAMX(pb + 5, 7, (l + 1) * BG_PER_LAYER);
        if (EN(8) && IN(pb + 6)) {
            FRESH(); moe_tables(F, l);
            MoeOrder<false> S{(const char*)(F.ws + WS_A), (const char*)(F.ws + WS_WED + (size_t)l * 32 * D * D * 2), nullptr, 4, F.G, F.vcu,
                              (const LAS int*)(F.lds + MISC_OFF + L_BLK), (const LAS int*)(F.lds + MISC_OFF + L_CNT), (const int*)(F.ws + WS_LIST)};
            EpiPlainBf16 E{(bf16*)(F.ws + WS_B)};
            pg8::gemm_phase<EpiPlainBf16, MoeOrder<false>, true>(F.lds, D, S, E);
        } SEAMX(pb + 6, 8, 0);
        if (EN(9) && IN(pb + 7)) { FRESH(); phase_ln2(F, args, l); }
        if (l == 0) SEAMX(pb + 7, 9, 0);
    }
#undef IN
#undef SEAM
}

#undef args
extern "C" void kernel_launch(void* const* d_in, const int* in_sizes, int n_in, void* d_out, int out_size, void* d_ws, size_t ws_size, hipStream_t stream) {
    static int grid = 0;
    if (grid == 0) {
        if (n_in != 22 || out_size != NL * D || ws_size < WS_END) { fprintf(stderr, "kernel_launch: unexpected shapes (n_in %d, out %d, ws %zu, need %zu)\n", n_in, out_size, ws_size, (size_t)WS_END); grid = -1; return; }
        int dev = 0, cus = 0, per_cu = 0;
        if (hipGetDevice(&dev) != hipSuccess || hipDeviceGetAttribute(&cus, hipDeviceAttributeMultiprocessorCount, dev) != hipSuccess) { grid = -1; return; }
        if (hipFuncSetAttribute((const void*)fwd_kernel, hipFuncAttributeMaxDynamicSharedMemorySize, LDS_BYTES) != hipSuccess) { fprintf(stderr, "kernel_launch: hipFuncSetAttribute failed\n"); grid = -1; return; }
        if (hipOccupancyMaxActiveBlocksPerMultiprocessor(&per_cu, (const void*)fwd_kernel, 512, LDS_BYTES) != hipSuccess || per_cu < 1) fprintf(stderr, "kernel_launch: occupancy query reports %d\n", per_cu);
        (void)hipGetLastError();
        grid = cus;
    }
    if (grid < 0) return;
    static_assert((CW_PHDONE + 64 * 24) * 4 <= 512 * 1024, "every control word sits in the first 512 KiB");
    (void)hipMemsetAsync((char*)d_ws + WS_CTL, 0, 512 * 1024, stream);
    Args a{};
    for (int i = 0; i < 22; ++i) a.in[i] = (const float*)d_in[i];
    a.out = (float*)d_out; a.ws = (unsigned char*)d_ws;
#if MK_ONE_LAUNCH
    a.ph_lo = 0; a.ph_hi = N_PHASES;
    hipLaunchKernelGGL(fwd_kernel, dim3(grid), dim3(512), LDS_BYTES, stream, a);
#else
    for (int p = 0; p < N_PHASES; ++p) { a.ph_lo = p; a.ph_hi = p + 1;
#ifdef DUP_PHASE
        if (p == DUP_PHASE && (p == 6 || p == 14)) { a.ph_hi = p + 101; hipLaunchKernelGGL(fwd_kernel, dim3(grid), dim3(512), LDS_BYTES, stream, a); a.ph_hi = p + 1; }
#endif
        hipLaunchKernelGGL(fwd_kernel, dim3(grid), dim3(512), LDS_BYTES, stream, a);
#ifdef DUP_PHASE
        if (p == DUP_PHASE) { if (p == 0) (void)hipMemsetAsync((char*)d_ws + WS_CTL, 0, CTL_ZERO_BYTES, stream); if (p != 6 && p != 14) hipLaunchKernelGGL(fwd_kernel, dim3(grid), dim3(512), LDS_BYTES, stream, a); }
#endif
    }
#endif
}
```

```cpp
#include <hip/hip_runtime.h>
#include <cstdio>
#include <cstdint>

#ifndef MK_ONE_LAUNCH
#define MK_ONE_LAUNCH 1
#endif

#define GAS __attribute__((address_space(1)))
#define LAS __attribute__((address_space(3)))
typedef unsigned short bf16;
typedef short bf16x8 __attribute__((ext_vector_type(8)));
typedef float f32x4 __attribute__((ext_vector_type(4)));
typedef float f32x2 __attribute__((ext_vector_type(2)));
typedef unsigned u32x4 __attribute__((ext_vector_type(4)));
typedef unsigned u32x2 __attribute__((ext_vector_type(2)));
typedef GAS unsigned gu32;

constexpr int D = 1024, NB_ = 2, SEQ = 16384, CTX = 256;
constexpr int NL = NB_ * SEQ;
constexpr int NC = NB_ * CTX;
constexpr int MT = NL + NC;
constexpr int IN_COLS = 3328;
constexpr int NEXP = 32;
constexpr int LCAP = 2 * MT;
constexpr int MAXBLK = 291;
constexpr float LN_EPS = 1e-6f;
constexpr float ALPHA = 1.4142135623730951f;
constexpr float LOG2E = 1.4426950408889634f;
constexpr float QSCALE = 0.125f * LOG2E;

constexpr size_t WS_CTL = 0, CTL_ZERO_BYTES = 1u << 20;
constexpr int CW_TMO = 0;
constexpr int CW_BAR = 4096;
constexpr int CW_CNT = 8192;
constexpr int CW_QHEAD = 12288;
constexpr int CW_PHDONE = 12352;
constexpr int BG_PER_LAYER = 3 * 32 * 256, BG_TOTAL = 2 * BG_PER_LAYER;
constexpr size_t al256(size_t x) { return (x + 255) & ~(size_t)255; }
constexpr size_t WS_DUMMY = 768u << 10;
constexpr size_t WS_ROPE = CTL_ZERO_BYTES;
constexpr size_t WS_WRT  = WS_ROPE + 65536;
constexpr size_t WS_ADAP = WS_WRT + 131072;
constexpr size_t WS_WIN  = WS_ADAP + (size_t)36864 * 4;
constexpr size_t WS_WPG  = WS_WIN + (size_t)2 * IN_COLS * D * 2;
constexpr size_t WS_WPB  = WS_WPG + (size_t)2 * 4 * 128 * 128 * 2;
constexpr size_t WS_WAB  = WS_WPB + (size_t)2 * 1024 * 512 * 2;
constexpr size_t WS_WO   = WS_WAB + (size_t)2 * 1024 * 512 * 2;
constexpr size_t WS_WEG  = WS_WO + (size_t)2 * 1024 * 1024 * 2;
constexpr size_t WS_WEU  = WS_WEG + (size_t)64 * 1024 * 1024 * 2;
constexpr size_t WS_WED  = WS_WEU + (size_t)64 * 1024 * 1024 * 2;
constexpr size_t WS_LIST = WS_WED + (size_t)64 * 1024 * 1024 * 2;
constexpr size_t WS_TOK  = WS_LIST + (size_t)NEXP * LCAP * 4;
constexpr size_t WS_X1C  = WS_TOK + (size_t)MT * 32;
constexpr size_t WS_A    = al256(WS_X1C + (size_t)NC * D * 4);
constexpr size_t SZ_A    = (size_t)MT * 4608;
static_assert(SZ_A >= (size_t)MAXBLK * 256 * D * 2, "region A holds ACT");
constexpr size_t WS_H    = WS_A;
constexpr size_t WS_U    = WS_H + (size_t)MT * D * 2;
constexpr size_t WS_Q    = WS_U + (size_t)MT * 512 * 2;
constexpr size_t WS_K    = WS_Q + (size_t)MT * 512 * 2;
constexpr size_t WS_V    = WS_K + (size_t)MT * 128 * 2;
static_assert(WS_V + (size_t)MT * 128 * 2 <= WS_A + SZ_A, "region A");
constexpr size_t WS_B    = WS_A + SZ_A;
constexpr size_t WS_GATE = WS_B;
static_assert((size_t)MT * 2048 * 2 <= SZ_A, "region B");
constexpr size_t WS_C    = WS_B + SZ_A;
constexpr size_t WS_E    = WS_C + (size_t)MT * D * 4;
constexpr size_t WS_PO   = WS_E;
constexpr size_t WS_AO   = WS_E + (size_t)MT * 512 * 2;
constexpr size_t WS_F    = WS_E + (size_t)MT * D * 2;
constexpr size_t WS_END  = WS_F + (size_t)MT * D * 2;
static_assert(WS_END <= (size_t)1073741824, "d_ws map must fit 1 GiB");

constexpr int RING_BYTES = 131072;
constexpr int MISC_OFF = RING_BYTES;
constexpr int L_BARW = 0;
constexpr int L_QSLOT = 32;
constexpr int L_BLK = 64;
constexpr int L_CNT = 256;
constexpr int L_LCNT = 384;
constexpr int L_BASE = 512;
constexpr int L_ROW = 1024;
constexpr int L_CONV = 4096;
constexpr int LDS_BYTES = 151552;

#define RLX_AGENT __ATOMIC_RELAXED, __HIP_MEMORY_SCOPE_AGENT
#define LDS_WAIT() asm volatile("s_waitcnt lgkmcnt(0)" ::: "memory")
#define VM_WAIT() asm volatile("s_waitcnt vmcnt(0)" ::: "memory")

__device__ __forceinline__ unsigned cvt_pk_bf16(float lo, float hi) { unsigned r; asm volatile("v_cvt_pk_bf16_f32 %0, %1, %2" : "=v"(r) : "v"(lo), "v"(hi)); return r; }
__device__ __forceinline__ float bf_lo(unsigned w) { return __uint_as_float(w << 16); }
__device__ __forceinline__ float bf_hi(unsigned w) { return __uint_as_float(w & 0xffff0000u); }
__device__ __forceinline__ float bf2f(bf16 b) { return __uint_as_float(((unsigned)b) << 16); }
__device__ __forceinline__ float sigmoid_fast(float x) { return __builtin_amdgcn_rcpf(1.0f + __builtin_amdgcn_exp2f(-x * LOG2E)); }

namespace pg8 {
constexpr int BM = 256, BK = 64, HALF = 128, HTB = HALF * BK * 2, STAGE_BYTES = 8 * HTB, NXCD = 8, WGM = 8;
__host__ __device__ __forceinline__ int lds_byte(int r, int c) { const int st = (r >> 4) * 2 + (c >> 5), rr = r & 15, cc = c & 31, ob = rr * 64 + cc * 2; return st * 1024 + (ob ^ (((ob >> 9) & 1) << 5)); }
__host__ __device__ __forceinline__ void stage_rc(int b, int& R, int& C) { const int st = b / 1024, sb = b % 1024, swz = sb ^ (((sb >> 9) & 1) << 5); R = (st >> 1) * 16 + swz / 64; C = (st & 1) * 32 + (swz % 64) / 2; }
__host__ __device__ __forceinline__ int perm32(int rho) { const int n = rho >> 4, i = rho & 15; return 8 * (i >> 2) + 4 * n + (i & 3); }

struct Unit { int pm, pn, e, x0, x1; };

struct NoConv { static constexpr bool ON = false; static constexpr int RATE2 = 0; };
template <int RATE2_> struct ConvW { static constexpr bool ON = true; static constexpr int RATE2 = RATE2_; const __attribute__((address_space(4))) char* kin; unsigned char* ws; int base, limit, G, c; };
constexpr int CONV_HALVES = 2 * 3 * 32 * 32;
template <class Epi, class Sched, bool ALIGN_EPI, class Cv = NoConv>
__device__ __forceinline__ void gemm_phase(LAS unsigned char* lds, const int K, const Sched& S, const Epi& E, const Cv& CV = Cv{}) {
    int tid_l = threadIdx.x; asm volatile("" : "+v"(tid_l));
    const int tid = tid_l, wid = __builtin_amdgcn_readfirstlane(tid >> 6), lane = tid & 63, wr = wid >> 2, wc = wid & 3, fr = lane & 15, fq = lane >> 4;
    const int nt = K / BK;
    int Rr[2]; unsigned Cc[2], voffB[2];
#pragma unroll
    for (int i = 0; i < 2; ++i) { int R, C; stage_rc(tid * 16 + i * 8192, R, C); const int Rb = Epi::PERM ? ((R & ~31) + perm32(R & 31)) : R;
        Rr[i] = R; Cc[i] = (unsigned)C * 2u; voffB[i] = (unsigned)(Rb * K + C) * 2u; }
    const size_t kstep = (size_t)(BK * 2);
    const unsigned ldsw = (unsigned)wid * 1024u;
    const int aoff = lds_byte(wr * 64 + fr, fq * 8), boff = lds_byte(wc * 32 + fr, fq * 8);
#define PG8_SA(b, h) (((b) * 2 + (h)) * HTB)
#define PG8_SB(b, h) ((4 + (b) * 2 + (h)) * HTB)
#define PG8_STAGE(bufoff, gbase, voff) do { _Pragma("unroll") for (int _i = 0; _i < 2; ++_i) \
        __builtin_amdgcn_global_load_lds((const unsigned*)((const char*)(gbase) + (voff)[_i]), (LAS unsigned*)(lds + (bufoff) + ldsw + _i * 8192), 16, 0, 0); } while (0)
#define PG8_LDA(dst, b, h) do { _Pragma("unroll") for (int m = 0; m < 4; ++m) _Pragma("unroll") for (int k = 0; k < 2; ++k) dst[m][k] = *(const LAS bf16x8*)(lds + PG8_SA(b, h) + aoff + m * 2048 + k * 1024); } while (0)
#define PG8_LDB(dst, b, h) do { _Pragma("unroll") for (int n = 0; n < 2; ++n) _Pragma("unroll") for (int k = 0; k < 2; ++k) dst[n][k] = *(const LAS bf16x8*)(lds + PG8_SB(b, h) + boff + n * 2048 + k * 1024); } while (0)
#define PG8_MMA(ai, bj, At, Bt) do { __builtin_amdgcn_s_setprio(1); _Pragma("unroll") for (int m = 0; m < 4; ++m) _Pragma("unroll") for (int n = 0; n < 2; ++n) _Pragma("unroll") for (int k = 0; k < 2; ++k) \
        acc[ai][bj][m][n] = __builtin_amdgcn_mfma_f32_16x16x32_bf16(Bt[n][k], At[m][k], acc[ai][bj][m][n], 0, 0, 0); __builtin_amdgcn_s_setprio(0); } while (0)
#define PG8_WAIT_V(n) asm volatile("s_waitcnt vmcnt(" #n ")" ::: "memory")
#define PG8_WAIT_L(n) asm volatile("s_waitcnt lgkmcnt(" #n ")" ::: "memory")
#define PG8_BAR __builtin_amdgcn_s_barrier()
#define PG8_SCHED __builtin_amdgcn_sched_barrier(0)
    Unit cur, nxt; int ui = 0; cur.e = 0;
    if (!S.next(0, cur)) return;
    GAS const char* csrc = nullptr; GAS char* cdst = nullptr; unsigned cmask = 0u; int chb = 0;
    const unsigned clds = (unsigned)(RING_BYTES + L_CONV) + (unsigned)wid * 2048u;
#define PG8_CONV_UNIT(ui_) do { if constexpr (Cv::ON) { \
        int hc_ = CV.base + Cv::RATE2 * ((ui_) * CV.G + CV.c); const bool ok_ = hc_ < CV.limit; hc_ = ok_ ? hc_ : 0; int ch_ = hc_ >> 1; chb = Cv::RATE2 == 1 ? 8 * (hc_ & 1) : 0; \
        const int cl_ = ch_ / 1536, cr_ = ch_ - cl_ * 1536, cw_ = cr_ >> 9, cm_ = cl_ * 32 + ((cr_ & 511) >> 4), ck_ = (cr_ & 15) * 64; \
        const float* sb_ = *(const float* const __attribute__((address_space(4)))*)(CV.kin + 8 * cw_); const float* s0_ = *(const float* const __attribute__((address_space(4)))*)(CV.kin); \
        const size_t wo_ = cw_ == 0 ? WS_WEG : (cw_ == 1 ? WS_WEU : WS_WED); \
        csrc = (GAS const char*)(ok_ ? (const char*)(sb_ + (size_t)cm_ * 1048576 + (size_t)ck_ * 1024) : (const char*)s0_); \
        cdst = (GAS char*)(ok_ ? (char*)CV.ws + wo_ + ((size_t)cm_ * 1048576 + ck_) * 2 : (char*)CV.ws + WS_DUMMY + CV.c * 64); \
        cmask = ok_ ? 0xffffffffu : 0u; \
        } } while (0)
#define PG8_CONV_FLUSH(hp_, real_) do { const int hq_ = (hp_); const bool rl_ = (real_); \
        if constexpr (Cv::RATE2 == 2) PG8_WAIT_V(8); else PG8_WAIT_V(16); \
        int tl_ = tid; asm volatile("" : "+v"(tl_)); const int l_ = tl_ & 63; \
        const LAS float* rp_ = (const LAS float*)(lds + clds) + (8 * (l_ >> 4)) * 16 + (l_ & 15); float x_[8]; \
        _Pragma("unroll") for (int i_ = 0; i_ < 8; ++i_) x_[i_] = rp_[16 * i_]; \
        const unsigned do_ = ((unsigned)((128 * (hq_ & 7)) * 1024 + 32 * (hq_ >> 3)) * 2u) & cmask; \
        const unsigned cld_ = ((unsigned)((16 * wid + (l_ & 15)) * 1024 + 8 * (l_ >> 4)) * 2u) & cmask; \
        GAS char* dp_ = rl_ ? cdst : (GAS char*)((char*)CV.ws + WS_DUMMY + CV.c * 64); const unsigned lo_ = rl_ ? cld_ + do_ : 0u; \
        u32x4 o_; o_.x = cvt_pk_bf16(x_[0], x_[1]); o_.y = cvt_pk_bf16(x_[2], x_[3]); o_.z = cvt_pk_bf16(x_[4], x_[5]); o_.w = cvt_pk_bf16(x_[6], x_[7]); \
        __builtin_nontemporal_store(o_, (GAS u32x4*)(dp_ + lo_)); } while (0)
#define PG8_CONV_STAGE(h_) do { const int hh_ = (h_); \
        int tm_ = tid; asm volatile("" : "+v"(tm_)); const int lm_ = tm_ & 63; \
        const unsigned so_ = ((unsigned)((32 * (hh_ >> 3)) * 1024 + 128 * (hh_ & 7)) * 4u + (unsigned)((lm_ >> 2) * 1024 + 16 * wid + 4 * (lm_ & 3)) * 4u) & cmask; \
        PG8_WAIT_L(0); \
        __builtin_amdgcn_global_load_lds((GAS const unsigned*)(csrc + so_), (LAS unsigned*)(lds + clds), 16, 0, 2); \
        __builtin_amdgcn_global_load_lds((GAS const unsigned*)(csrc + 65536 + so_), (LAS unsigned*)(lds + clds + 1024), 16, 0, 2); } while (0)
#define PG8_CONV_STEP(hflush_, hstage_) do { PG8_CONV_FLUSH(hflush_, true); PG8_CONV_STAGE(hstage_); PG8_SCHED; } while (0)
#define PG8_CONV_START() do { if constexpr (Cv::ON) { PG8_SCHED; PG8_CONV_FLUSH(0, false); PG8_CONV_STAGE(chb); PG8_SCHED; } } while (0)
#define PG8_WAIT_VC(nc, n) do { if constexpr (Cv::ON) PG8_WAIT_V(nc); else PG8_WAIT_V(n); } while (0)
#define PG8_WAIT_VC2(nc, n) do { if constexpr (Cv::RATE2 == 2) PG8_WAIT_V(nc); else PG8_WAIT_V(n); } while (0)
    PG8_CONV_UNIT(0);
    f32x4 acc[2][2][4][2];
#pragma unroll
    for (int a = 0; a < 2; ++a)
#pragma unroll
        for (int b = 0; b < 2; ++b)
#pragma unroll
            for (int m = 0; m < 4; ++m)
#pragma unroll
                for (int n = 0; n < 2; ++n) acc[a][b][m][n] = (f32x4){0.f, 0.f, 0.f, 0.f};
    bf16x8 At[4][2], B0[2][2], B1[2][2];
    unsigned voffA[2][2];
#pragma unroll
    for (int h = 0; h < 2; ++h)
#pragma unroll
        for (int i = 0; i < 2; ++i) voffA[h][i] = S.a_off(cur, Rr[i] + 128 * h) + Cc[i];
    const char* const Ab = S.A;
    const char *cB0, *cB1; S.b_ptr(cur, cB0, cB1);
    PG8_STAGE(PG8_SB(0, 0), cB0, voffB); PG8_STAGE(PG8_SB(0, 1), cB1, voffB); PG8_STAGE(PG8_SA(0, 0), Ab, voffA[0]); PG8_STAGE(PG8_SA(0, 1), Ab, voffA[1]);
    if (wr == 1) PG8_BAR;
    PG8_WAIT_V(2); PG8_BAR;
    PG8_STAGE(PG8_SB(1, 0), cB0 + kstep, voffB); PG8_STAGE(PG8_SA(1, 0), Ab + kstep, voffA[0]); PG8_STAGE(PG8_SB(1, 1), cB1 + kstep, voffB);
    PG8_WAIT_V(6); PG8_BAR;
    PG8_CONV_START();
    for (;;) {
        nxt = cur; const bool has_next = S.next(ui + 1, nxt);
        const char *nB0 = cB0, *nB1 = cB1; if (has_next) S.b_ptr(nxt, nB0, nB1);
        for (int t = 0; t < nt; t += 2) {
            const bool last = (t == nt - 2);
            const char* a1 = Ab + (size_t)(t + 1) * kstep;
            const char* a2 = last ? Ab : Ab + (size_t)(t + 2) * kstep;
            const char* b20 = last ? nB0 : cB0 + (size_t)(t + 2) * kstep; const char* b21 = last ? nB1 : cB1 + (size_t)(t + 2) * kstep;
            const char* a3 = a2 + kstep; const char* b30 = b20 + kstep; const char* b31 = b21 + kstep;
            if constexpr (Epi::MID) { if (t == nt / 2) E.mid(acc, cur, wr, wc, fr, fq); }
            PG8_LDB(B0, 0, 0); PG8_LDB(B1, 0, 1); PG8_SCHED; PG8_LDA(At, 0, 0); PG8_STAGE(PG8_SA(1, 1), a1, voffA[1]);
            if (last && has_next) {
                int tt = tid; asm volatile("" : "+v"(tt));
#pragma unroll
                for (int i = 0; i < 2; ++i) { int R, C; stage_rc(tt * 16 + i * 8192, R, C);
#pragma unroll
                    for (int h = 0; h < 2; ++h) voffA[h][i] = S.a_off(nxt, R + 128 * h) + (unsigned)C * 2u; }
            }
            PG8_WAIT_VC(11, 8); PG8_WAIT_L(0); PG8_BAR; PG8_MMA(0, 0, At, B0); PG8_MMA(0, 1, At, B1); PG8_BAR; PG8_SCHED;
            PG8_LDA(At, 0, 1); PG8_STAGE(PG8_SB(0, 0), b20, voffB); PG8_STAGE(PG8_SB(0, 1), b21, voffB); PG8_STAGE(PG8_SA(0, 0), a2, voffA[0]);
            PG8_WAIT_VC(11, 8); PG8_WAIT_L(0); PG8_BAR; PG8_MMA(1, 0, At, B0); PG8_MMA(1, 1, At, B1);
            if constexpr (Cv::RATE2 == 2) PG8_CONV_STEP(t, t + 1);
            PG8_BAR; PG8_SCHED;
            PG8_LDB(B0, 1, 0); PG8_LDB(B1, 1, 1); PG8_SCHED; PG8_LDA(At, 1, 0); PG8_STAGE(PG8_SA(0, 1), a2, voffA[1]);
            PG8_WAIT_VC2(11, 8); PG8_WAIT_L(0); PG8_BAR; PG8_MMA(0, 0, At, B0); PG8_MMA(0, 1, At, B1); PG8_BAR; PG8_SCHED;
            PG8_LDA(At, 1, 1); PG8_STAGE(PG8_SB(1, 0), b30, voffB); PG8_STAGE(PG8_SB(1, 1), b31, voffB); PG8_STAGE(PG8_SA(1, 0), a3, voffA[0]);
            PG8_WAIT_VC2(11, 8); PG8_WAIT_L(0); PG8_BAR; PG8_MMA(1, 0, At, B0); PG8_MMA(1, 1, At, B1);
            if constexpr (Cv::ON) { int tq = t; asm volatile("" : "+s"(tq));
                if (tq + 2 < nt) { const int jc = chb + (Cv::RATE2 == 2 ? tq + 1 : (tq >> 1)); PG8_CONV_STEP(jc, jc + 1); } }
            PG8_BAR; PG8_SCHED;
        }
        if constexpr (Cv::ON) { PG8_CONV_FLUSH(chb + (Cv::RATE2 == 2 ? nt - 1 : nt / 2 - 1), true); PG8_SCHED; }
        if constexpr (ALIGN_EPI) { if (wr == 0) PG8_BAR; }
        E(acc, cur, wr, wc, fr, fq);
        if (!has_next) break;
#pragma unroll
        for (int a = 0; a < 2; ++a)
#pragma unroll
            for (int b = 0; b < 2; ++b)
#pragma unroll
                for (int m = 0; m < 4; ++m)
#pragma unroll
                    for (int n = 0; n < 2; ++n) acc[a][b][m][n] = (f32x4){0.f, 0.f, 0.f, 0.f};
        cur = nxt; cB0 = nB0; cB1 = nB1; ++ui;
        PG8_CONV_UNIT(ui); PG8_CONV_START();
        if constexpr (ALIGN_EPI) { if (wr == 1) PG8_BAR; }
    }
    PG8_WAIT_V(0);
    if constexpr (!ALIGN_EPI) { if (wr == 0) PG8_BAR; }
    PG8_BAR;
#undef PG8_SA
#undef PG8_SB
#undef PG8_STAGE
#undef PG8_LDA
#undef PG8_LDB
#undef PG8_MMA
#undef PG8_WAIT_V
#undef PG8_WAIT_VC
#undef PG8_WAIT_VC2
#undef PG8_CONV_UNIT
#undef PG8_CONV_STEP
#undef PG8_CONV_FLUSH
#undef PG8_WAIT_L
#undef PG8_BAR
#undef PG8_SCHED
}
}
using pg8::Unit;

#define XB_TMO      128
#define XB_XCNT(j)  (256  + 64 * (j))
#define XB_XSUB(j)  (1280 + 64 * (j))
#define XB_XGEN(j)  (2304 + 64 * (j))
#define XB_TOP      3328
#define XB_TOPGEN   3392
#define XCD_BAR_WORDS 3456
#define XB_SPIN_CAP (1u << 18)
__device__ __forceinline__ unsigned xb_ld(unsigned* p)              { return __hip_atomic_load(p, __ATOMIC_RELAXED, __HIP_MEMORY_SCOPE_AGENT); }
__device__ __forceinline__ unsigned xb_add(unsigned* p, unsigned v) { return __hip_atomic_fetch_add(p, v, __ATOMIC_RELAXED, __HIP_MEMORY_SCOPE_AGENT); }
__device__ __forceinline__ unsigned xb_xcc_id() { return (unsigned)__builtin_amdgcn_s_getreg((3 << 11) | 20) & 0xFu; }
#define XB_SPIN(cond, bar) do { unsigned _sp = 0; while (cond) { __builtin_amdgcn_s_sleep(1); \
    if ((++_sp & 255u) == 0u) { if (xb_ld(&(bar)[XB_TMO])) break; if (_sp > XB_SPIN_CAP) { atomicAdd(&(bar)[XB_TMO], 1u); break; } } } } while (0)
struct XcdBarrier { unsigned* bar; unsigned x; volatile LAS unsigned* st; };
__device__ __forceinline__ XcdBarrier xcd_barrier_post(unsigned* bar, volatile LAS unsigned* st) {
    XcdBarrier b; b.bar = bar; b.x = xb_xcc_id(); b.st = st;
    if (threadIdx.x == 0) (void)xb_add(&bar[XB_XCNT(b.x)], 1u);
    return b;
}
__device__ __forceinline__ void xcd_barrier_complete(unsigned* bar, unsigned x, unsigned& nloc, unsigned& nx) {
    const unsigned G = gridDim.x * gridDim.y * gridDim.z;
    unsigned sum, cnt, mine, sp = 0u;
    for (;;) {
        sum = 0u; cnt = 0u; mine = 0u;
#pragma unroll
        for (unsigned j = 0; j < 16; ++j) { const unsigned c = xb_ld(&bar[XB_XCNT(j)]); sum += c; cnt += (c > 0u) ? 1u : 0u; mine = (j == x) ? c : mine; }
        if (sum == G) break;
        __builtin_amdgcn_s_sleep(1);
        if ((++sp & 255u) == 0u) { if (xb_ld(&bar[XB_TMO])) break; if (sp > XB_SPIN_CAP) { atomicAdd(&bar[XB_TMO], 1u); break; } }
    }
    nloc = mine > 0u ? mine : 1u; nx = cnt > 0u ? cnt : 1u;
}
__device__ __forceinline__ void xcd_barrier(const XcdBarrier& b) {
    asm volatile("s_waitcnt vmcnt(0)" ::: "memory");
    __syncthreads();
    if (threadIdx.x == 0) {
        unsigned* bar = b.bar;
        __builtin_amdgcn_s_waitcnt(0);
        unsigned nloc = b.st[0], nx = b.st[1];
        if (nloc == 0u) { xcd_barrier_complete(bar, b.x, nloc, nx); b.st[0] = nloc; b.st[1] = nx; }
        const unsigned old = xb_add(&bar[XB_XSUB(b.x)], 1u);
        const unsigned gen = old / nloc;
        if (old + 1u == (gen + 1u) * nloc) {
            __builtin_amdgcn_fence(__ATOMIC_RELEASE, "agent");
            asm volatile("s_waitcnt vmcnt(0)" ::: "memory");
            const unsigned og = xb_add(&bar[XB_TOP], 1u);
            const unsigned tg = og / nx;
            if (og + 1u == (tg + 1u) * nx) xb_add(&bar[XB_TOPGEN], 1u);
            else XB_SPIN(xb_ld(&bar[XB_TOPGEN]) == tg, bar);
            __builtin_amdgcn_fence(__ATOMIC_ACQUIRE, "agent");
            xb_add(&bar[XB_XGEN(b.x)], 1u);
            asm volatile("s_waitcnt vmcnt(0)" ::: "memory");
        } else {
            XB_SPIN(xb_ld(&bar[XB_XGEN(b.x)]) == gen, bar);
            __builtin_amdgcn_fence(__ATOMIC_ACQUIRE, "agent");
            asm volatile("s_waitcnt vmcnt(0)" ::: "memory");
        }
    }
    __syncthreads();
}

struct Args { const float* in[22]; float* out; unsigned char* ws; int ph_lo, ph_hi; };
struct Frame {
    LAS unsigned char* lds; unsigned char* ws; unsigned* ctl;
    int tid, lane, wave, vcu, G;
};
enum { I_X = 0, I_C, I_CTX, I_CCTX, I_WADA, I_BADA, I_WIN, I_WPG, I_PSCALE, I_WPB, I_WAB, I_SINK, I_WO, I_LN1G, I_LN1B, I_WR, I_RB, I_WEG, I_WEU, I_WED, I_LN2G, I_LN2B };

template <int CTRL> __device__ __forceinline__ float dppf(float v) { return __builtin_bit_cast(float, __builtin_amdgcn_update_dpp(0, __builtin_bit_cast(int, v), CTRL, 0xf, 0xf, true)); }
template <int CTRL> __device__ __forceinline__ int dppi(int v) { return __builtin_amdgcn_update_dpp(0, v, CTRL, 0xf, 0xf, true); }
__device__ __forceinline__ float xor4f(float v) { return dppf<0x1B>(dppf<0x141>(v)); }
__device__ __forceinline__ int xor4i(int v) { return dppi<0x1B>(dppi<0x141>(v)); }
__device__ __forceinline__ float wave_sum(float v) {
#pragma unroll
    for (int o = 1; o < 64; o <<= 1) v += __shfl_xor(v, o);
    return v;
}
__device__ __forceinline__ void ln_stats(const f32x4 (&v)[4], float& mean, float& rstd) {
    float s = 0.f, q = 0.f;
#pragma unroll
    for (int j = 0; j < 4; ++j) { s += (v[j].x + v[j].y) + (v[j].z + v[j].w); q += (v[j].x * v[j].x + v[j].y * v[j].y) + (v[j].z * v[j].z + v[j].w * v[j].w); }
    s += dppf<0xB1>(s); q += dppf<0xB1>(q); s += dppf<0x4E>(s); q += dppf<0x4E>(q); s += dppf<0x141>(s); q += dppf<0x141>(q); s += dppf<0x140>(s); q += dppf<0x140>(q);
    s += __shfl_xor(s, 16); q += __shfl_xor(q, 16); s += __shfl_xor(s, 32); q += __shfl_xor(q, 32);
    mean = s * (1.f / D);
    const float var = fmaxf(q * (1.f / D) - mean * mean, 0.f);
    rstd = 1.0f / sqrtf(var + LN_EPS);
}
__device__ __forceinline__ void load_row(const float* p, int lane, f32x4 (&v)[4]) {
#pragma unroll
    for (int j = 0; j < 4; ++j) v[j] = *(const f32x4*)(p + 256 * j + 4 * lane);
}
__device__ __forceinline__ void store_row(float* p, int lane, const f32x4 (&v)[4]) {
#pragma unroll
    for (int j = 0; j < 4; ++j) *(f32x4*)(p + 256 * j + 4 * lane) = v[j];
}
__device__ __forceinline__ void store_row_bf16(bf16* p, int lane, const f32x4 (&v)[4]) {
#pragma unroll
    for (int j = 0; j < 4; ++j) { u32x2 w; w.x = cvt_pk_bf16(v[j].x, v[j].y); w.y = cvt_pk_bf16(v[j].z, v[j].w); *(u32x2*)(p + 256 * j + 4 * lane) = w; }
}
__device__ __forceinline__ void load_vec(const float* p, int lane, f32x4 (&v)[4]) {
#pragma unroll
    for (int j = 0; j < 4; ++j) v[j] = *(const f32x4*)(p + 256 * j + 4 * lane);
}
__device__ __forceinline__ void pin_vec(f32x4 (&v)[4]) {
#pragma unroll
    for (int j = 0; j < 4; ++j) asm volatile("" : "+v"(v[j]));
}
__device__ __forceinline__ int row_vec(int row) { return row < NL ? (row >> 14) : 2; }
__device__ __forceinline__ const float* ada_vec(const Frame& F, int layer, int vec, int chunk) { return (const float*)(F.ws + WS_ADAP) + ((size_t)(layer * 3 + vec) * 6 + chunk) * D; }
__device__ __forceinline__ void load_ada(const float* p, int lane, f32x4 (&v)[4]) { load_vec(p, lane, v); }
__device__ __forceinline__ void modulate_store(const f32x4 (&v)[4], const float* sh, const float* sc, bf16* out, int lane) {
    float mean, rstd; ln_stats(v, mean, rstd);
    f32x4 h[4];
#pragma unroll
    for (int j = 0; j < 4; ++j) { const f32x4 s1 = *(const f32x4*)(sc + 256 * j + 4 * lane), s0 = *(const f32x4*)(sh + 256 * j + 4 * lane); h[j] = (v[j] - mean) * rstd * (s1 + 1.0f) + s0; }
    store_row_bf16(out, lane, h);
}

__device__ __forceinline__ void transpose_item(const float* W, int K, int N, bf16* WT, int k0, int n0, bool perm, LAS float* scr, int lane, int ldk = 0, int kd0 = -1) {
    if (ldk == 0) ldk = K; if (kd0 < 0) kd0 = k0;
    f32x4 r[16];
#pragma unroll
    for (int q = 0; q < 16; ++q) r[q] = *(const f32x4*)(W + (size_t)(k0 + 4 * q + (lane >> 4)) * N + n0 + 4 * (lane & 15));
#pragma unroll
    for (int hf = 0; hf < 2; ++hf) {
#pragma unroll
        for (int q = 0; q < 8; ++q) { const int kk = 4 * q + (lane >> 4); LAS float* d = scr + kk * 65 + 4 * (lane & 15); const f32x4 x = r[hf * 8 + q]; d[0] = x.x; d[1] = x.y; d[2] = x.z; d[3] = x.w; }
        LDS_WAIT(); asm volatile("" ::: "memory");
        const int c = lane & 3;
#pragma unroll
        for (int i = 0; i < 4; ++i) {
            const int n = (lane >> 2) + 16 * i;
            int ns = n;
            if (perm) { const int hh = n >> 5, rem = n & 31; ns = 32 * hh + 16 * (rem & 1) + (rem >> 1); }
            const LAS float* s = scr + (8 * c) * 65 + ns;
            u32x4 o; o.x = cvt_pk_bf16(s[0 * 65], s[1 * 65]); o.y = cvt_pk_bf16(s[2 * 65], s[3 * 65]); o.z = cvt_pk_bf16(s[4 * 65], s[5 * 65]); o.w = cvt_pk_bf16(s[6 * 65], s[7 * 65]);
            *(u32x4*)(WT + (size_t)(n0 + n) * ldk + kd0 + 32 * hf + 8 * c) = o;
        }
        LDS_WAIT(); asm volatile("" ::: "memory");
    }
}
__device__ __forceinline__ float silu_f(float x) { return x / (1.0f + expf(-x)); }
struct TDesc { const float* src; bf16* dst; int N, ldk, k0, kd0, n0, perm; };
__device__ __forceinline__ void t_load(const TDesc& d, int lane, f32x4 (&r)[16]) {
#pragma unroll
    for (int q = 0; q < 16; ++q) r[q] = *(const f32x4*)(d.src + (size_t)(d.k0 + 4 * q + (lane >> 4)) * d.N + d.n0 + 4 * (lane & 15));
}
__device__ __forceinline__ void t_process(const TDesc& d, int lane, const f32x4 (&r)[16], LAS float* scr) {
#pragma unroll
    for (int hf = 0; hf < 2; ++hf) {
#pragma unroll
        for (int q = 0; q < 8; ++q) { const int kk = 4 * q + (lane >> 4); LAS float* p = scr + kk * 65 + 4 * (lane & 15); const f32x4 x = r[hf * 8 + q]; p[0] = x.x; p[1] = x.y; p[2] = x.z; p[3] = x.w; }
        LDS_WAIT(); asm volatile("" ::: "memory");
        const int c = lane & 3;
#pragma unroll
        for (int i = 0; i < 4; ++i) {
            const int n = (lane >> 2) + 16 * i;
            int ns = n;
            if (d.perm) { const int hh = n >> 5, rem = n & 31; ns = 32 * hh + 16 * (rem & 1) + (rem >> 1); }
            const LAS float* sp = scr + (8 * c) * 65 + ns;
            u32x4 o; o.x = cvt_pk_bf16(sp[0 * 65], sp[1 * 65]); o.y = cvt_pk_bf16(sp[2 * 65], sp[3 * 65]); o.z = cvt_pk_bf16(sp[4 * 65], sp[5 * 65]); o.w = cvt_pk_bf16(sp[6 * 65], sp[7 * 65]);
            *(u32x4*)(d.dst + (size_t)(d.n0 + n) * d.ldk + d.kd0 + 32 * hf + 8 * c) = o;
        }
        LDS_WAIT(); asm volatile("" ::: "memory");
    }
}
template <class AT> __device__ __forceinline__ TDesc t_decode(Frame& F, AT& a, int r) {
    constexpr int I_WINn = 2 * 16 * 52, I_WPGn = 2 * 4 * 2 * 2, I_WPBn = 2 * 8 * 16, I_WOn = 2 * 16 * 16, I_EXn = 64 * 256;
    TDesc d; d.perm = 0; d.src = nullptr; d.dst = nullptr; d.N = 0; d.ldk = 0; d.k0 = 0; d.kd0 = 0; d.n0 = 0;
    if (r < I_WINn) { const int l = r / 832, q = r % 832, kb = q / 52, nb = q % 52; d.src = a.in[I_WIN] + (size_t)l * D * IN_COLS; d.dst = (bf16*)(F.ws + WS_WIN) + (size_t)l * IN_COLS * D; d.N = IN_COLS; d.ldk = D; d.k0 = 64 * kb; d.kd0 = d.k0; d.n0 = 64 * nb; d.perm = (d.n0 >= 512 && d.n0 < 1152) ? 1 : 0; return d; }
    r -= I_WINn;
    if (r < I_WPGn) { const int m = r / 4, q = r % 4; d.src = a.in[I_WPG] + (size_t)m * 128 * 128; d.dst = (bf16*)(F.ws + WS_WPG) + (size_t)m * 128 * 128; d.N = 128; d.ldk = 128; d.k0 = 64 * (q >> 1); d.kd0 = d.k0; d.n0 = 64 * (q & 1); return d; }
    r -= I_WPGn;
    if (r < 2 * I_WPBn) { const int second = r >= I_WPBn; if (second) r -= I_WPBn; const int l = r / 128, q = r % 128; d.src = a.in[second ? I_WAB : I_WPB] + (size_t)l * 512 * D; d.dst = (bf16*)(F.ws + WS_WPB) + (size_t)l * D * D; d.N = D; d.ldk = D; d.k0 = 64 * (q / 16); d.kd0 = (second ? 512 : 0) + d.k0; d.n0 = 64 * (q % 16); return d; }
    r -= 2 * I_WPBn;
    if (r < I_WOn) { const int l = r / 256, q = r % 256; d.src = a.in[I_WO] + (size_t)l * D * D; d.dst = (bf16*)(F.ws + WS_WO) + (size_t)l * D * D; d.N = D; d.ldk = D; d.k0 = 64 * (q / 16); d.kd0 = d.k0; d.n0 = 64 * (q % 16); return d; }
    r -= I_WOn;
    { const int which = r / I_EXn, q = r % I_EXn, m = q / 256, t = q % 256;
      d.src = a.in[which == 0 ? I_WEG : (which == 1 ? I_WEU : I_WED)] + (size_t)m * D * D;
      d.dst = (bf16*)(F.ws + (which == 0 ? WS_WEG : (which == 1 ? WS_WEU : WS_WED))) + (size_t)m * D * D;
      d.N = D; d.ldk = D; d.k0 = 64 * (t / 16); d.kd0 = d.k0; d.n0 = 64 * (t % 16); }
    return d;
}
template <class AT> __device__ __forceinline__ void phase_pre(Frame& F, AT& a, bool with_experts) {
    LAS float* scr = (LAS float*)(F.lds + F.wave * 8448);
    const int gw = F.vcu * 8 + F.wave, NGW = F.G * 8;
    { float* tab = (float*)(F.ws + WS_ROPE);
      for (int idx = blockIdx.x * 512 + F.tid; idx < 320 * 16; idx += F.G * 512) {
          const int p = idx >> 4, i = idx & 15; const int pos = p < 256 ? p : p - 256;
          const float inv = powf(10000.0f, -(float)i / 16.0f); const float ang = (float)pos * inv;
          tab[2 * idx] = cosf(ang); tab[2 * idx + 1] = sinf(ang); } }
    { const float* wr = a.in[I_WR]; float* wt = (float*)(F.ws + WS_WRT);
      for (int idx = blockIdx.x * 512 + F.tid; idx < D * NEXP; idx += F.G * 512) { const int c = idx >> 5, e = idx & 31; wt[e * D + c] = wr[idx]; } }
    if (F.vcu < 48) {
        const int l = F.vcu / 24, cg = F.vcu % 24, kc = F.wave; const int col = cg * 256 + 4 * F.lane;
        const float* W = a.in[I_WADA] + (size_t)l * D * 6144 + col;
        f32x4 a0 = {0.f, 0.f, 0.f, 0.f}, a1 = a0, a2 = a0;
        for (int kb = kc * 128; kb < kc * 128 + 128; kb += 16) {
            f32x4 w[16];
#pragma unroll
            for (int i = 0; i < 16; ++i) w[i] = *(const f32x4*)(W + (size_t)(kb + i) * 6144);
            const int kl = kb + (F.lane & 15);
            const float m0 = silu_f(a.in[I_C][kl]), m1 = silu_f(a.in[I_C][D + kl]), m2 = silu_f(a.in[I_CCTX][kl]);
#pragma unroll
            for (int i = 0; i < 16; ++i) {
                const float s0 = __builtin_bit_cast(float, __builtin_amdgcn_readlane(__builtin_bit_cast(int, m0), i)), s1 = __builtin_bit_cast(float, __builtin_amdgcn_readlane(__builtin_bit_cast(int, m1), i)), s2 = __builtin_bit_cast(float, __builtin_amdgcn_readlane(__builtin_bit_cast(int, m2), i));
                a0 += w[i] * s0; a1 += w[i] * s1; a2 += w[i] * s2; }
        }
        LAS f32x4* part = (LAS f32x4*)(F.lds + 69632);
        part[(kc * 3 + 0) * 64 + F.lane] = a0; part[(kc * 3 + 1) * 64 + F.lane] = a1; part[(kc * 3 + 2) * 64 + F.lane] = a2;
        __syncthreads();
        if (F.tid < 192) { const int v = F.tid >> 6, ln = F.tid & 63;
            f32x4 sum = part[(0 * 3 + v) * 64 + ln];
#pragma unroll
            for (int w8 = 1; w8 < 8; ++w8) sum += part[(w8 * 3 + v) * 64 + ln];
            sum += *(const f32x4*)(a.in[I_BADA] + (size_t)l * 6144 + cg * 256 + 4 * ln);
            *(f32x4*)((float*)(F.ws + WS_ADAP) + (size_t)(l * 3 + v) * 6144 + cg * 256 + 4 * ln) = sum; }
        __syncthreads();
    }
    constexpr int I_SMALL = 2 * 16 * 52 + 2 * 4 * 2 * 2 + 2 * 2 * 8 * 16 + 2 * 16 * 16, I_EXn = 64 * 256;
    const int NT = I_SMALL + (with_experts ? 3 * I_EXn : 0);
    int it = gw;
    if (it < NT) {
        f32x4 rc[16]; { const TDesc d0 = t_decode(F, a, it); t_load(d0, F.lane, rc); }
        for (;;) {
            const int nx = it + NGW; const bool more = nx < NT;
            f32x4 rn[16];
            if (more) { const TDesc nd = t_decode(F, a, nx); t_load(nd, F.lane, rn); }
            { const TDesc cd = t_decode(F, a, it); t_process(cd, F.lane, rc, scr); }
            if (!more) break;
            it = nx;
#pragma unroll
            for (int q = 0; q < 16; ++q) rc[q] = rn[q];
        }
    }
}
template <class AT> __device__ __forceinline__ void bg_item(Frame& F, AT& a, int it, LAS float* scr) {
    const int layer = it / BG_PER_LAYER, r = it % BG_PER_LAYER, which = r >> 13, q = r & 8191, m = layer * 32 + (q >> 8), t = q & 255;
    const float* src = a.in[which == 0 ? I_WEG : (which == 1 ? I_WEU : I_WED)] + (size_t)m * D * D;
    bf16* dst = (bf16*)(F.ws + (which == 0 ? WS_WEG : (which == 1 ? WS_WEU : WS_WED))) + (size_t)m * D * D;
    transpose_item(src, D, D, dst, 64 * (t / 16), 64 * (t % 16), false, scr, F.lane);
}
template <class AT> __device__ __forceinline__ TDesc bg_desc(Frame& F, AT& a, int it) {
    const int layer = it / BG_PER_LAYER, r = it % BG_PER_LAYER, which = r >> 13, q = r & 8191, m = layer * 32 + (q >> 8), t = q & 255;
    TDesc d; d.perm = 0;
    d.src = a.in[which == 0 ? I_WEG : (which == 1 ? I_WEU : I_WED)] + (size_t)m * D * D;
    d.dst = (bf16*)(F.ws + (which == 0 ? WS_WEG : (which == 1 ? WS_WEU : WS_WED))) + (size_t)m * D * D;
    d.N = D; d.ldk = D; d.k0 = 64 * (t / 16); d.kd0 = d.k0; d.n0 = 64 * (t % 16);
    return d;
}
template <class AT> __device__ __forceinline__ void seam_fill(Frame& F, AT& a, int k, int drain_limit) {
    LAS int* slot = (LAS int*)(F.lds + MISC_OFF + L_QSLOT);
    LAS float* scr = (LAS float*)(F.lds + F.wave * 8448);
    __syncthreads();
    if (F.tid == 0) (void)__hip_atomic_fetch_add(F.ctl + CW_PHDONE + 64 * k, 1u, RLX_AGENT);
    for (;;) {
        if (F.tid == 0) {
            int base = 0x7fffffff, cnt = 0;
            const int head = (int)__hip_atomic_load(F.ctl + CW_QHEAD, RLX_AGENT);
            if (head < drain_limit) { cnt = 64; base = (int)__hip_atomic_fetch_add(F.ctl + CW_QHEAD, 64u, RLX_AGENT); }
            else if (head < BG_TOTAL && (int)__hip_atomic_load(F.ctl + CW_PHDONE + 64 * k, RLX_AGENT) < F.G) { cnt = 8; base = (int)__hip_atomic_fetch_add(F.ctl + CW_QHEAD, 8u, RLX_AGENT); }
            slot[0] = base; slot[1] = cnt;
        }
        __syncthreads();
        const int base = slot[0], cnt = slot[1];
        if (base >= BG_TOTAL) break;
        int it = base + F.wave; const int end = (base + cnt < BG_TOTAL) ? base + cnt : BG_TOTAL;
        if (it < end) {
            f32x4 rc[16]; { const TDesc d0 = bg_desc(F, a, it); t_load(d0, F.lane, rc); }
            for (;;) {
                const int nx = it + 8; const bool more = nx < end;
                f32x4 rn[16];
                if (more) { const TDesc nd = bg_desc(F, a, nx); t_load(nd, F.lane, rn); }
                { const TDesc cd = bg_desc(F, a, it); t_process(cd, F.lane, rc, scr); }
                if (!more) break;
                it = nx;
#pragma unroll
                for (int q = 0; q < 16; ++q) rc[q] = rn[q];
            }
        }
        __syncthreads();
    }
}

template <class AT> __device__ __forceinline__ void phase_h0(Frame& F, AT& a) {
    const int gw = F.vcu * 8 + F.wave, NGW = F.G * 8;
    f32x4 psh[4], psc[4]; int cvec = -1;
    f32x4 nv[4]; int row = gw;
    if (row < MT) load_row(row < NL ? a.in[I_X] + (size_t)row * D : a.in[I_CTX] + (size_t)(row - NL) * D, F.lane, nv);
    while (row < MT) {
      { const int vec = row_vec(row); cvec = vec; load_ada(ada_vec(F, 0, vec, 0), F.lane, psh); load_ada(ada_vec(F, 0, vec, 1), F.lane, psc); pin_vec(psh); pin_vec(psc); }
      const int seg_hi = cvec == 0 ? SEQ : (cvec == 1 ? NL : MT);
      while (row < seg_hi) {
        f32x4 v[4];
#pragma unroll
        for (int j = 0; j < 4; ++j) v[j] = nv[j];
        const int nrow = row + NGW;
        if (nrow < MT) load_row(nrow < NL ? a.in[I_X] + (size_t)nrow * D : a.in[I_CTX] + (size_t)(nrow - NL) * D, F.lane, nv);
        __builtin_amdgcn_sched_barrier(0);
        { float mean, rstd; ln_stats(v, mean, rstd); f32x4 hh[4];
#pragma unroll
          for (int j = 0; j < 4; ++j) hh[j] = (v[j] - mean) * rstd * (psc[j] + 1.0f) + psh[j];
          store_row_bf16((bf16*)(F.ws + WS_H) + (size_t)row * D, F.lane, hh); }
        row = nrow;
      }
    }
}

struct PlainOrder {
    const char* A; const char* Bt; int K, nM, nN, nwg, G, c, exN, exPm0, exPn;
    __device__ __forceinline__ void init(const void* A_, const void* Bt_, int K_, int nM_, int nN_, int G_, int c_) { A = (const char*)A_; Bt = (const char*)Bt_; K = K_; nM = nM_; nN = nN_; nwg = nM * nN; G = G_; c = c_; exN = 0; exPm0 = 0; exPn = 0; }
    __device__ __forceinline__ bool next(int i, Unit& u) const {
        int L = i * G + c; u.e = 0; u.x0 = 0; u.x1 = 0;
        if (L >= nwg) { L -= nwg; if (L < exN) { u.pm = exPm0 + L; u.pn = exPn; return true; } return false; }
        int wgid = L; { const int q = nwg / 8, r = nwg % 8, xcd = wgid % 8, off = wgid / 8; wgid = (xcd < r ? xcd * (q + 1) : r * (q + 1) + (xcd - r) * q) + off; }
        const int nig = 8 * nN, gid = wgid / nig, fm = gid * 8, gsz = (nM - fm) < 8 ? (nM - fm) : 8;
        u.pm = fm + ((wgid % nig) % gsz); u.pn = (wgid % nig) / gsz; return true;
    }
    __device__ __forceinline__ unsigned a_off(const Unit& u, int R) const { return (unsigned)(u.pm * 256 + R) * (unsigned)(K * 2); }
    __device__ __forceinline__ void b_ptr(const Unit& u, const char*& b0, const char*& b1) const { b0 = Bt + (size_t)u.pn * 256 * K * 2; b1 = b0 + (size_t)128 * K * 2; }
};
struct InProjOrder : PlainOrder {
    __device__ __forceinline__ void b_ptr(const Unit& u, const char*& b0, const char*& b1) const {
        if (u.pn < 5) { b0 = Bt + (size_t)u.pn * 256 * K * 2; b1 = b0 + (size_t)128 * K * 2; }
        else { b0 = Bt + (size_t)(1280 + 128 * (u.pn - 5)) * K * 2; b1 = Bt + (size_t)(2304 + 128 * (u.pn - 5)) * K * 2; }
    }
};
template <bool GATHER> struct MoeOrder {
    const char* A; const char* B0; const char* B1; int NPN, G, vcu; const LAS int* blk; const LAS int* cnt; const int* list;
    __device__ __forceinline__ bool next(int i, Unit& u) const {
        const int L = i * G + vcu; const int NB = blk[32];
        if (L >= NB * NPN) return false;
        const int rbg = L / NPN; u.pn = L % NPN; int e = (i > 0) ? u.e : 0;
        if (e < 0 || e > 31 || rbg < blk[e]) e = 0;
        while (e < 31 && rbg >= blk[e + 1]) ++e;
        const int rb = rbg - blk[e]; u.pm = rbg; u.e = e; u.x0 = e * LCAP + rb * 256; u.x1 = cnt[e] - rb * 256; return true;
    }
    __device__ __forceinline__ unsigned a_off(const Unit& u, int R) const {
        if (GATHER) { int tok = list[u.x0 + R]; tok = (R < u.x1) ? tok : 0; return (unsigned)tok * 2048u; }
        return (unsigned)(u.pm * 256 + R) * 2048u;
    }
    __device__ __forceinline__ void b_ptr(const Unit& u, const char*& b0, const char*& b1) const {
        if (GATHER) { const size_t o = ((size_t)u.e * 1024 + (size_t)u.pn * 128) * 2048; b0 = B0 + o; b1 = B1 + o; }
        else { b0 = B0 + ((size_t)u.e * 1024 + (size_t)u.pn * 256) * 2048; b1 = b0 + (size_t)128 * 2048; }
    }
};

typedef const f32x4 (&AccRef)[2][2][4][2];
__device__ __forceinline__ void store8(bf16* p, const f32x4& a, const f32x4& b) { u32x4 w; w.x = cvt_pk_bf16(a.x, a.y); w.y = cvt_pk_bf16(a.z, a.w); w.z = cvt_pk_bf16(b.x, b.y); w.w = cvt_pk_bf16(b.z, b.w); *(u32x4*)p = w; }
struct EpiInProj {
    static constexpr bool PERM = true; static constexpr bool MID = false;
    bf16 *U, *Q, *Kb, *Vb, *GT; const float* rope;
    __device__ __forceinline__ void rot(f32x4& a, f32x4& b, const f32x4& c0, const f32x4& c1) const {
        const f32x4 ia = a, ib = b;
        a.x = ia.x * c0.x - ia.y * c0.y; a.y = ia.y * c0.x + ia.x * c0.y; a.z = ia.z * c0.z - ia.w * c0.w; a.w = ia.w * c0.z + ia.z * c0.w;
        b.x = ib.x * c1.x - ib.y * c1.y; b.y = ib.y * c1.x + ib.x * c1.y; b.z = ib.z * c1.z - ib.w * c1.w; b.w = ib.w * c1.z + ib.z * c1.w;
    }
    __device__ __forceinline__ void operator()(AccRef acc, const Unit& u, int wr, int wc, int fr, int fq) const {
        const int pn = u.pn; int rowb = u.pm * 256 + wr * 64 + fr; const int cl = wc * 32 + 8 * fq; asm volatile("" : "+v"(rowb));
        const bool lat = u.pm < 128;
        if (pn >= 2 && pn <= 4) {
#pragma unroll
            for (int ai = 0; ai < 2; ++ai) {
                f32x4 cs[4][2];
                if (lat) {
#pragma unroll
                    for (int m = 0; m < 4; ++m) { const int t = (rowb + ai * 128 + m * 16) & (SEQ - 1); const int p = (wc & 1) ? 256 + (t & 63) : (t >> 6);
                        cs[m][0] = *(const f32x4*)(rope + (size_t)(p * 16 + 4 * fq) * 2); cs[m][1] = *(const f32x4*)(rope + (size_t)(p * 16 + 4 * fq) * 2 + 4); }
#pragma unroll
                    for (int m = 0; m < 4; ++m) asm volatile("" : "+v"(cs[m][0]), "+v"(cs[m][1]));
                }
#pragma unroll
                for (int m = 0; m < 4; ++m) { const int row = rowb + ai * 128 + m * 16;
#pragma unroll
                    for (int bj = 0; bj < 2; ++bj) { f32x4 v0 = acc[ai][bj][m][0], v1 = acc[ai][bj][m][1];
                        if (pn < 4) { if (lat) rot(v0, v1, cs[m][0], cs[m][1]); v0 *= QSCALE; v1 *= QSCALE; store8(Q + (size_t)row * 512 + (pn - 2) * 256 + bj * 128 + cl, v0, v1); }
                        else if (bj == 0) { if (lat) rot(v0, v1, cs[m][0], cs[m][1]); store8(Kb + (size_t)row * 128 + cl, v0, v1); }
                        else store8(Vb + (size_t)row * 128 + cl, v0, v1); } }
            }
            return;
        }
#pragma unroll
        for (int ai = 0; ai < 2; ++ai)
#pragma unroll
            for (int m = 0; m < 4; ++m) {
                const int row = rowb + ai * 128 + m * 16;
#pragma unroll
                for (int bj = 0; bj < 2; ++bj) {
                    const f32x4 v0 = acc[ai][bj][m][0], v1 = acc[ai][bj][m][1];
                    if (pn < 2) { store8(U + (size_t)row * 512 + pn * 256 + bj * 128 + cl, v0, v1); }
                    else if (bj == 0) {
                        f32x4 a0 = acc[ai][1][m][0], a1 = acc[ai][1][m][1]; f32x4 r0, r1, g0, g1;
#pragma unroll
                        for (int j = 0; j < 4; ++j) { a0[j] = fmaxf(a0[j], -30.0f); a1[j] = fmaxf(a1[j], -30.0f); }
#pragma unroll
                        for (int j = 0; j < 4; ++j) { const float ea0 = __builtin_amdgcn_exp2f(-a0[j] * LOG2E), ea1 = __builtin_amdgcn_exp2f(-a1[j] * LOG2E);
                            g0[j] = __builtin_amdgcn_rcpf(1.0f + ea0); g1[j] = __builtin_amdgcn_rcpf(1.0f + ea1);
                            r0[j] = sigmoid_fast(v0[j]) * (1.0f + ea0); r1[j] = sigmoid_fast(v1[j]) * (1.0f + ea1); }
                        store8(GT + (size_t)row * 2048 + (pn - 5) * 128 + cl, r0, r1); store8(GT + (size_t)row * 2048 + 1024 + (pn - 5) * 128 + cl, g0, g1); }
                }
            }
    }
};
__device__ __forceinline__ void load8(const bf16* p, f32x4& a, f32x4& b) { const u32x4 w = *(const u32x4*)p; a = (f32x4){bf_lo(w.x), bf_hi(w.x), bf_lo(w.y), bf_hi(w.y)}; b = (f32x4){bf_lo(w.z), bf_hi(w.z), bf_lo(w.w), bf_hi(w.w)}; }
struct EpiMergeOne {
    static constexpr bool PERM = true; static constexpr bool MID = true;
    const bf16* GT; bf16* G;
    __device__ __forceinline__ void mid(f32x4 (&acc)[2][2][4][2], const Unit& u, int wr, int wc, int fr, int fq) const {
        int rowb = u.pm * 256 + wr * 64 + fr; const int colb = u.pn * 256 + wc * 32 + 8 * fq; asm volatile("" : "+v"(rowb));
        const bf16* gp = GT + (size_t)rowb * 2048 + colb;
        u32x4 g[2][4][2];
#pragma unroll
        for (int ai = 0; ai < 2; ++ai)
#pragma unroll
            for (int m = 0; m < 4; ++m)
#pragma unroll
                for (int bj = 0; bj < 2; ++bj) g[ai][m][bj] = *(const u32x4*)(gp + (size_t)(ai * 128 + m * 16) * 2048 + bj * 128);
#pragma unroll
        for (int ai = 0; ai < 2; ++ai)
#pragma unroll
            for (int m = 0; m < 4; ++m)
#pragma unroll
                for (int bj = 0; bj < 2; ++bj) asm volatile("" : "+v"(g[ai][m][bj]));
#pragma unroll
        for (int ai = 0; ai < 2; ++ai)
#pragma unroll
            for (int m = 0; m < 4; ++m)
#pragma unroll
                for (int bj = 0; bj < 2; ++bj) { const u32x4 w = g[ai][m][bj];
                    acc[ai][bj][m][0] *= (f32x4){bf_lo(w.x), bf_hi(w.x), bf_lo(w.y), bf_hi(w.y)}; acc[ai][bj][m][1] *= (f32x4){bf_lo(w.z), bf_hi(w.z), bf_lo(w.w), bf_hi(w.w)}; }
    }
    __device__ __forceinline__ void operator()(AccRef acc, const Unit& u, int wr, int wc, int fr, int fq) const {
        int rowb = u.pm * 256 + wr * 64 + fr; const int colb = u.pn * 256 + wc * 32 + 8 * fq; asm volatile("" : "+v"(rowb));
        const bf16* gp = GT + (size_t)rowb * 2048 + 1024 + colb;
        u32x4 g[2][4][2];
#pragma unroll
        for (int ai = 0; ai < 2; ++ai)
#pragma unroll
            for (int m = 0; m < 4; ++m)
#pragma unroll
                for (int bj = 0; bj < 2; ++bj) g[ai][m][bj] = *(const u32x4*)(gp + (size_t)(ai * 128 + m * 16) * 2048 + bj * 128);
#pragma unroll
        for (int ai = 0; ai < 2; ++ai)
#pragma unroll
            for (int m = 0; m < 4; ++m)
#pragma unroll
                for (int bj = 0; bj < 2; ++bj) asm volatile("" : "+v"(g[ai][m][bj]));
#pragma unroll
        for (int ai = 0; ai < 2; ++ai)
#pragma unroll
            for (int m = 0; m < 4; ++m) { const int row = rowb + ai * 128 + m * 16;
#pragma unroll
                for (int bj = 0; bj < 2; ++bj) { const int col = colb + bj * 128; const u32x4 w = g[ai][m][bj];
                    const f32x4 g0 = {bf_lo(w.x), bf_hi(w.x), bf_lo(w.y), bf_hi(w.y)}, g1 = {bf_lo(w.z), bf_hi(w.z), bf_lo(w.w), bf_hi(w.w)};
                    store8(G + (size_t)row * D + col, acc[ai][bj][m][0] * g0, acc[ai][bj][m][1] * g1); } }
    }
};
struct EpiGateUp {
    static constexpr bool PERM = true; static constexpr bool MID = false;
    bf16* ACT;
    __device__ __forceinline__ void operator()(AccRef acc, const Unit& u, int wr, int wc, int fr, int fq) const {
        const int rowb = u.pm * 256 + wr * 64 + fr, col = u.pn * 128 + wc * 32 + 8 * fq;
#pragma unroll
        for (int ai = 0; ai < 2; ++ai)
#pragma unroll
            for (int m = 0; m < 4; ++m) {
                const int row = rowb + ai * 128 + m * 16; f32x4 o[2];
#pragma unroll
                for (int n = 0; n < 2; ++n)
#pragma unroll
                    for (int j = 0; j < 4; ++j) { const float g = acc[ai][0][m][n][j]; o[n][j] = g * sigmoid_fast(g) * acc[ai][1][m][n][j]; }
                store8(ACT + (size_t)row * D + col, o[0], o[1]);
            }
    }
};
struct EpiPlainBf16 {
    static constexpr bool PERM = true; static constexpr bool MID = false;
    bf16* O;
    __device__ __forceinline__ void operator()(AccRef acc, const Unit& u, int wr, int wc, int fr, int fq) const {
        const int rowb = u.pm * 256 + wr * 64 + fr, colb = u.pn * 256 + wc * 32 + 8 * fq;
#pragma unroll
        for (int ai = 0; ai < 2; ++ai)
#pragma unroll
            for (int m = 0; m < 4; ++m) {
                const int row = rowb + ai * 128 + m * 16;
#pragma unroll
                for (int bj = 0; bj < 2; ++bj) store8(O + (size_t)row * D + colb + bj * 128, acc[ai][bj][m][0], acc[ai][bj][m][1]);
            }
    }
};

template <int MODE> __device__ __forceinline__ void ctx_gemm(Frame& F, const bf16* A, const bf16* Bt, const bf16* GT, bf16* O) {
    const int lane = F.lane, i16 = lane & 15, kq = lane >> 4;
    const int rg = F.vcu >> 5, cg = F.vcu & 31;
    if (F.vcu >= 256) return;
    const int row = NL + 64 * rg + 16 * (F.wave & 3) + i16, n0 = 32 * cg + 16 * (F.wave >> 2);
    const bf16* ap = A + (size_t)row * D + 8 * kq; const bf16* bp = Bt + (size_t)(n0 + i16) * D + 8 * kq;
    f32x4 acc = {0.f, 0.f, 0.f, 0.f};
#pragma unroll 1
    for (int kb = 0; kb < 4; ++kb) {
        bf16x8 af[8], bfg[8];
#pragma unroll
        for (int s = 0; s < 8; ++s) { af[s] = *(const bf16x8*)(ap + 256 * kb + 32 * s); bfg[s] = *(const bf16x8*)(bp + 256 * kb + 32 * s); }
        if (MODE == 0 && kb == 2) { const int col = n0 + 4 * kq; const u32x2 w = *(const u32x2*)(GT + (size_t)row * 2048 + col);
            acc *= (f32x4){bf_lo(w.x), bf_hi(w.x), bf_lo(w.y), bf_hi(w.y)}; }
#pragma unroll
        for (int s = 0; s < 8; ++s) acc = __builtin_amdgcn_mfma_f32_16x16x32_bf16(bfg[s], af[s], acc, 0, 0, 0);
    }
    const int col = n0 + 4 * kq;
    if (MODE == 0) { const u32x2 w = *(const u32x2*)(GT + (size_t)row * 2048 + 1024 + col); acc *= (f32x4){bf_lo(w.x), bf_hi(w.x), bf_lo(w.y), bf_hi(w.y)}; }
    u32x2 o; o.x = cvt_pk_bf16(acc.x, acc.y); o.y = cvt_pk_bf16(acc.z, acc.w);
    *(u32x2*)(O + (size_t)row * D + col) = o;
}

template <class AT> __device__ __forceinline__ void pool_unit(Frame& F, AT& a, int layer, int rt, int g) {
    LAS float* P = (LAS float*)F.lds;
    const bf16* U = (const bf16*)(F.ws + WS_U);
    const int w = 2 << g;
    __syncthreads();
    { const int r = F.tid >> 3, c16 = (F.tid & 7) * 16; const int row = rt * 64 + r;
      int s0, len, t;
      if (row < NL) { s0 = row & ~(SEQ - 1); len = SEQ; t = row - s0; } else { s0 = NL + ((row - NL) & ~(CTX - 1)); len = CTX; t = row - s0; }
      int lo = t - w / 2, hi = t - w / 2 + w - 1; lo = lo < 0 ? 0 : lo; hi = hi > len - 1 ? len - 1 : hi;
      float sum[16];
#pragma unroll
      for (int j = 0; j < 16; ++j) sum[j] = 0.f;
      for (int tt = lo; tt <= hi; ++tt) { f32x4 x0, x1, x2, x3; const bf16* p = U + (size_t)(s0 + tt) * 512 + g * 128 + c16; load8(p, x0, x1); load8(p + 8, x2, x3);
#pragma unroll
          for (int j = 0; j < 4; ++j) { sum[j] += x0[j]; sum[4 + j] += x1[j]; sum[8 + j] += x2[j]; sum[12 + j] += x3[j]; } }
      const float inv = 1.0f / (float)(hi - lo + 1);
      f32x4 x0, x1, x2, x3; const bf16* p = U + (size_t)row * 512 + g * 128 + c16; load8(p, x0, x1); load8(p + 8, x2, x3);
#pragma unroll
      for (int j = 0; j < 4; ++j) { P[r * 128 + c16 + j] = sum[j] * inv - x0[j]; P[r * 128 + c16 + 4 + j] = sum[4 + j] * inv - x1[j]; P[r * 128 + c16 + 8 + j] = sum[8 + j] * inv - x2[j]; P[r * 128 + c16 + 12 + j] = sum[12 + j] * inv - x3[j]; } }
    __syncthreads();
    { const int d = F.tid & 127, rg = F.tid >> 7;
      const float* Wg = a.in[I_WPG] + ((size_t)(layer * 4 + g) * 128) * 128 + d;
      float acc[16];
#pragma unroll
      for (int j = 0; j < 16; ++j) acc[j] = 0.f;
      for (int c = 0; c < 128; ++c) { const float wv = Wg[(size_t)c * 128];
#pragma unroll
          for (int j = 0; j < 16; ++j) acc[j] += P[(rg * 16 + j) * 128 + c] * wv; }
      const float sc = a.in[I_PSCALE][layer * 512 + g * 128 + d];
      bf16* O = (bf16*)(F.ws + WS_PO);
#pragma unroll
      for (int j = 0; j < 16; ++j) O[(size_t)(rt * 64 + rg * 16 + j) * 1024 + g * 128 + d] = (bf16)(cvt_pk_bf16(acc[j] * sc, 0.f) & 0xffffu); }
}
template <class AT> __device__ __forceinline__ void attn_unit_simple(Frame& F, AT& a, int layer, int qrow0, int qpos0, int g, int lrow0, int jlo, int jhi, int crow0) {
    LAS float* Ks = (LAS float*)F.lds; LAS float* Vs = Ks + 64 * 64;
    const bf16* Q = (const bf16*)(F.ws + WS_Q); const bf16* Kb = (const bf16*)(F.ws + WS_K); const bf16* Vb = (const bf16*)(F.ws + WS_V);
    const int qi = F.tid & 127, r = F.tid >> 7, h = 4 * g + r; const int qrow = qrow0 + qi, qpos = qpos0 + qi;
    float q[64], o[64];
#pragma unroll
    for (int c = 0; c < 8; ++c) { f32x4 x0, x1; load8(Q + (size_t)qrow * 512 + h * 64 + 8 * c, x0, x1);
#pragma unroll
        for (int j = 0; j < 4; ++j) { q[8 * c + j] = x0[j]; q[8 * c + 4 + j] = x1[j]; } }
#pragma unroll
    for (int d = 0; d < 64; ++d) o[d] = 0.f;
    float m = a.in[I_SINK][layer * 8 + h] * LOG2E, l = 1.0f;
    const int nloc = jhi >= jlo ? jhi - jlo + 1 : 0;
    for (int ch = 0; ch < nloc + 4; ++ch) {
        const bool local = ch < nloc; const int j = jlo + ch;
        const int krow0 = local ? lrow0 + 64 * j : crow0 + 64 * (ch - nloc);
        __syncthreads();
        { const int key = F.tid >> 3, d8 = (F.tid & 7) * 8; f32x4 x0, x1;
          load8(Kb + (size_t)(krow0 + key) * 128 + g * 64 + d8, x0, x1); *(LAS f32x4*)(Ks + key * 64 + d8) = x0; *(LAS f32x4*)(Ks + key * 64 + d8 + 4) = x1;
          load8(Vb + (size_t)(krow0 + key) * 128 + g * 64 + d8, x0, x1); *(LAS f32x4*)(Vs + key * 64 + d8) = x0; *(LAS f32x4*)(Vs + key * 64 + d8 + 4) = x1; }
        __syncthreads();
#pragma unroll 1
        for (int kk = 0; kk < 64; ++kk) {
            const LAS float* kr = Ks + kk * 64; float dsum = 0.f;
#pragma unroll
            for (int d = 0; d < 64; d += 4) { const f32x4 kv = *(const LAS f32x4*)(kr + d); dsum += q[d] * kv.x + q[d + 1] * kv.y + q[d + 2] * kv.z + q[d + 3] * kv.w; }
            bool valid = true;
            if (local) { const int kpos = 64 * j + kk; const int df = qpos - kpos; valid = (df <= 128) && (df >= -128); }
            const float sc = valid ? dsum : -INFINITY;
            const float mn = fmaxf(m, sc), al = __builtin_amdgcn_exp2f(m - mn), p = __builtin_amdgcn_exp2f(sc - mn);
            l = l * al + p; m = mn;
            const LAS float* vr = Vs + kk * 64;
#pragma unroll
            for (int d = 0; d < 64; d += 4) { const f32x4 vv = *(const LAS f32x4*)(vr + d); o[d] = o[d] * al + p * vv.x; o[d + 1] = o[d + 1] * al + p * vv.y; o[d + 2] = o[d + 2] * al + p * vv.z; o[d + 3] = o[d + 3] * al + p * vv.w; }
        }
    }
    const float il = 1.0f / l; bf16* O = (bf16*)(F.ws + WS_PO) + (size_t)qrow * 1024 + 512 + h * 64;
#pragma unroll
    for (int c = 0; c < 8; ++c) { f32x4 x0, x1;
#pragma unroll
        for (int j = 0; j < 4; ++j) { x0[j] = o[8 * c + j] * il; x1[j] = o[8 * c + 4 + j] * il; }
        store8(O + 8 * c, x0, x1); }
}
typedef float f32x16 __attribute__((ext_vector_type(16)));
typedef short s16x4 __attribute__((ext_vector_type(4)));
typedef short v4i16_t __attribute__((ext_vector_type(4)));
constexpr int AK_STRIDE = 144, AV_STRIDE = 192, AK_BYTES = 64 * AK_STRIDE, AV_BYTES = 64 * AV_STRIDE, ABUF_BYTES = AK_BYTES + AV_BYTES;
#ifndef ATT_THR
#define ATT_THR 8.0f
#endif
template <class AT> __device__ __forceinline__ void attn_unit_mfma(Frame& F, AT& a, int layer, int qrow0, int qpos0, int g, int lrow0, int jlo, int jhi, int crow0) {
    const bf16* Q = (const bf16*)(F.ws + WS_Q); const bf16* Kb = (const bf16*)(F.ws + WS_K); const bf16* Vb = (const bf16*)(F.ws + WS_V);
    const int lane = F.lane, r32 = lane & 31, hi = lane >> 5, w = F.wave, r = w >> 1, hq = w & 1, h = 4 * g + r;
    bf16x8 qf[2][4];
#pragma unroll
    for (int qt = 0; qt < 2; ++qt)
#pragma unroll
        for (int s = 0; s < 4; ++s) qf[qt][s] = *(const bf16x8*)(Q + (size_t)(qrow0 + 64 * hq + 32 * qt + r32) * 512 + h * 64 + 16 * s + 8 * hi);
    f32x16 O[2][2];
#pragma unroll
    for (int dt = 0; dt < 2; ++dt)
#pragma unroll
        for (int qt = 0; qt < 2; ++qt)
#pragma unroll
            for (int i = 0; i < 16; ++i) O[dt][qt][i] = 0.f;
    const float sink2 = a.in[I_SINK][layer * 8 + h] * LOG2E;
    float m[2] = {sink2, sink2}, l[2]; l[0] = hi == 0 ? 1.0f : 0.0f; l[1] = l[0];
    const int nloc = jhi >= jlo ? jhi - jlo + 1 : 0, NT = nloc + 4;
    const int skey = F.tid >> 3, sc8 = F.tid & 7;
    const int qa = qpos0 + 64 * hq;
    u32x4 kreg, vreg;
    const unsigned lane_off = (unsigned)(skey * 128 + 8 * sc8) * 2u;
    { const int krow = nloc > 0 ? lrow0 + 64 * jlo : crow0;
      kreg = *(const u32x4*)((const char*)(Kb + (size_t)krow * 128 + g * 64) + lane_off); vreg = *(const u32x4*)((const char*)(Vb + (size_t)krow * 128 + g * 64) + lane_off); }
    __syncthreads();
    *(LAS u32x4*)(F.lds + skey * AK_STRIDE + sc8 * 16) = kreg; *(LAS u32x4*)(F.lds + AK_BYTES + skey * AV_STRIDE + sc8 * 16) = vreg;
    __syncthreads();
#pragma unroll 1
    for (int it = 0; it < NT; ++it) {
        const int bo = (it & 1) * ABUF_BYTES;
        if (it + 1 < NT) { const int krow = (it + 1 < nloc) ? lrow0 + 64 * (jlo + it + 1) : crow0 + 64 * (it + 1 - nloc);
            kreg = *(const u32x4*)((const char*)(Kb + (size_t)krow * 128 + g * 64) + lane_off); vreg = *(const u32x4*)((const char*)(Vb + (size_t)krow * 128 + g * 64) + lane_off); }
        int mode = 1; const int ka = 64 * (jlo + it);
        if (it < nloc) { if (ka - (qa + 63) > 128 || qa - (ka + 63) > 128) mode = 0; else if (ka + 63 - qa > 128 || qa + 63 - ka > 128) mode = 2; }
        if (mode != 0) {
            unsigned kbase = (unsigned)bo + (unsigned)(r32 * AK_STRIDE + 16 * hi), vbase = (unsigned)bo + (unsigned)(AK_BYTES + (4 * hi + ((lane & 15) >> 2)) * AV_STRIDE + (16 * ((lane >> 4) & 1) + 4 * (lane & 3)) * 2);
            asm volatile("" : "+v"(kbase), "+v"(vbase));
            const LAS unsigned char* Kl = F.lds + kbase; const LAS unsigned char* Vl = F.lds + vbase;
#define ATT_VLOAD(dst, kt_) do { _Pragma("unroll") for (int s2 = 0; s2 < 2; ++s2) _Pragma("unroll") for (int dt = 0; dt < 2; ++dt) { \
                const LAS unsigned char* vp = Vl + (32 * (kt_) + 16 * s2) * AV_STRIDE + (32 * dt) * 2; \
                const s16x4 lo = __builtin_bit_cast(s16x4, __builtin_amdgcn_ds_read_tr16_b64_v4i16((LAS v4i16_t*)vp)); \
                const s16x4 hh = __builtin_bit_cast(s16x4, __builtin_amdgcn_ds_read_tr16_b64_v4i16((LAS v4i16_t*)(vp + 8 * AV_STRIDE))); \
                dst[s2][dt] = (bf16x8){lo[0], lo[1], lo[2], lo[3], hh[0], hh[1], hh[2], hh[3]}; } } while (0)
#pragma unroll
            for (int qt = 0; qt < 2; ++qt) {
                f32x16 S0, S1;
#pragma unroll
                for (int i = 0; i < 16; ++i) { S0[i] = 0.f; S1[i] = 0.f; }
                { bf16x8 ka[4], kb[4];
#pragma unroll
                  for (int s = 0; s < 4; ++s) ka[s] = *(const LAS bf16x8*)(Kl + 32 * s);
#pragma unroll
                  for (int s = 0; s < 4; ++s) asm volatile("" : "+v"(ka[s]));
#pragma unroll
                  for (int s = 0; s < 4; ++s) kb[s] = *(const LAS bf16x8*)(Kl + 32 * AK_STRIDE + 32 * s);
#pragma unroll
                  for (int s = 0; s < 4; ++s) S0 = __builtin_amdgcn_mfma_f32_32x32x16_bf16(ka[s], qf[qt][s], S0, 0, 0, 0);
#pragma unroll
                  for (int s = 0; s < 4; ++s) asm volatile("" : "+v"(kb[s]));
#pragma unroll
                  for (int s = 0; s < 4; ++s) S1 = __builtin_amdgcn_mfma_f32_32x32x16_bf16(kb[s], qf[qt][s], S1, 0, 0, 0); }
                if (mode == 2) { const int qp = qa + 32 * qt + r32;
#pragma unroll
                    for (int i = 0; i < 16; ++i) { const int kp = ka + (i & 3) + 8 * (i >> 2) + 4 * hi; const int d0 = qp - kp, d1 = d0 - 32;
                        if (d0 > 128 || d0 < -128) S0[i] = -INFINITY; if (d1 > 128 || d1 < -128) S1[i] = -INFINITY; } }
                float ta = fmaxf(fmaxf(S0[0], S0[1]), S0[2]), tb = fmaxf(fmaxf(S1[0], S1[1]), S1[2]);
#pragma unroll
                for (int i = 3; i < 15; i += 2) { ta = fmaxf(fmaxf(ta, S0[i]), S0[i + 1]); tb = fmaxf(fmaxf(tb, S1[i]), S1[i + 1]); }
                float tmax = fmaxf(fmaxf(ta, tb), fmaxf(S0[15], S1[15]));
                tmax = fmaxf(tmax, __shfl_xor(tmax, 32));
                if (__any(tmax > m[qt] + ATT_THR)) {
                    const float mn = fmaxf(m[qt], tmax), al = __builtin_amdgcn_exp2f(m[qt] - mn);
                    l[qt] *= al; m[qt] = mn;
#pragma unroll
                    for (int i = 0; i < 16; ++i) { O[0][qt][i] *= al; O[1][qt][i] *= al; }
                }
                const float mm = m[qt]; const f32x2 nm2 = {-mm, -mm}; f32x2 ls2 = {0.f, 0.f};
#pragma unroll
                for (int i = 0; i < 16; i += 2) {
                    f32x2 a0 = (f32x2){S0[i], S0[i + 1]} + nm2, a1 = (f32x2){S1[i], S1[i + 1]} + nm2;
                    a0.x = __builtin_amdgcn_exp2f(a0.x); a0.y = __builtin_amdgcn_exp2f(a0.y); a1.x = __builtin_amdgcn_exp2f(a1.x); a1.y = __builtin_amdgcn_exp2f(a1.y);
                    S0[i] = a0.x; S0[i + 1] = a0.y; S1[i] = a1.x; S1[i + 1] = a1.y; ls2 += a0; ls2 += a1; }
                l[qt] += ls2.x + ls2.y;
                bf16x8 pf[2][2];
#pragma unroll
                for (int s2 = 0; s2 < 2; ++s2) {
                    u32x4 p0, p1;
                    p0.x = cvt_pk_bf16(S0[8 * s2 + 0], S0[8 * s2 + 1]); p0.y = cvt_pk_bf16(S0[8 * s2 + 2], S0[8 * s2 + 3]); p0.z = cvt_pk_bf16(S0[8 * s2 + 4], S0[8 * s2 + 5]); p0.w = cvt_pk_bf16(S0[8 * s2 + 6], S0[8 * s2 + 7]);
                    p1.x = cvt_pk_bf16(S1[8 * s2 + 0], S1[8 * s2 + 1]); p1.y = cvt_pk_bf16(S1[8 * s2 + 2], S1[8 * s2 + 3]); p1.z = cvt_pk_bf16(S1[8 * s2 + 4], S1[8 * s2 + 5]); p1.w = cvt_pk_bf16(S1[8 * s2 + 6], S1[8 * s2 + 7]);
                    pf[0][s2] = __builtin_bit_cast(bf16x8, p0); pf[1][s2] = __builtin_bit_cast(bf16x8, p1);
                }
                { bf16x8 g0[2], g1[2], g2[2], g3[2];
#define ATT_VG(dst, kt_, s2_) do { _Pragma("unroll") for (int dt = 0; dt < 2; ++dt) { \
                const LAS unsigned char* vp = Vl + (32 * (kt_) + 16 * (s2_)) * AV_STRIDE + (32 * dt) * 2; \
                const s16x4 lo = __builtin_bit_cast(s16x4, __builtin_amdgcn_ds_read_tr16_b64_v4i16((LAS v4i16_t*)vp)); \
                const s16x4 hh = __builtin_bit_cast(s16x4, __builtin_amdgcn_ds_read_tr16_b64_v4i16((LAS v4i16_t*)(vp + 8 * AV_STRIDE))); \
                dst[dt] = (bf16x8){lo[0], lo[1], lo[2], lo[3], hh[0], hh[1], hh[2], hh[3]}; } } while (0)
#define ATT_PIN2(x) asm volatile("" : "+v"(x[0]), "+v"(x[1]))
#define ATT_PV(x, kt_, s2_) do { O[0][qt] = __builtin_amdgcn_mfma_f32_32x32x16_bf16(x[0], pf[kt_][s2_], O[0][qt], 0, 0, 0); O[1][qt] = __builtin_amdgcn_mfma_f32_32x32x16_bf16(x[1], pf[kt_][s2_], O[1][qt], 0, 0, 0); } while (0)
                  ATT_VG(g0, 0, 0); ATT_VG(g1, 0, 1); ATT_PIN2(g0); ATT_PV(g0, 0, 0);
                  ATT_VG(g2, 1, 0); ATT_PIN2(g1); ATT_PV(g1, 0, 1);
                  ATT_VG(g3, 1, 1); ATT_PIN2(g2); ATT_PV(g2, 1, 0);
                  ATT_PIN2(g3); ATT_PV(g3, 1, 1); }
            }
        }
        if (it + 1 < NT) { const int bn = ((it + 1) & 1) * ABUF_BYTES;
            *(LAS u32x4*)(F.lds + bn + skey * AK_STRIDE + sc8 * 16) = kreg; *(LAS u32x4*)(F.lds + bn + AK_BYTES + skey * AV_STRIDE + sc8 * 16) = vreg; }
        __syncthreads();
    }
#pragma unroll
    for (int qt = 0; qt < 2; ++qt) {
        const float lt = l[qt] + __shfl_xor(l[qt], 32), il = 1.0f / lt;
        bf16* Op = (bf16*)(F.ws + WS_PO) + (size_t)(qrow0 + 64 * hq + 32 * qt + r32) * 1024 + 512 + h * 64;
#pragma unroll
        for (int dt = 0; dt < 2; ++dt)
#pragma unroll
            for (int g4 = 0; g4 < 4; ++g4) { u32x2 wv; wv.x = cvt_pk_bf16(O[dt][qt][4 * g4] * il, O[dt][qt][4 * g4 + 1] * il); wv.y = cvt_pk_bf16(O[dt][qt][4 * g4 + 2] * il, O[dt][qt][4 * g4 + 3] * il);
                *(u32x2*)(Op + 32 * dt + 8 * g4 + 4 * hi) = wv; }
    }
}
constexpr int PL_STRIDE = 272;
constexpr int PL_UT = 0, PL_PT = 24576;
template <int W, class AT> __device__ __forceinline__ void pool_units_mfma(Frame& F, AT& a, int layer, int u0, int ustride, int n_units) {
    if (u0 >= n_units) return;
    const bf16* U = (const bf16*)(F.ws + WS_U);
    const int g = u0 & 3; constexpr int w = W;
    const int lane = F.lane, i16 = lane & 15, kq = lane >> 4, rt4 = F.wave & 3, ch = F.wave >> 2;
    const bf16* Wt = (const bf16*)(F.ws + WS_WPG) + (size_t)(layer * 4 + g) * 128 * 128;
    bf16x8 wb[4][4];
#pragma unroll
    for (int ks = 0; ks < 4; ++ks)
#pragma unroll
        for (int ct = 0; ct < 4; ++ct) wb[ks][ct] = *(const bf16x8*)(Wt + (size_t)(64 * ch + 16 * ct + i16) * 128 + 32 * ks + 8 * kq);
    f32x4 scv[4];
#pragma unroll
    for (int ct = 0; ct < 4; ++ct) scv[ct] = *(const f32x4*)(a.in[I_PSCALE] + layer * 512 + g * 128 + 64 * ch + 16 * ct + 4 * kq);
    u32x4 st[3];
    auto stage_load = [&](int u) {
        const int row0 = (u >> 2) * 64; int s0, len;
        if (row0 < NL) { s0 = row0 & ~(SEQ - 1); len = SEQ; } else { s0 = NL + ((row0 - NL) & ~(CTX - 1)); len = CTX; }
        const int t0 = row0 - s0;
#pragma unroll
        for (int i = 0; i < 3; ++i) { const int idx = F.tid + 512 * i, rr = idx >> 4, cc = idx & 15; const int t = t0 - 8 + rr;
            st[i] = (u32x4){0u, 0u, 0u, 0u};
            if (idx < 1280 && t >= 0 && t < len) st[i] = *(const u32x4*)(U + (size_t)(s0 + t) * 512 + g * 128 + 8 * cc); }
    };
    stage_load(u0);
    for (int u = u0; u < n_units; u += ustride) {
        const int row0 = (u >> 2) * 64; int s0, len;
        if (row0 < NL) { s0 = row0 & ~(SEQ - 1); len = SEQ; } else { s0 = NL + ((row0 - NL) & ~(CTX - 1)); len = CTX; }
        const int t0 = row0 - s0;
        __syncthreads();
#pragma unroll
        for (int i = 0; i < 3; ++i) { const int idx = F.tid + 512 * i, rr = idx >> 4, cc = idx & 15; if (idx < 1280) *(LAS u32x4*)(F.lds + PL_UT + rr * PL_STRIDE + cc * 16) = st[i]; }
        if (u + ustride < n_units) stage_load(u + ustride);
        __syncthreads();
        { const int r = F.tid >> 3, c16 = (F.tid & 7) * 16; const int t = t0 + r;
          int lo = t - w / 2, hi = t - w / 2 + w - 1; lo = lo < 0 ? 0 : lo; hi = hi > len - 1 ? len - 1 : hi;
          f32x4 sm[4];
#pragma unroll
          for (int j = 0; j < 4; ++j) sm[j] = (f32x4){0.f, 0.f, 0.f, 0.f};
#pragma unroll
          for (int i = 0; i < W; ++i) { const int tt = t - W / 2 + i; const bool ok = tt >= lo && tt <= hi; const int tc = tt < lo ? lo : (tt > hi ? hi : tt); const float wt = ok ? 1.0f : 0.0f;
              const LAS unsigned char* p = F.lds + PL_UT + (tc - t0 + 8) * PL_STRIDE + c16 * 2;
              const u32x4 w0 = *(const LAS u32x4*)p, w1 = *(const LAS u32x4*)(p + 16);
              sm[0] += (f32x4){bf_lo(w0.x), bf_hi(w0.x), bf_lo(w0.y), bf_hi(w0.y)} * wt; sm[1] += (f32x4){bf_lo(w0.z), bf_hi(w0.z), bf_lo(w0.w), bf_hi(w0.w)} * wt;
              sm[2] += (f32x4){bf_lo(w1.x), bf_hi(w1.x), bf_lo(w1.y), bf_hi(w1.y)} * wt; sm[3] += (f32x4){bf_lo(w1.z), bf_hi(w1.z), bf_lo(w1.w), bf_hi(w1.w)} * wt; }
          const float inv = 1.0f / (float)(hi - lo + 1);
          { const LAS unsigned char* p = F.lds + PL_UT + (r + 8) * PL_STRIDE + c16 * 2; const u32x4 w0 = *(const LAS u32x4*)p, w1 = *(const LAS u32x4*)(p + 16);
            sm[0] = sm[0] * inv - (f32x4){bf_lo(w0.x), bf_hi(w0.x), bf_lo(w0.y), bf_hi(w0.y)}; sm[1] = sm[1] * inv - (f32x4){bf_lo(w0.z), bf_hi(w0.z), bf_lo(w0.w), bf_hi(w0.w)};
            sm[2] = sm[2] * inv - (f32x4){bf_lo(w1.x), bf_hi(w1.x), bf_lo(w1.y), bf_hi(w1.y)}; sm[3] = sm[3] * inv - (f32x4){bf_lo(w1.z), bf_hi(w1.z), bf_lo(w1.w), bf_hi(w1.w)}; }
          u32x4 o0, o1; o0.x = cvt_pk_bf16(sm[0].x, sm[0].y); o0.y = cvt_pk_bf16(sm[0].z, sm[0].w); o0.z = cvt_pk_bf16(sm[1].x, sm[1].y); o0.w = cvt_pk_bf16(sm[1].z, sm[1].w);
          o1.x = cvt_pk_bf16(sm[2].x, sm[2].y); o1.y = cvt_pk_bf16(sm[2].z, sm[2].w); o1.z = cvt_pk_bf16(sm[3].x, sm[3].y); o1.w = cvt_pk_bf16(sm[3].z, sm[3].w);
          *(LAS u32x4*)(F.lds + PL_PT + r * PL_STRIDE + c16 * 2) = o0; *(LAS u32x4*)(F.lds + PL_PT + r * PL_STRIDE + c16 * 2 + 16) = o1; }
        __syncthreads();
        { f32x4 acc[4];
#pragma unroll
          for (int ct = 0; ct < 4; ++ct) acc[ct] = (f32x4){0.f, 0.f, 0.f, 0.f};
#pragma unroll
          for (int ks = 0; ks < 4; ++ks) {
              const bf16x8 pa = *(const LAS bf16x8*)(F.lds + PL_PT + (16 * rt4 + i16) * PL_STRIDE + (32 * ks + 8 * kq) * 2);
#pragma unroll
              for (int ct = 0; ct < 4; ++ct) acc[ct] = __builtin_amdgcn_mfma_f32_16x16x32_bf16(wb[ks][ct], pa, acc[ct], 0, 0, 0);
          }
          const int row = row0 + 16 * rt4 + i16; bf16* O = (bf16*)(F.ws + WS_PO) + (size_t)row * 1024 + g * 128;
#pragma unroll
          for (int ct = 0; ct < 4; ++ct) { const int d = 64 * ch + 16 * ct + 4 * kq;
              u32x2 wv; wv.x = cvt_pk_bf16(acc[ct].x * scv[ct].x, acc[ct].y * scv[ct].y); wv.y = cvt_pk_bf16(acc[ct].z * scv[ct].z, acc[ct].w * scv[ct].w); *(u32x2*)(O + d) = wv; }
        }
    }
}
template <class AT> __device__ __forceinline__ void attn_unit_v2(Frame& F, AT& a, int layer, int qrow0, int qpos0, int g, int lrow0, int jlo, int jhi, int crow0) {
    const bf16* Q = (const bf16*)(F.ws + WS_Q); const bf16* Kb = (const bf16*)(F.ws + WS_K); const bf16* Vb = (const bf16*)(F.ws + WS_V);
    const int lane = F.lane, r32 = lane & 31, hi = lane >> 5, w = F.wave, r = w >> 1, qh = w & 1, h = 4 * g + r;
    bf16x8 qf[4];
#pragma unroll
    for (int s = 0; s < 4; ++s) qf[s] = *(const bf16x8*)(Q + (size_t)(qrow0 + 32 * qh + r32) * 512 + h * 64 + 16 * s + 8 * hi);
    f32x16 O0, O1;
#pragma unroll
    for (int i = 0; i < 16; ++i) { O0[i] = 0.f; O1[i] = 0.f; }
    const float sink2 = a.in[I_SINK][layer * 8 + h] * LOG2E;
    float m = sink2, l = hi == 0 ? 1.0f : 0.0f;
    const int nloc = jhi >= jlo ? jhi - jlo + 1 : 0, NT = nloc + 4;
    const int skey = F.tid >> 3, sc8 = F.tid & 7;
    const int qa = qpos0 + 32 * qh;
    const unsigned lane_off = (unsigned)(skey * 128 + 8 * sc8) * 2u;
    const unsigned st_k = (unsigned)(skey * AK_STRIDE + sc8 * 16), st_v = (unsigned)(AK_BYTES + skey * AV_STRIDE + sc8 * 16);
    const unsigned kb0 = (unsigned)(r32 * AK_STRIDE + 16 * hi), vb0 = (unsigned)(AK_BYTES + (4 * hi + ((lane & 15) >> 2)) * AV_STRIDE + (16 * ((lane >> 4) & 1) + 4 * (lane & 3)) * 2);
#define A2_KROW(it_) (((it_) < nloc) ? lrow0 + 64 * (jlo + (it_)) : crow0 + 64 * ((it_) - nloc))
#define A2_GLOAD(kr_, vr_, it_) do { const int krow_ = A2_KROW(it_); kr_ = *(const u32x4*)((const char*)(Kb + (size_t)krow_ * 128 + g * 64) + lane_off); vr_ = *(const u32x4*)((const char*)(Vb + (size_t)krow_ * 128 + g * 64) + lane_off); } while (0)
#define A2_QK(S0_, S1_, bo_) do { unsigned kbase_ = (unsigned)(bo_) + kb0; asm volatile("" : "+v"(kbase_)); const LAS unsigned char* Kl_ = F.lds + kbase_; bf16x8 ka_[4], kb_[4]; \
        _Pragma("unroll") for (int i_ = 0; i_ < 16; ++i_) { S0_[i_] = 0.f; S1_[i_] = 0.f; } \
        _Pragma("unroll") for (int s_ = 0; s_ < 4; ++s_) ka_[s_] = *(const LAS bf16x8*)(Kl_ + 32 * s_); \
        _Pragma("unroll") for (int s_ = 0; s_ < 4; ++s_) asm volatile("" : "+v"(ka_[s_])); \
        _Pragma("unroll") for (int s_ = 0; s_ < 4; ++s_) kb_[s_] = *(const LAS bf16x8*)(Kl_ + 32 * AK_STRIDE + 32 * s_); \
        _Pragma("unroll") for (int s_ = 0; s_ < 4; ++s_) S0_ = __builtin_amdgcn_mfma_f32_32x32x16_bf16(ka_[s_], qf[s_], S0_, 0, 0, 0); \
        _Pragma("unroll") for (int s_ = 0; s_ < 4; ++s_) asm volatile("" : "+v"(kb_[s_])); \
        _Pragma("unroll") for (int s_ = 0; s_ < 4; ++s_) S1_ = __builtin_amdgcn_mfma_f32_32x32x16_bf16(kb_[s_], qf[s_], S1_, 0, 0, 0); } while (0)
    u32x4 kreg, vreg, kreg1, vreg1;
    A2_GLOAD(kreg, vreg, 0); A2_GLOAD(kreg1, vreg1, 1);
    __syncthreads();
    *(LAS u32x4*)(F.lds + st_k) = kreg; *(LAS u32x4*)(F.lds + st_v) = vreg;
    *(LAS u32x4*)(F.lds + ABUF_BYTES + st_k) = kreg1; *(LAS u32x4*)(F.lds + ABUF_BYTES + st_v) = vreg1;
    A2_GLOAD(kreg, vreg, 2);
    __syncthreads();
    f32x16 SA0, SA1, SB0, SB1;
    A2_QK(SA0, SA1, 0);
    int bcur = 0, bnx = ABUF_BYTES, bst = 2 * ABUF_BYTES;
#define A2_STEP(C0_, C1_, N0_, N1_, t_) do { \
        if ((t_) + 2 < NT) { *(LAS u32x4*)(F.lds + bst + st_k) = kreg; *(LAS u32x4*)(F.lds + bst + st_v) = vreg; }     \
        { const int nt3_ = (t_) + 3 < NT ? (t_) + 3 : NT - 1; A2_GLOAD(kreg, vreg, nt3_); }                             \
        __builtin_amdgcn_sched_barrier(0); \
        if ((t_) + 1 < NT) { A2_QK(N0_, N1_, bnx); } \
        __builtin_amdgcn_sched_barrier(0); \
        { const int ka_t = 64 * (jlo + (t_)); \
          if ((t_) < nloc && (ka_t + 63 - qa > 128 || qa + 31 - ka_t > 128)) { const int qp_ = qa + r32; \
              _Pragma("unroll") for (int i_ = 0; i_ < 16; ++i_) { const int kp_ = ka_t + (i_ & 3) + 8 * (i_ >> 2) + 4 * hi; const int d0_ = qp_ - kp_, d1_ = d0_ - 32; \
                  if (d0_ > 128 || d0_ < -128) C0_[i_] = -INFINITY; if (d1_ > 128 || d1_ < -128) C1_[i_] = -INFINITY; } } } \
        float ta_ = fmaxf(fmaxf(C0_[0], C0_[1]), C0_[2]), tb_ = fmaxf(fmaxf(C1_[0], C1_[1]), C1_[2]); \
        _Pragma("unroll") for (int i_ = 3; i_ < 15; i_ += 2) { ta_ = fmaxf(fmaxf(ta_, C0_[i_]), C0_[i_ + 1]); tb_ = fmaxf(fmaxf(tb_, C1_[i_]), C1_[i_ + 1]); } \
        float tmax_ = fmaxf(fmaxf(ta_, tb_), fmaxf(C0_[15], C1_[15])); \
        tmax_ = fmaxf(tmax_, __shfl_xor(tmax_, 32)); \
        if (__any(tmax_ > m + ATT_THR)) { const float mn_ = fmaxf(m, tmax_), al_ = __builtin_amdgcn_exp2f(m - mn_); l *= al_; m = mn_; \
            _Pragma("unroll") for (int i_ = 0; i_ < 16; ++i_) { O0[i_] *= al_; O1[i_] *= al_; } } \
        { const f32x2 nm2_ = {-m, -m}; f32x2 ls2_ = {0.f, 0.f}; \
          _Pragma("unroll") for (int i_ = 0; i_ < 16; i_ += 2) { f32x2 a0_ = (f32x2){C0_[i_], C0_[i_ + 1]} + nm2_, a1_ = (f32x2){C1_[i_], C1_[i_ + 1]} + nm2_; \
              a0_.x = __builtin_amdgcn_exp2f(a0_.x); a0_.y = __builtin_amdgcn_exp2f(a0_.y); a1_.x = __builtin_amdgcn_exp2f(a1_.x); a1_.y = __builtin_amdgcn_exp2f(a1_.y); \
              C0_[i_] = a0_.x; C0_[i_ + 1] = a0_.y; C1_[i_] = a1_.x; C1_[i_ + 1] = a1_.y; ls2_ += a0_; ls2_ += a1_; } \
          l += ls2_.x + ls2_.y; } \
        bf16x8 pf_[2][2]; \
        _Pragma("unroll") for (int s2_ = 0; s2_ < 2; ++s2_) { u32x4 p0_, p1_; \
            p0_.x = cvt_pk_bf16(C0_[8 * s2_ + 0], C0_[8 * s2_ + 1]); p0_.y = cvt_pk_bf16(C0_[8 * s2_ + 2], C0_[8 * s2_ + 3]); p0_.z = cvt_pk_bf16(C0_[8 * s2_ + 4], C0_[8 * s2_ + 5]); p0_.w = cvt_pk_bf16(C0_[8 * s2_ + 6], C0_[8 * s2_ + 7]); \
            p1_.x = cvt_pk_bf16(C1_[8 * s2_ + 0], C1_[8 * s2_ + 1]); p1_.y = cvt_pk_bf16(C1_[8 * s2_ + 2], C1_[8 * s2_ + 3]); p1_.z = cvt_pk_bf16(C1_[8 * s2_ + 4], C1_[8 * s2_ + 5]); p1_.w = cvt_pk_bf16(C1_[8 * s2_ + 6], C1_[8 * s2_ + 7]); \
            pf_[0][s2_] = __builtin_bit_cast(bf16x8, p0_); pf_[1][s2_] = __builtin_bit_cast(bf16x8, p1_); } \
        { unsigned vbase_ = (unsigned)bcur + vb0; asm volatile("" : "+v"(vbase_)); const LAS unsigned char* Vl_ = F.lds + vbase_; bf16x8 g0_[2], g1_[2], g2_[2], g3_[2]; \
          A2_VG(g0_, 0, 0); A2_VG(g1_, 0, 1); A2_PIN2(g0_); A2_PV(g0_, 0, 0); \
          A2_VG(g2_, 1, 0); A2_PIN2(g1_); A2_PV(g1_, 0, 1); \
          A2_VG(g3_, 1, 1); A2_PIN2(g2_); A2_PV(g2_, 1, 0); \
          A2_PIN2(g3_); A2_PV(g3_, 1, 1); } \
        __syncthreads(); \
        { const int tmp_ = bcur; bcur = bnx; bnx = bst; bst = tmp_; } } while (0)
#define A2_VG(dst, kt_, s2_) do { _Pragma("unroll") for (int dt_ = 0; dt_ < 2; ++dt_) { \
        const LAS unsigned char* vp_ = Vl_ + (32 * (kt_) + 16 * (s2_)) * AV_STRIDE + (32 * dt_) * 2; \
        const s16x4 lo_ = __builtin_bit_cast(s16x4, __builtin_amdgcn_ds_read_tr16_b64_v4i16((LAS v4i16_t*)vp_)); \
        const s16x4 hh_ = __builtin_bit_cast(s16x4, __builtin_amdgcn_ds_read_tr16_b64_v4i16((LAS v4i16_t*)(vp_ + 8 * AV_STRIDE))); \
        dst[dt_] = (bf16x8){lo_[0], lo_[1], lo_[2], lo_[3], hh_[0], hh_[1], hh_[2], hh_[3]}; } } while (0)
#define A2_PIN2(x) asm volatile("" : "+v"(x[0]), "+v"(x[1]))
#define A2_PV(x, kt_, s2_) do { O0 = __builtin_amdgcn_mfma_f32_32x32x16_bf16(x[0], pf_[kt_][s2_], O0, 0, 0, 0); O1 = __builtin_amdgcn_mfma_f32_32x32x16_bf16(x[1], pf_[kt_][s2_], O1, 0, 0, 0); } while (0)
#pragma unroll 1
    for (int t = 0; t < NT; t += 2) {
        A2_STEP(SA0, SA1, SB0, SB1, t);
        if (t + 1 < NT) A2_STEP(SB0, SB1, SA0, SA1, t + 1);
    }
#undef A2_KROW
#undef A2_GLOAD
#undef A2_QK
#undef A2_STEP
#undef A2_VG
#undef A2_PIN2
#undef A2_PV
    { const float lt = l + __shfl_xor(l, 32), il = 1.0f / lt;
      bf16* Op = (bf16*)(F.ws + WS_PO) + (size_t)(qrow0 + 32 * qh + r32) * 1024 + 512 + h * 64;
#pragma unroll
      for (int g4 = 0; g4 < 4; ++g4) { u32x2 wv; wv.x = cvt_pk_bf16(O0[4 * g4] * il, O0[4 * g4 + 1] * il); wv.y = cvt_pk_bf16(O0[4 * g4 + 2] * il, O0[4 * g4 + 3] * il); *(u32x2*)(Op + 8 * g4 + 4 * hi) = wv; }
#pragma unroll
      for (int g4 = 0; g4 < 4; ++g4) { u32x2 wv; wv.x = cvt_pk_bf16(O1[4 * g4] * il, O1[4 * g4 + 1] * il); wv.y = cvt_pk_bf16(O1[4 * g4 + 2] * il, O1[4 * g4 + 3] * il); *(u32x2*)(Op + 32 + 8 * g4 + 4 * hi) = wv; } }
}
constexpr int PW_BYTES = 12800, PW_PT = 8192;
template <int W, class AT> __device__ __forceinline__ void pool_wave(Frame& F, AT& a, int layer, int u0, int ustride, int n_units) {
    if (u0 >= n_units) return;
    const bf16* U = (const bf16*)(F.ws + WS_U);
    const int g = u0 & 3, ch = (u0 >> 2) & 1; constexpr int w = W;
    const int lane = F.lane, i16 = lane & 15, kq = lane >> 4;
    LAS unsigned char* UT = F.lds + F.wave * PW_BYTES; LAS unsigned char* PT = UT + PW_PT;
    const bf16* Wt = (const bf16*)(F.ws + WS_WPG) + (size_t)(layer * 4 + g) * 128 * 128;
    bf16x8 wb[4][4];
#pragma unroll
    for (int ks = 0; ks < 4; ++ks)
#pragma unroll
        for (int ct = 0; ct < 4; ++ct) wb[ks][ct] = *(const bf16x8*)(Wt + (size_t)(64 * ch + 16 * ct + i16) * 128 + 32 * ks + 8 * kq);
    f32x4 scv[4];
#pragma unroll
    for (int ct = 0; ct < 4; ++ct) scv[ct] = *(const f32x4*)(a.in[I_PSCALE] + layer * 512 + g * 128 + 64 * ch + 16 * ct + 4 * kq);
    u32x4 st[8];
    auto stage_load = [&](int u) {
        const int row0 = (u >> 3) * 16; int s0, len;
        if (row0 < NL) { s0 = row0 & ~(SEQ - 1); len = SEQ; } else { s0 = NL + ((row0 - NL) & ~(CTX - 1)); len = CTX; }
        const int t0 = row0 - s0;
#pragma unroll
        for (int i = 0; i < 8; ++i) { const int idx = lane + 64 * i, rr = idx >> 4, cc = idx & 15; const int t = t0 - 8 + rr;
            st[i] = (u32x4){0u, 0u, 0u, 0u};
            if (t >= 0 && t < len) st[i] = *(const u32x4*)(U + (size_t)(s0 + t) * 512 + g * 128 + 8 * cc); }
    };
    stage_load(u0);
    for (int u = u0; u < n_units; u += ustride) {
        const int row0 = (u >> 3) * 16; int s0, len;
        if (row0 < NL) { s0 = row0 & ~(SEQ - 1); len = SEQ; } else { s0 = NL + ((row0 - NL) & ~(CTX - 1)); len = CTX; }
        const int t0 = row0 - s0;
#pragma unroll
        for (int i = 0; i < 8; ++i) { const int idx = lane + 64 * i; *(LAS u32x4*)(UT + (idx >> 4) * 256 + (idx & 15) * 16) = st[i]; }
        if (u + ustride < n_units) stage_load(u + ustride);
        __builtin_amdgcn_sched_barrier(0);
        LDS_WAIT();
        { const LAS unsigned char* up = UT + 4 * lane;
          unsigned uv[32];
#pragma unroll
          for (int r = 0; r < 32; ++r) uv[r] = *(const LAS unsigned*)(up + r * 256);
          float sa = 0.f, sb = 0.f;
#pragma unroll
          for (int i = 0; i < W; ++i) { sa += bf_lo(uv[8 - W / 2 + i]); sb += bf_hi(uv[8 - W / 2 + i]); }
#pragma unroll
          for (int r = 0; r < 16; ++r) {
              if (r > 0) { sa += bf_lo(uv[8 - W / 2 + W - 1 + r]) - bf_lo(uv[8 - W / 2 + r - 1]); sb += bf_hi(uv[8 - W / 2 + W - 1 + r]) - bf_hi(uv[8 - W / 2 + r - 1]); }
              const int t = t0 + r; int lo = t - W / 2, hi = t - W / 2 + W - 1; lo = lo < 0 ? 0 : lo; hi = hi > len - 1 ? len - 1 : hi;
              const float inv = 1.0f / (float)(hi - lo + 1);
              *(LAS unsigned*)(PT + r * PL_STRIDE + 4 * lane) = cvt_pk_bf16(sa * inv - bf_lo(uv[r + 8]), sb * inv - bf_hi(uv[r + 8]));
          } }
        LDS_WAIT(); asm volatile("" ::: "memory");
        { f32x4 acc[4];
#pragma unroll
          for (int ct = 0; ct < 4; ++ct) acc[ct] = (f32x4){0.f, 0.f, 0.f, 0.f};
          bf16x8 pa[4];
#pragma unroll
          for (int ks = 0; ks < 4; ++ks) pa[ks] = *(const LAS bf16x8*)(PT + i16 * PL_STRIDE + (32 * ks + 8 * kq) * 2);
#pragma unroll
          for (int ks = 0; ks < 4; ++ks)
#pragma unroll
              for (int ct = 0; ct < 4; ++ct) acc[ct] = __builtin_amdgcn_mfma_f32_16x16x32_bf16(wb[ks][ct], pa[ks], acc[ct], 0, 0, 0);
          const int row = row0 + i16; bf16* O = (bf16*)(F.ws + WS_PO) + (size_t)row * 1024 + g * 128;
#pragma unroll
          for (int ct = 0; ct < 4; ++ct) { const int d = 64 * ch + 16 * ct + 4 * kq;
              u32x2 wv; wv.x = cvt_pk_bf16(acc[ct].x * scv[ct].x, acc[ct].y * scv[ct].y); wv.y = cvt_pk_bf16(acc[ct].z * scv[ct].z, acc[ct].w * scv[ct].w); *(u32x2*)(O + d) = wv; }
        }
        LDS_WAIT(); asm volatile("" ::: "memory");
    }
}
#ifndef MIX_SIMPLE
#define MIX_SIMPLE 0
#endif
template <class AT> __device__ __forceinline__ void phase_mix(Frame& F, AT& a, int layer) {
#ifndef MIX_DUP
#define MIX_DUP 0
#endif
#ifndef ATT_V2
#define ATT_V2 1
#endif
#if ATT_V2
    { const int n_lat = 1024, n_ctx = layer == 0 ? 16 : 0;
      for (int rep = 0; rep < ((MIX_DUP & 1) ? 2 : 1); ++rep)
      for (int u = F.vcu; u < n_lat + n_ctx; u += F.G) {
          if (u < n_lat) { const int b = u >> 9, mm = (u & 511) >> 1, g = u & 1;
              int jlo = mm - 2, jhi = mm + 2; jlo = jlo < 0 ? 0 : jlo; jhi = jhi > 255 ? 255 : jhi;
              attn_unit_v2(F, a, layer, b * SEQ + 64 * mm, 64 * mm, g, b * SEQ, jlo, jhi, NL + b * CTX);
          } else { const int v = u - n_lat, b = v >> 3, g = (v >> 2) & 1, cb = v & 3;
              attn_unit_v2(F, a, layer, NL + b * CTX + 64 * cb, 0, g, 0, 0, -1, NL + b * CTX); }
      } }
#else
    const int n_lat = 512, n_ctx = layer == 0 ? 8 : 0;
    for (int rep = 0; rep < ((MIX_DUP & 1) ? 2 : 1); ++rep)
    for (int u = F.vcu; u < n_lat + n_ctx; u += F.G) {
        if (u < n_lat) { const int b = u >> 8, n = (u & 255) >> 1, g = u & 1;
            int jlo = 2 * n - 2, jhi = 2 * n + 3; jlo = jlo < 0 ? 0 : jlo; jhi = jhi > 255 ? 255 : jhi;
            if (MIX_SIMPLE & 1) attn_unit_simple(F, a, layer, b * SEQ + 128 * n, 128 * n, g, b * SEQ, jlo, jhi, NL + b * CTX);
            else attn_unit_mfma(F, a, layer, b * SEQ + 128 * n, 128 * n, g, b * SEQ, jlo, jhi, NL + b * CTX);
        } else { const int v = u - n_lat, b = v >> 2, g = (v >> 1) & 1, cb = v & 1;
            if (MIX_SIMPLE & 1) attn_unit_simple(F, a, layer, NL + b * CTX + 128 * cb, 0, g, 0, 0, -1, NL + b * CTX);
            else attn_unit_mfma(F, a, layer, NL + b * CTX + 128 * cb, 0, g, 0, 0, -1, NL + b * CTX); }
    }
#endif
    const int n_rt = (layer == 0 ? MT : NL) / 64;
    const int skip = (layer == 0 && F.G > 32) ? (ATT_V2 ? 16 : 8) : 0;
    if (F.vcu >= skip)
    for (int rep = 0; rep < ((MIX_DUP & 2) ? 2 : 1); ++rep) {
        if (MIX_SIMPLE & 2) { for (int u = F.vcu - skip; u < n_rt * 4; u += F.G - skip) pool_unit(F, a, layer, u >> 2, u & 3); }
        else { __syncthreads();
            const int u0 = (F.vcu - skip) * 8 + F.wave, us = (F.G - skip) * 8, nu = n_rt * 4 * 8;
            switch (F.wave & 3) { case 0: pool_wave<2>(F, a, layer, u0, us, nu); break; case 1: pool_wave<4>(F, a, layer, u0, us, nu); break;
                                  case 2: pool_wave<8>(F, a, layer, u0, us, nu); break; default: pool_wave<16>(F, a, layer, u0, us, nu); break; } }
    }
    __syncthreads();
}

__device__ __forceinline__ float top2sum(float a, float b, float c, float d) {
    const float h1 = fmaxf(a, b), l1 = fminf(a, b), h2 = fmaxf(c, d), l2 = fminf(c, d);
    return fmaxf(h1, h2) + fmaxf(fminf(h1, h2), fmaxf(l1, l2));
}
template <class AT> __device__ __forceinline__ void phase_ln1_route(Frame& F, AT& a, int layer, bool dry = false) {
    LAS float* WT = (LAS float*)F.lds;
    LAS int* lcnt = (LAS int*)(F.lds + MISC_OFF + L_LCNT); LAS int* lbase = (LAS int*)(F.lds + MISC_OFF + L_BASE);
    LAS unsigned* rinfo = (LAS unsigned*)(F.lds + MISC_OFF + L_ROW);
    const int rows_total = layer == 0 ? MT : NL; const int chunk = (rows_total + F.G - 1) / F.G;
    const int row_lo = F.vcu * chunk; int row_hi = row_lo + chunk; row_hi = row_hi > rows_total ? rows_total : row_hi;
    __syncthreads();
    { const f32x4* src = (const f32x4*)(F.ws + WS_WRT); f32x4 tv[16];
#pragma unroll
      for (int i = 0; i < 16; ++i) tv[i] = src[F.tid + 512 * i];
#pragma unroll
      for (int i = 0; i < 16; ++i) *(LAS f32x4*)(WT + 4 * (F.tid + 512 * i)) = tv[i]; }
    if (F.tid < 32) lcnt[F.tid] = 0;
    __syncthreads();
    const bf16* Yb = (const bf16*)(F.ws + WS_E);
    const int e_mine = 16 * (F.lane & 1) + 8 * ((F.lane >> 1) & 1) + 4 * ((F.lane >> 2) & 1) + 2 * ((F.lane >> 3) & 1) + ((F.lane >> 4) & 1);
    const float bias_mine = a.in[I_RB][e_mine];
    const int src_canon = e_mine | (F.lane & 32);
    f32x4 pg1[4], pb1[4], pga[4], psh[4], psc[4]; int cvec = -1;
    load_vec(a.in[I_LN1G] + layer * D, F.lane, pg1); load_vec(a.in[I_LN1B] + layer * D, F.lane, pb1);
    f32x4 nv[4]; u32x2 ny[4];
#define XROW(r_) (layer == 0 ? ((r_) < NL ? a.in[I_X] + (size_t)(r_) * D : a.in[I_CTX] + (size_t)((r_) - NL) * D) : (const float*)(F.ws + WS_C) + (size_t)(r_) * D)
    if (row_lo + F.wave < row_hi) { const int r0 = row_lo + F.wave; load_row(XROW(r0), F.lane, nv);
#pragma unroll
        for (int j = 0; j < 4; ++j) ny[j] = *(const u32x2*)(Yb + (size_t)r0 * D + 256 * j + 4 * F.lane); }
    for (int row = row_lo + F.wave; row < row_hi; ) {
      { const int vec = row_vec(row); cvec = vec; load_ada(ada_vec(F, layer, vec, 2), F.lane, pga); load_ada(ada_vec(F, layer, vec, 3), F.lane, psh); load_ada(ada_vec(F, layer, vec, 4), F.lane, psc);
        pin_vec(pga); pin_vec(psh); pin_vec(psc); pin_vec(pg1); pin_vec(pb1); }
      int seg_hi = cvec == 0 ? SEQ : (cvec == 1 ? NL : MT); seg_hi = seg_hi < row_hi ? seg_hi : row_hi;
      for (; row < seg_hi; row += 8) {
        f32x4 v[4]; u32x2 yv[4];
#pragma unroll
        for (int j = 0; j < 4; ++j) { v[j] = nv[j]; yv[j] = ny[j]; }
        if (row + 8 < row_hi) { const int r1 = row + 8; load_row(XROW(r1), F.lane, nv);
#pragma unroll
            for (int j = 0; j < 4; ++j) ny[j] = *(const u32x2*)(Yb + (size_t)r1 * D + 256 * j + 4 * F.lane); }
        __builtin_amdgcn_sched_barrier(0);
#pragma unroll
        for (int j = 0; j < 4; ++j) { const f32x4 yy = {bf_lo(yv[j].x), bf_hi(yv[j].x), bf_lo(yv[j].y), bf_hi(yv[j].y)}; v[j] = v[j] * ALPHA + pga[j] * yy; }
        float mean, rstd; ln_stats(v, mean, rstd);
#pragma unroll
        for (int j = 0; j < 4; ++j) v[j] = (v[j] - mean) * rstd * pg1[j] + pb1[j];
        float* x1 = row < NL ? a.out + (size_t)row * D : (float*)(F.ws + WS_X1C) + (size_t)(row - NL) * D;
        store_row(x1, F.lane, v);
        ln_stats(v, mean, rstd);
        f32x4 h[4];
#pragma unroll
        for (int j = 0; j < 4; ++j) h[j] = (v[j] - mean) * rstd * (psc[j] + 1.0f) + psh[j];
        store_row_bf16((bf16*)(F.ws + WS_E) + (size_t)row * D, F.lane, h);
        float lg[32];
        {
            f32x4 wA[4], wB[4];
#define RT_LOAD(dst, e_) do { _Pragma("unroll") for (int j = 0; j < 4; ++j) dst[j] = *(const LAS f32x4*)(WT + (e_) * D + 256 * j + 4 * F.lane); } while (0)
#define RT_MUL(src, e_) do { f32x2 sa = {0.f, 0.f}; _Pragma("unroll") for (int j = 0; j < 4; ++j) { \
                sa = __builtin_elementwise_fma((f32x2){h[j].x, h[j].y}, (f32x2){src[j].x, src[j].y}, sa); sa = __builtin_elementwise_fma((f32x2){h[j].z, h[j].w}, (f32x2){src[j].z, src[j].w}, sa); } \
                lg[(e_)] = sa.x + sa.y; } while (0)
            RT_LOAD(wA, 0);
#pragma unroll
            for (int e2 = 0; e2 < 32; e2 += 2) {
                RT_LOAD(wB, e2 + 1); __builtin_amdgcn_sched_barrier(0); RT_MUL(wA, e2); __builtin_amdgcn_sched_barrier(0);
                if (e2 + 2 < 32) { RT_LOAD(wA, e2 + 2); } __builtin_amdgcn_sched_barrier(0); RT_MUL(wB, e2 + 1); __builtin_amdgcn_sched_barrier(0);
            }
#undef RT_LOAD
#undef RT_MUL
        }
#pragma unroll
        for (int k = 0; k < 16; ++k) { const bool up = (F.lane & 1) != 0; const float send = up ? lg[k] : lg[k + 16], keep = up ? lg[k + 16] : lg[k]; lg[k] = keep + dppf<0xB1>(send); }
#pragma unroll
        for (int k = 0; k < 8; ++k) { const bool up = (F.lane & 2) != 0; const float send = up ? lg[k] : lg[k + 8], keep = up ? lg[k + 8] : lg[k]; lg[k] = keep + dppf<0x4E>(send); }
#pragma unroll
        for (int k = 0; k < 4; ++k) { const bool up = (F.lane & 4) != 0; const float send = up ? lg[k] : lg[k + 4], keep = up ? lg[k + 4] : lg[k]; lg[k] = keep + xor4f(send); }
#pragma unroll
        for (int k = 0; k < 2; ++k) { const bool up = (F.lane & 8) != 0; const float send = up ? lg[k] : lg[k + 2], keep = up ? lg[k + 2] : lg[k]; lg[k] = keep + dppf<0x128>(send); }
        { const bool up = (F.lane & 16) != 0; const float send = up ? lg[0] : lg[1], keep = up ? lg[1] : lg[0]; lg[0] = keep + __shfl_xor(send, 16); }
        const float logit = lg[0] + __shfl_xor(lg[0], 32);
        const float score_m = 1.0f / (1.0f + expf(-logit)); const float biased_m = score_m + bias_mine;
        const float score = __shfl(score_m, src_canon), biased = __shfl(biased_m, src_canon);
        const float ba = dppf<0x00>(biased), bb = dppf<0x55>(biased), bc = dppf<0xAA>(biased), bd = dppf<0xFF>(biased);
        float gs = top2sum(ba, bb, bc, bd); int gi = (F.lane & 31) >> 2;
        { const float os = xor4f(gs); const int oi = xor4i(gi); if (os > gs || (os == gs && oi < gi)) { gs = os; gi = oi; } }
        { const float os = dppf<0x128>(gs); const int oi = dppi<0x128>(gi); if (os > gs || (os == gs && oi < gi)) { gs = os; gi = oi; } }
        { const float os = __shfl_xor(gs, 16); const int oi = __shfl_xor(gi, 16); if (os > gs || (os == gs && oi < gi)) { gs = os; gi = oi; } }
        gi = __builtin_amdgcn_readfirstlane(gi);
        float bv[4], sv[4];
#pragma unroll
        for (int k = 0; k < 4; ++k) { bv[k] = __builtin_bit_cast(float, __builtin_amdgcn_readlane(__builtin_bit_cast(int, biased), gi * 4 + k)); sv[k] = __builtin_bit_cast(float, __builtin_amdgcn_readlane(__builtin_bit_cast(int, score), gi * 4 + k)); }
        int i0 = 0; float bb0 = bv[0];
#pragma unroll
        for (int k = 1; k < 4; ++k) if (bv[k] > bb0) { bb0 = bv[k]; i0 = k; }
        int i1 = -1; float bb1 = -INFINITY;
#pragma unroll
        for (int k = 0; k < 4; ++k) if (k != i0 && (i1 < 0 || bv[k] > bb1)) { bb1 = bv[k]; i1 = k; }
        float s0 = 0.f, s1 = 0.f;
#pragma unroll
        for (int k = 0; k < 4; ++k) { s0 = (k == i0) ? sv[k] : s0; s1 = (k == i1) ? sv[k] : s1; }
        const float wsum = s0 + s1;
        if (F.lane == 0) { const int e0 = gi * 4 + i0, e1 = gi * 4 + i1; const int lr = row - row_lo;
            const int p0 = __hip_atomic_fetch_add(&lcnt[e0], 1, __ATOMIC_RELAXED, __HIP_MEMORY_SCOPE_WORKGROUP), p1 = __hip_atomic_fetch_add(&lcnt[e1], 1, __ATOMIC_RELAXED, __HIP_MEMORY_SCOPE_WORKGROUP);
            rinfo[lr * 4 + 0] = (unsigned)e0 | ((unsigned)e1 << 8) | ((unsigned)p0 << 16); rinfo[lr * 4 + 1] = (unsigned)p1;
            rinfo[lr * 4 + 2] = __float_as_uint(s0 / wsum); rinfo[lr * 4 + 3] = __float_as_uint(s1 / wsum); }
      }
    }
    __syncthreads();
    if (dry) return;
    if (F.tid < 32) lbase[F.tid] = (int)__hip_atomic_fetch_add(F.ctl + CW_CNT + 64 * layer + F.tid, (unsigned)lcnt[F.tid], RLX_AGENT);
    __syncthreads();
    int* list = (int*)(F.ws + WS_LIST); unsigned* tok = (unsigned*)(F.ws + WS_TOK);
    for (int lr = F.tid; lr < row_hi - row_lo; lr += 512) {
        const unsigned w0 = rinfo[lr * 4 + 0], w1 = rinfo[lr * 4 + 1]; const int e0 = w0 & 255, e1 = (w0 >> 8) & 255;
        const int p0 = lbase[e0] + (int)(w0 >> 16), p1 = lbase[e1] + (int)w1; const int row = row_lo + lr;
        list[(size_t)e0 * LCAP + p0] = row; list[(size_t)e1 * LCAP + p1] = row;
        u32x4 o; o.x = (unsigned)e0 | ((unsigned)e1 << 8); o.y = (unsigned)p0; o.z = (unsigned)p1; o.w = rinfo[lr * 4 + 2];
        *(u32x4*)(tok + (size_t)row * 8) = o; tok[(size_t)row * 8 + 4] = rinfo[lr * 4 + 3];
    }
    __syncthreads();
}
__device__ __forceinline__ void moe_tables(Frame& F, int layer) {
    LAS int* blk = (LAS int*)(F.lds + MISC_OFF + L_BLK); LAS int* cnt = (LAS int*)(F.lds + MISC_OFF + L_CNT);
    __syncthreads();
    if (F.tid < 32) cnt[F.tid] = (int)__hip_atomic_load(F.ctl + CW_CNT + 64 * layer + F.tid, RLX_AGENT);
    __syncthreads();
    if (F.tid == 0) { int s = 0; for (int e = 0; e < 32; ++e) { blk[e] = s; s += (cnt[e] + 255) >> 8; } blk[32] = s; }
    __syncthreads();
}
template <class AT> __device__ __forceinline__ void phase_ln2(Frame& F, AT& a, int layer) {
    moe_tables(F, layer);
    const LAS int* blk = (const LAS int*)(F.lds + MISC_OFF + L_BLK);
    const int gw = F.vcu * 8 + F.wave, NGW = F.G * 8; const int rows_total = layer == 0 ? MT : NL;
    const bf16* YB = (const bf16*)(F.ws + WS_B); const unsigned* tok = (const unsigned*)(F.ws + WS_TOK);
    const float* g2g = a.in[I_LN2G] + layer * D; const float* g2b = a.in[I_LN2B] + layer * D;
    f32x4 pg2[4], pl2g[4], pl2b[4], qsh[4], qsc[4]; int cvec = -1;
    load_vec(g2g, F.lane, pl2g); load_vec(g2b, F.lane, pl2b);
    u32x4 tiA = {0u, 0u, 0u, 0u}, tiB = tiA; unsigned twA = 0u, twB = 0u;
    f32x4 nv[4]; u32x2 nya[4], nyb[4]; float nw0 = 0.f, nw1 = 0.f;
    int row = gw;
    if (row < rows_total) { tiB = *(const u32x4*)(tok + (size_t)row * 8); twB = tok[(size_t)row * 8 + 4]; }
    if (row + NGW < rows_total) { tiA = *(const u32x4*)(tok + (size_t)(row + NGW) * 8); twA = tok[(size_t)(row + NGW) * 8 + 4]; }
    if (row < rows_total) {
        const int e0 = tiB.x & 255, e1 = (tiB.x >> 8) & 255; const size_t r0 = (size_t)blk[e0] * 256 + tiB.y, r1 = (size_t)blk[e1] * 256 + tiB.z;
        load_row(row < NL ? a.out + (size_t)row * D : (const float*)(F.ws + WS_X1C) + (size_t)(row - NL) * D, F.lane, nv);
#pragma unroll
        for (int j = 0; j < 4; ++j) { nya[j] = *(const u32x2*)(YB + r0 * D + 256 * j + 4 * F.lane); nyb[j] = *(const u32x2*)(YB + r1 * D + 256 * j + 4 * F.lane); }
        nw0 = __uint_as_float(tiB.w); nw1 = __uint_as_float(twB);
    }
    while (row < rows_total) {
      { const int vec = row_vec(row); cvec = vec; load_ada(ada_vec(F, layer, vec, 5), F.lane, pg2); load_ada(ada_vec(F, 1, vec, 0), F.lane, qsh); load_ada(ada_vec(F, 1, vec, 1), F.lane, qsc);
        pin_vec(pg2); pin_vec(qsh); pin_vec(qsc); pin_vec(pl2g); pin_vec(pl2b); }
      int seg_hi = cvec == 0 ? SEQ : (cvec == 1 ? NL : MT); seg_hi = seg_hi < rows_total ? seg_hi : rows_total;
      while (row < seg_hi) {
        f32x4 v[4]; u32x2 ya[4], yb[4]; const float w0 = nw0, w1 = nw1;
#pragma unroll
        for (int j = 0; j < 4; ++j) { v[j] = nv[j]; ya[j] = nya[j]; yb[j] = nyb[j]; }
        const int nrow = row + NGW;
        u32x4 tiN; unsigned twN;
        { const int pr = nrow < rows_total ? nrow : rows_total - 1;
          const int e0 = tiA.x & 255, e1 = (tiA.x >> 8) & 255; const size_t r0 = (size_t)blk[e0] * 256 + tiA.y, r1 = (size_t)blk[e1] * 256 + tiA.z;
          load_row(pr < NL ? a.out + (size_t)pr * D : (const float*)(F.ws + WS_X1C) + (size_t)(pr - NL) * D, F.lane, nv);
#pragma unroll
          for (int j = 0; j < 4; ++j) { nya[j] = *(const u32x2*)(YB + r0 * D + 256 * j + 4 * F.lane); nyb[j] = *(const u32x2*)(YB + r1 * D + 256 * j + 4 * F.lane); }
          nw0 = __uint_as_float(tiA.w); nw1 = __uint_as_float(twA);
          const int r2 = (nrow + NGW < rows_total) ? nrow + NGW : rows_total - 1;
          tiN = *(const u32x4*)(tok + (size_t)r2 * 8); twN = tok[(size_t)r2 * 8 + 4]; }
        __builtin_amdgcn_sched_barrier(0);
#pragma unroll
        for (int j = 0; j < 4; ++j) {
            const f32x4 fa = {bf_lo(ya[j].x), bf_hi(ya[j].x), bf_lo(ya[j].y), bf_hi(ya[j].y)}, fb = {bf_lo(yb[j].x), bf_hi(yb[j].x), bf_lo(yb[j].y), bf_hi(yb[j].y)};
            v[j] = v[j] * ALPHA + pg2[j] * (fa * w0 + fb * w1); }
        float mean, rstd; ln_stats(v, mean, rstd);
#pragma unroll
        for (int j = 0; j < 4; ++j) v[j] = (v[j] - mean) * rstd * pl2g[j] + pl2b[j];
        if (layer == 0) { store_row((float*)(F.ws + WS_C) + (size_t)row * D, F.lane, v);
            ln_stats(v, mean, rstd); f32x4 hh[4];
#pragma unroll
            for (int j = 0; j < 4; ++j) hh[j] = (v[j] - mean) * rstd * (qsc[j] + 1.0f) + qsh[j];
            store_row_bf16((bf16*)(F.ws + WS_H) + (size_t)row * D, F.lane, hh); }
        else store_row(a.out + (size_t)row * D, F.lane, v);
        row = nrow; tiA = tiN; twA = twN;
      }
    }
}

constexpr int N_PHASES = 18;
typedef const __attribute__((address_space(4))) Args CArgs;
__device__ __forceinline__ CArgs& kargs() { CArgs* p = (CArgs*)__builtin_amdgcn_kernarg_segment_ptr(); asm volatile("" : "+s"(p)); return *p; }
#define args (kargs())
__global__ void __launch_bounds__(512, 2) fwd_kernel(Args args_unused) {
    extern __shared__ __attribute__((aligned(16))) unsigned char lds_raw[];
    Frame F;
    F.lds = (LAS unsigned char*)lds_raw; F.ws = args.ws; F.ctl = (unsigned*)(args.ws + WS_CTL);
    F.tid = threadIdx.x; F.lane = F.tid & 63; F.wave = __builtin_amdgcn_readfirstlane(F.tid >> 6);
    F.G = gridDim.x; { const int bx = blockIdx.x; F.vcu = (F.G % 8 == 0) ? (bx % 8) * (F.G / 8) + bx / 8 : bx; }
    for (int u = F.tid; u < (LDS_BYTES - MISC_OFF) / 4; u += 512) ((LAS unsigned*)(F.lds + MISC_OFF))[u] = 0u;
    __syncthreads();
    const int lo = args.ph_lo; int hi = args.ph_hi; const bool dry = hi > 100; if (dry) hi -= 100;
    XcdBarrier bar; bar.bar = F.ctl + CW_BAR; bar.x = 0; bar.st = nullptr;
    if (hi - lo > 1) bar = xcd_barrier_post(F.ctl + CW_BAR, (volatile LAS unsigned*)(F.lds + MISC_OFF + L_BARW));
#ifndef PH_MASK
#define PH_MASK 0xFFFFFFFFu
#endif
#define IN(k) (lo <= (k) && (k) < hi)
#define EN(b) ((PH_MASK >> (b)) & 1u)
#define FRESH() do { asm volatile("" : "+v"(F.tid)); F.lane = F.tid & 63; } while (0)
    const bool fused = (hi - lo) > 1;
#ifndef FILL_MASK
#define FILL_MASK 0u
#endif
#ifndef BG_DRAIN
#define BG_DRAIN 2
#endif
    constexpr int CONV_B1 = 130 * 13, CONV_B2 = CONV_B1 + 2 * 512, CONV_B3 = CONV_B2 + 2 * 512, CONV_B4 = CONV_B3 + 128 * 13;
    static_assert(CONV_B1 % 2 == 0 && CONV_B4 % 2 == 0 && CONV_B3 >= 3072 && CONV_B4 >= 5120 && CONV_B4 + 2 * 512 >= pg8::CONV_HALVES, "every expert matrix is converted before the phase that reads it");
#define SEAMX(k, fillbit, lim) do { if (IN(k) && IN((k) + 1)) { if (BG_DRAIN == 1 && fused && (((FILL_MASK >> (fillbit)) & 1u) || (lim) > 0)) { FRESH(); seam_fill(F, args, (k), (lim)); } xcd_barrier(bar); } } while (0)
#define SEAM(k) do { if (IN(k) && IN((k) + 1)) xcd_barrier(bar); } while (0)
    if (EN(0) && IN(0)) { FRESH(); phase_pre(F, args, BG_DRAIN == 2 ? !fused : (!fused || !BG_DRAIN)); } SEAM(0);
    if (EN(1) && IN(1)) { FRESH(); phase_h0(F, args); } SEAMX(1, 1, 0);
    for (int l = 0; l < 2; ++l) {
        const int pb = 2 + 8 * l;
        const int nMall = l == 0 ? 130 : 128;
        if (EN(2) && IN(pb + 0)) {
            InProjOrder S; S.init(F.ws + WS_H, F.ws + WS_WIN + (size_t)l * IN_COLS * D * 2, D, nMall, 13, F.G, (int)blockIdx.x);
            if (l == 1) { S.exN = 2; S.exPm0 = 128; S.exPn = 4; }
            EpiInProj E{(bf16*)(F.ws + WS_U), (bf16*)(F.ws + WS_Q), (bf16*)(F.ws + WS_K), (bf16*)(F.ws + WS_V), (bf16*)(F.ws + WS_GATE), (const float*)(F.ws + WS_ROPE)};
#if BG_DRAIN == 2
            const pg8::ConvW<1> CV{(const __attribute__((address_space(4))) char*)&args.in[I_WEG], F.ws, l == 0 ? 0 : CONV_B3, pg8::CONV_HALVES, F.G, (int)blockIdx.x};
            pg8::gemm_phase<EpiInProj, InProjOrder, true, pg8::ConvW<1>>(F.lds, D, S, E, CV);
#else
            pg8::gemm_phase<EpiInProj, InProjOrder, true>(F.lds, D, S, E);
#endif
        } SEAMX(pb + 0, 2, 0);
        if (EN(3) && IN(pb + 1)) { FRESH(); phase_mix(F, args, l); } SEAMX(pb + 1, 3, 0);
        if (EN(4) && IN(pb + 2)) {
            if (l == 0) { FRESH(); ctx_gemm<0>(F, (const bf16*)(F.ws + WS_PO), (const bf16*)(F.ws + WS_WPB), (const bf16*)(F.ws + WS_GATE), (bf16*)(F.ws + WS_F)); }
            PlainOrder S; S.init(F.ws + WS_PO, F.ws + WS_WPB + (size_t)l * D * D * 2, D, 128, 4, F.G, (int)blockIdx.x);
            EpiMergeOne E{(const bf16*)(F.ws + WS_GATE), (bf16*)(F.ws + WS_F)};
#if BG_DRAIN == 2
            { const pg8::ConvW<2> CV{(const __attribute__((address_space(4))) char*)&args.in[I_WEG], F.ws, l == 0 ? CONV_B1 : CONV_B4, pg8::CONV_HALVES, F.G, (int)blockIdx.x};
                pg8::gemm_phase<EpiMergeOne, PlainOrder, true, pg8::ConvW<2>>(F.lds, D, S, E, CV); }
#else
            pg8::gemm_phase<EpiMergeOne, PlainOrder, true>(F.lds, D, S, E);
#endif
        } SEAMX(pb + 2, 4, 0);
        if (EN(5) && IN(pb + 3)) {
            if (l == 0) { FRESH(); ctx_gemm<1>(F, (const bf16*)(F.ws + WS_F), (const bf16*)(F.ws + WS_WO), nullptr, (bf16*)(F.ws + WS_E)); }
            PlainOrder S; S.init(F.ws + WS_F, F.ws + WS_WO + (size_t)l * D * D * 2, D, 128, 4, F.G, (int)blockIdx.x);
            EpiPlainBf16 E{(bf16*)(F.ws + WS_E)};
#if BG_DRAIN == 2
            if (l == 0) { const pg8::ConvW<2> CV{(const __attribute__((address_space(4))) char*)&args.in[I_WEG], F.ws, CONV_B2, pg8::CONV_HALVES, F.G, (int)blockIdx.x};
                pg8::gemm_phase<EpiPlainBf16, PlainOrder, true, pg8::ConvW<2>>(F.lds, D, S, E, CV); }
            else
#endif
            pg8::gemm_phase<EpiPlainBf16, PlainOrder, true>(F.lds, D, S, E);
        } SEAMX(pb + 3, 5, 0);
        if (EN(6) && IN(pb + 4)) { FRESH(); phase_ln1_route(F, args, l, dry); } SEAMX(pb + 4, 6, l * BG_PER_LAYER + 16384);
        if (EN(7) && IN(pb + 5)) {
            FRESH(); moe_tables(F, l);
            MoeOrder<true> S{(const char*)(F.ws + WS_E), (const char*)(F.ws + WS_WEG + (size_t)l * 32 * D * D * 2), (const char*)(F.ws + WS_WEU + (size_t)l * 32 * D * D * 2), 8, F.G, F.vcu,
                             (const LAS int*)(F.lds + MISC_OFF + L_BLK), (const LAS int*)(F.lds + MISC_OFF + L_CNT), (const int*)(F.ws + WS_LIST)};
            EpiGateUp E{(bf16*)(F.ws + WS_A)};
            pg8::gemm_phase<EpiGateUp, MoeOrder<true>, true>(F.lds, D, S, E);
        } SEAMX(pb + 5, 7, (l + 1) * BG_PER_LAYER);
        if (EN(8) && IN(pb + 6)) {
            FRESH(); moe_tables(F, l);
            MoeOrder<false> S{(const char*)(F.ws + WS_A), (const char*)(F.ws + WS_WED + (size_t)l * 32 * D * D * 2), nullptr, 4, F.G, F.vcu,
                              (const LAS int*)(F.lds + MISC_OFF + L_BLK), (const LAS int*)(F.lds + MISC_OFF + L_CNT), (const int*)(F.ws + WS_LIST)};
            EpiPlainBf16 E{(bf16*)(F.ws + WS_B)};
            pg8::gemm_phase<EpiPlainBf16, MoeOrder<false>, true>(F.lds, D, S, E);
        } SEAMX(pb + 6, 8, 0);
        if (EN(9) && IN(pb + 7)) { FRESH(); phase_ln2(F, args, l); }
        if (l == 0) SEAMX(pb + 7, 9, 0);
    }
#undef IN
#undef SEAM
}

#undef args
extern "C" void kernel_launch(void* const* d_in, const int* in_sizes, int n_in, void* d_out, int out_size, void* d_ws, size_t ws_size, hipStream_t stream) {
    static int grid = 0;
    if (grid == 0) {
        if (n_in != 22 || out_size != NL * D || ws_size < WS_END) { fprintf(stderr, "kernel_launch: unexpected shapes (n_in %d, out %d, ws %zu, need %zu)\n", n_in, out_size, ws_size, (size_t)WS_END); grid = -1; return; }
        int dev = 0, cus = 0, per_cu = 0;
        if (hipGetDevice(&dev) != hipSuccess || hipDeviceGetAttribute(&cus, hipDeviceAttributeMultiprocessorCount, dev) != hipSuccess) { grid = -1; return; }
        if (hipFuncSetAttribute((const void*)fwd_kernel, hipFuncAttributeMaxDynamicSharedMemorySize, LDS_BYTES) != hipSuccess) { fprintf(stderr, "kernel_launch: hipFuncSetAttribute failed\n"); grid = -1; return; }
        if (hipOccupancyMaxActiveBlocksPerMultiprocessor(&per_cu, (const void*)fwd_kernel, 512, LDS_BYTES) != hipSuccess || per_cu < 1) fprintf(stderr, "kernel_launch: occupancy query reports %d\n", per_cu);
        (void)hipGetLastError();
        grid = cus;
    }
    if (grid < 0) return;
    static_assert((CW_PHDONE + 64 * 24) * 4 <= 512 * 1024, "every control word sits in the first 512 KiB");
    (void)hipMemsetAsync((char*)d_ws + WS_CTL, 0, 512 * 1024, stream);
    Args a{};
    for (int i = 0; i < 22; ++i) a.in[i] = (const float*)d_in[i];
    a.out = (float*)d_out; a.ws = (unsigned char*)d_ws;
#if MK_ONE_LAUNCH
    a.ph_lo = 0; a.ph_hi = N_PHASES;
    hipLaunchKernelGGL(fwd_kernel, dim3(grid), dim3(512), LDS_BYTES, stream, a);
#else
    for (int p = 0; p < N_PHASES; ++p) { a.ph_lo = p; a.ph_hi = p + 1;
#ifdef DUP_PHASE
        if (p == DUP_PHASE && (p == 6 || p == 14)) { a.ph_hi = p + 101; hipLaunchKernelGGL(fwd_kernel, dim3(grid), dim3(512), LDS_BYTES, stream, a); a.ph_hi = p + 1; }
#endif
        hipLaunchKernelGGL(fwd_kernel, dim3(grid), dim3(512), LDS_BYTES, stream, a);
#ifdef DUP_PHASE
        if (p == DUP_PHASE) { if (p == 0) (void)hipMemsetAsync((char*)d_ws + WS_CTL, 0, CTL_ZERO_BYTES, stream); if (p != 6 && p != 14) hipLaunchKernelGGL(fwd_kernel, dim3(grid), dim3(512), LDS_BYTES, stream, a); }
#endif
    }
#endif
}
```
